# Optimizing an MI355X kernel written in HIP

```python
import jax, jax.numpy as jnp
from jax import lax
import numpy as np

D_MODEL = 1024
BATCH = 2
SEQ = 16384
DEPTH = 1

CHUNK = 64
EPS = 1e-6

GLA_HEADS = 4
GLA_DK = 64
GLA_DV = 128
GLA_GATE_RANK = 16
GLA_GATE_TAU = 16.0
GLA_GATE_BIAS_INIT = 2.0

ATT_HEADS = 8
ATT_DH = 64
N_BACK_CHUNKS = 8
BAND_CHUNKS = N_BACK_CHUNKS + 1
REL_CLIP = 256
MASK_VALUE = -1e30

N_EXPERTS = 32
TOP_K = 4
D_FF = D_MODEL
SWIGLU_ALPHA = 1.702
SWIGLU_LIMIT = 7.0
MOE_BLOCK = 256

GLA_QK_W = GLA_HEADS * GLA_DK
GLA_V_W = GLA_HEADS * GLA_DV
ATT_W = ATT_HEADS * ATT_DH
MIX_W = GLA_V_W + ATT_W
IN_SIZES = (GLA_QK_W, GLA_QK_W, GLA_V_W, GLA_GATE_RANK, GLA_V_W, ATT_W, ATT_W, ATT_W)
IN_W = sum(IN_SIZES)
IN_SPLITS = [int(s) for s in np.cumsum(IN_SIZES)[:-1]]

kernel_name = "hybrid_gla_bandattn_moe_block"


def rms_norm(x, g):
    xf = x.astype(jnp.float32)
    y = xf * lax.rsqrt(jnp.mean(xf * xf, axis=-1, keepdims=True) + EPS)
    return (y * g.astype(jnp.float32)).astype(x.dtype)


def gla_mixer(q, k, v, gate_lr, g_out, gate_up, gate_bias, norm_g):
    B, S = q.shape[0], q.shape[1]
    NC = S // CHUNK
    f32 = jnp.float32
    qc = q.astype(f32).reshape(B, NC, CHUNK, GLA_HEADS, GLA_DK) * (GLA_DK ** -0.5)
    kc = k.astype(f32).reshape(B, NC, CHUNK, GLA_HEADS, GLA_DK)
    vc = v.astype(f32).reshape(B, NC, CHUNK, GLA_HEADS, GLA_DV)
    log_a = jax.nn.log_sigmoid((gate_lr @ gate_up + gate_bias).astype(f32)) / GLA_GATE_TAU
    log_a = log_a.reshape(B, NC, CHUNK, GLA_HEADS, GLA_DK)
    cum = jnp.cumsum(log_a, axis=2)
    tot = cum[:, :, -1]
    k_dec = kc * jnp.exp(tot[:, :, None] - cum)
    u = jnp.einsum('bnchk,bnchv->bnhkv', k_dec, vc)

    def step(state, inp):
        decay, u_n = inp
        state = decay[..., None] * state + u_n
        return state, state

    s0 = jnp.zeros((B, GLA_HEADS, GLA_DK, GLA_DV), f32)
    _, states = lax.scan(step, s0, (jnp.moveaxis(jnp.exp(tot), 1, 0), jnp.moveaxis(u, 1, 0)))
    states = jnp.moveaxis(states, 0, 1)
    o = jnp.einsum('bnchk,bnhkv->bnchv', qc, states)
    o = rms_norm(o, norm_g).reshape(B, S, GLA_V_W)
    o = o * jax.nn.silu(g_out.astype(f32))
    return o.astype(q.dtype)


def band_chunk_attention(q, k, v, q_norm_g, k_norm_g, rel_bias):
    B, S = q.shape[0], q.shape[1]
    NC = S // CHUNK
    qn = rms_norm(q.reshape(B, S, ATT_HEADS, ATT_DH), q_norm_g).reshape(B, NC, CHUNK, ATT_HEADS, ATT_DH)
    kn = rms_norm(k.reshape(B, S, ATT_HEADS, ATT_DH), k_norm_g).reshape(B, NC, CHUNK, ATT_HEADS, ATT_DH)
    vc = v.reshape(B, NC, CHUNK, ATT_HEADS, ATT_DH)

    def band(t):
        tp = jnp.pad(t, ((0, 0), (N_BACK_CHUNKS, 0), (0, 0), (0, 0), (0, 0)))
        tb = jnp.stack([tp[:, i:i + NC] for i in range(BAND_CHUNKS)], axis=2)
        return tb.reshape(B, NC, BAND_CHUNKS * CHUNK, ATT_HEADS, ATT_DH)

    kb, vb = band(kn), band(vc)
    scores = jnp.einsum('bnqhd,bnkhd->bnhqk', qn, kb).astype(jnp.float32) * (ATT_DH ** -0.5)
    rel = (N_BACK_CHUNKS * CHUNK + np.arange(CHUNK)[:, None]) - np.arange(BAND_CHUNKS * CHUNK)[None, :]
    idx = np.clip(rel, -REL_CLIP, REL_CLIP) + REL_CLIP
    bias = rel_bias[:, idx].astype(jnp.float32)
    key_chunk = np.arange(NC)[:, None] - N_BACK_CHUNKS + np.arange(BAND_CHUNKS)[None, :]
    valid = np.repeat(key_chunk >= 0, CHUNK, axis=1)
    scores = jnp.where(valid[None, :, None, None, :], scores + bias[None, None], MASK_VALUE)
    p = jax.nn.softmax(scores, axis=-1).astype(vb.dtype)
    o = jnp.einsum('bnhqk,bnkhd->bnqhd', p, vb)
    return o.reshape(B, S, ATT_W)


def moe_ffn(h, router_w, router_b, w_in, b_in, w_out, b_out):
    N, D = h.shape
    logits = (h @ router_w + router_b).astype(jnp.float32)
    top_val, top_idx = lax.top_k(logits, TOP_K)
    gates = jax.nn.softmax(top_val, axis=-1).astype(h.dtype)

    A = N * TOP_K
    n_blocks = -(-A // MOE_BLOCK) + N_EXPERTS
    P = n_blocks * MOE_BLOCK
    flat_e = top_idx.reshape(-1).astype(jnp.int32)
    flat_tok = jnp.repeat(jnp.arange(N, dtype=jnp.int32), TOP_K)
    flat_g = gates.reshape(-1)
    order = jnp.argsort(flat_e, stable=True)
    e_sorted, tok_sorted, g_sorted = flat_e[order], flat_tok[order], flat_g[order]
    counts = jnp.bincount(flat_e, length=N_EXPERTS).astype(jnp.int32)
    start = jnp.cumsum(counts) - counts
    padded = ((counts + MOE_BLOCK - 1) // MOE_BLOCK) * MOE_BLOCK
    pend = jnp.cumsum(padded)
    pstart = pend - padded
    dest = pstart[e_sorted] + (jnp.arange(A, dtype=jnp.int32) - start[e_sorted])
    buf_tok = jnp.full((P,), N, jnp.int32).at[dest].set(tok_sorted)
    buf_g = jnp.zeros((P,), h.dtype).at[dest].set(g_sorted)
    block_expert = jnp.minimum(
        jnp.searchsorted(pend, jnp.arange(n_blocks, dtype=jnp.int32) * MOE_BLOCK, side='right'),
        N_EXPERTS - 1).astype(jnp.int32)
    h_pad = jnp.concatenate([h, jnp.zeros((1, D), h.dtype)], axis=0)
    xb = h_pad[buf_tok].reshape(n_blocks, MOE_BLOCK, D)

    def expert_block(args):
        xblk, e = args
        hc = xblk @ w_in[e] + b_in[e]
        glu, lin = hc[:, :D_FF], hc[:, D_FF:]
        glu = jnp.minimum(glu, SWIGLU_LIMIT)
        lin = jnp.clip(lin, -SWIGLU_LIMIT, SWIGLU_LIMIT)
        act = glu * jax.nn.sigmoid(SWIGLU_ALPHA * glu) * (lin + 1.0)
        return act @ w_out[e] + b_out[e]

    y = lax.map(expert_block, (xb, block_expert)).reshape(P, D)
    out = jnp.zeros((N + 1, D), h.dtype).at[buf_tok].add(y * buf_g[:, None])
    return out[:N]


def hybrid_layer(x, norm1_g, w_in, gla_gate_up, gla_gate_bias, gla_norm_g, q_norm_g, k_norm_g,
                 rel_bias, w_out, norm2_g, router_w, router_b, moe_w_in, moe_b_in, moe_w_out, moe_b_out):
    B, S, D = x.shape
    h = rms_norm(x, norm1_g)
    proj = h @ w_in
    g_q, g_k, g_v, g_lr, g_og, a_q, a_k, a_v = jnp.split(proj, IN_SPLITS, axis=-1)
    o_gla = gla_mixer(g_q, g_k, g_v, g_lr, g_og, gla_gate_up, gla_gate_bias, gla_norm_g)
    o_att = band_chunk_attention(a_q, a_k, a_v, q_norm_g, k_norm_g, rel_bias)
    x = x + jnp.concatenate([o_gla, o_att], axis=-1) @ w_out
    h2 = rms_norm(x, norm2_g).reshape(B * S, D)
    y = moe_ffn(h2, router_w, router_b, moe_w_in, moe_b_in, moe_w_out, moe_b_out)
    return x + y.reshape(B, S, D)


def setup_inputs(seed: int = 0) -> dict:
    key = jax.random.key(seed)
    ks = jax.random.split(key, 17)
    f32 = jnp.float32
    L, D = DEPTH, D_MODEL
    nrm = lambda k, shape, s: jax.random.normal(k, shape, f32) * s
    return {
        "x": nrm(ks[0], (BATCH, SEQ, D), 1.0),
        "norm1_g": 1.0 + nrm(ks[1], (L, D), 0.02),
        "w_in": nrm(ks[2], (L, D, IN_W), D ** -0.5),
        "gla_gate_up": nrm(ks[3], (L, GLA_GATE_RANK, GLA_QK_W), GLA_GATE_RANK ** -0.5),
        "gla_gate_bias": GLA_GATE_BIAS_INIT + nrm(ks[4], (L, GLA_QK_W), 0.1),
        "gla_norm_g": 1.0 + nrm(ks[5], (L, GLA_DV), 0.02),
        "q_norm_g": 1.0 + nrm(ks[6], (L, ATT_DH), 0.02),
        "k_norm_g": 1.0 + nrm(ks[7], (L, ATT_DH), 0.02),
        "rel_bias": nrm(ks[8], (L, ATT_HEADS, 2 * REL_CLIP + 1), 0.3),
        "w_out": nrm(ks[9], (L, MIX_W, D), MIX_W ** -0.5),
        "norm2_g": 1.0 + nrm(ks[10], (L, D), 0.02),
        "router_w": nrm(ks[11], (L, D, N_EXPERTS), D ** -0.5),
        "router_b": nrm(ks[12], (L, N_EXPERTS), 0.01),
        "moe_w_in": nrm(ks[13], (L, N_EXPERTS, D, 2 * D_FF), D ** -0.5),
        "moe_b_in": nrm(ks[14], (L, N_EXPERTS, 2 * D_FF), 0.01),
        "moe_w_out": nrm(ks[15], (L, N_EXPERTS, D_FF, D), D_FF ** -0.5),
        "moe_b_out": nrm(ks[16], (L, N_EXPERTS, D), 0.01),
    }


def reference(x, norm1_g, w_in, gla_gate_up, gla_gate_bias, gla_norm_g, q_norm_g, k_norm_g,
              rel_bias, w_out, norm2_g, router_w, router_b, moe_w_in, moe_b_in, moe_w_out, moe_b_out):
    for l in range(DEPTH):
        x = hybrid_layer(x, norm1_g[l], w_in[l], gla_gate_up[l], gla_gate_bias[l], gla_norm_g[l],
                         q_norm_g[l], k_norm_g[l], rel_bias[l], w_out[l], norm2_g[l], router_w[l],
                         router_b[l], moe_w_in[l], moe_b_in[l], moe_w_out[l], moe_b_out[l])
    return x
```

```cpp
#include <hip/hip_runtime.h>
#include <cstdio>
#include <cstdint>

#ifndef MK_ONE_LAUNCH
#define MK_ONE_LAUNCH 0
#endif

namespace pg8 {
#define PG8_LAS __attribute__((address_space(3)))
typedef unsigned short bf16_t;
typedef short bf16x8 __attribute__((ext_vector_type(8)));
typedef float f32x4 __attribute__((ext_vector_type(4)));
typedef unsigned u32x4 __attribute__((ext_vector_type(4)));
constexpr int BM = 256, BK = 64, HALF = 128, HTB = HALF * BK * 2, STAGE_BYTES = 8 * HTB, NXCD = 8, WGM = 8;

__host__ __device__ __forceinline__ int lds_byte(int r, int c) { const int st = (r >> 4) * 2 + (c >> 5), rr = r & 15, cc = c & 31, ob = rr * 64 + cc * 2; return st * 1024 + (ob ^ (((ob >> 9) & 1) << 5)); }
__host__ __device__ __forceinline__ void stage_rc(int b, int& R, int& C) { const int st = b / 1024, sb = b % 1024, swz = sb ^ (((sb >> 9) & 1) << 5); R = (st >> 1) * 16 + swz / 64; C = (st & 1) * 32 + (swz % 64) / 2; }
__host__ __device__ __forceinline__ int perm32(int rho) { const int n = rho >> 4, i = rho & 15; return 8 * (i >> 2) + 4 * n + (i & 3); }

struct Unit { int pm, pn, pb, e; };
struct Gemm { const bf16_t* A; const bf16_t* Bt; int K; const int* rowtok; };

__device__ __forceinline__ bool tile_of(long L, int nM, int nN, int& pm, int& pn) {
    const int nwg = nM * nN; if (L >= nwg) return false;
    int wgid = (int)L; { const int q = nwg / NXCD, r = nwg % NXCD, xcd = wgid % NXCD, off = wgid / NXCD; wgid = (xcd < r ? xcd * (q + 1) : r * (q + 1) + (xcd - r) * q) + off; }
    const int nig = WGM * nN, gid = wgid / nig, fm = gid * WGM, gsz = (nM - fm) < WGM ? (nM - fm) : WGM;
    pm = fm + ((wgid % nig) % gsz); pn = (wgid % nig) / gsz; return true;
}
struct StaticOrder {
    int nM, nN, G, c;
    __device__ void init(int nM_, int nN_, int G_, int c_) { nM = nM_; nN = nN_; G = G_; c = c_; }
    __device__ __forceinline__ bool next(int i, Unit& u) const { if (!tile_of((long)i * G + c, nM, nN, u.pm, u.pn)) return false; u.pb = u.pn; u.e = 0; return true; }
};
struct MoeOrder {
    int nM, nN, G, c; const int* tile_e;
    __device__ void init(int nM_, int nN_, int G_, int c_, const int* te) { nM = nM_; nN = nN_; G = G_; c = c_; tile_e = te; }
    __device__ __forceinline__ bool next(int i, Unit& u) const { if (!tile_of((long)i * G + c, nM, nN, u.pm, u.pn)) return false; u.e = tile_e[u.pm]; u.pb = u.e * nN + u.pn; return true; }
};

__device__ __forceinline__ unsigned cvt_pk_bf16(float lo, float hi) { unsigned r; asm volatile("v_cvt_pk_bf16_f32 %0, %1, %2" : "=v"(r) : "v"(lo), "v"(hi)); return r; }

template <class Epi, class Sched, bool ALIGN_EPI, bool GATHER>
__device__ __forceinline__ void gemm_phase(PG8_LAS unsigned char* lds, const Gemm g, const Sched& S, const Epi& E) {
    const int tid = threadIdx.x, wid = __builtin_amdgcn_readfirstlane(tid >> 6), lane = tid & 63, wr = wid >> 2, wc = wid & 3, fr = lane & 15, fq = lane >> 4;
    const int K = g.K, nt = K / BK;
    const size_t kstep = (size_t)(BK * 2);
    const size_t hstep = (size_t)HALF * K * 2;
    const size_t tstep = 2 * hstep;
    int RA[2]; unsigned CA2[2], voffB[2];
#pragma unroll
    for (int i = 0; i < 2; ++i) { int R, C; stage_rc(tid * 16 + i * 8192, R, C); const int Rb = Epi::PERM ? ((R & ~31) + perm32(R & 31)) : R;
        RA[i] = R; CA2[i] = (unsigned)C * 2u; voffB[i] = (unsigned)(Rb * K + C) * 2u; }
    const unsigned ldsw = (unsigned)wid * 1024u;
    const int aoff = lds_byte(wr * 64 + fr, fq * 8), boff = lds_byte(wc * 32 + fr, fq * 8);
#define PG8_SA(b, h) (((b) * 2 + (h)) * HTB)
#define PG8_SB(b, h) ((4 + (b) * 2 + (h)) * HTB)
#define PG8_STAGE(bufoff, gbase, voff) do { _Pragma("unroll") for (int _i = 0; _i < 2; ++_i) \
        __builtin_amdgcn_global_load_lds((const unsigned*)((const char*)(gbase) + (voff)[_i]), (PG8_LAS unsigned*)(lds + (bufoff) + ldsw + _i * 8192), 16, 0, 0); } while (0)
#define PG8_LDA(dst, b, h) do { _Pragma("unroll") for (int m = 0; m < 4; ++m) _Pragma("unroll") for (int k = 0; k < 2; ++k) dst[m][k] = *(const PG8_LAS bf16x8*)(lds + PG8_SA(b, h) + aoff + m * 2048 + k * 1024); } while (0)
#define PG8_LDB(dst, b, h) do { _Pragma("unroll") for (int n = 0; n < 2; ++n) _Pragma("unroll") for (int k = 0; k < 2; ++k) dst[n][k] = *(const PG8_LAS bf16x8*)(lds + PG8_SB(b, h) + boff + n * 2048 + k * 1024); } while (0)
#define PG8_MMA(ai, bj, At, Bt) do { __builtin_amdgcn_s_setprio(1); _Pragma("unroll") for (int m = 0; m < 4; ++m) _Pragma("unroll") for (int n = 0; n < 2; ++n) _Pragma("unroll") for (int k = 0; k < 2; ++k) \
        acc[ai][bj][m][n] = __builtin_amdgcn_mfma_f32_16x16x32_bf16(Bt[n][k], At[m][k], acc[ai][bj][m][n], 0, 0, 0); __builtin_amdgcn_s_setprio(0); } while (0)
#define PG8_WAIT_V(n) asm volatile("s_waitcnt vmcnt(" #n ")" ::: "memory")
#define PG8_WAIT_L(n) asm volatile("s_waitcnt lgkmcnt(" #n ")" ::: "memory")
#define PG8_BAR __builtin_amdgcn_s_barrier()
#define PG8_SCHED __builtin_amdgcn_sched_barrier(0)
#define PG8_AOFF(dst, u) do { _Pragma("unroll") for (int h_ = 0; h_ < 2; ++h_) _Pragma("unroll") for (int i_ = 0; i_ < 2; ++i_) { \
        if constexpr (GATHER) { const int tok_ = g.rowtok[(u).pm * BM + h_ * HALF + RA[i_]]; dst[h_][i_] = (unsigned)tok_ * (unsigned)(K * 2) + CA2[i_]; } \
        else { dst[h_][i_] = (unsigned)(RA[i_] * K) * 2u + CA2[i_] + (unsigned)(h_ * (int)hstep); } } } while (0)
#define PG8_ABASE(u) ((const char*)g.A + (GATHER ? (size_t)0 : (size_t)(u).pm * tstep))
    Unit cur, nxt; int ui = 0;
    if (!S.next(0, cur)) return;
    f32x4 acc[2][2][4][2];
#pragma unroll
    for (int a = 0; a < 2; ++a)
#pragma unroll
        for (int b = 0; b < 2; ++b)
#pragma unroll
            for (int m = 0; m < 4; ++m)
#pragma unroll
                for (int n = 0; n < 2; ++n) acc[a][b][m][n] = (f32x4){0.f, 0.f, 0.f, 0.f};
    bf16x8 At[4][2], B0[2][2], B1[2][2];
    unsigned vA[2][2], nvA[2][2];
    PG8_AOFF(vA, cur);
#pragma unroll
    for (int h_ = 0; h_ < 2; ++h_) { nvA[h_][0] = vA[h_][0]; nvA[h_][1] = vA[h_][1]; }
    const char* cA = PG8_ABASE(cur); const char* cB = (const char*)g.Bt + (size_t)cur.pb * tstep;
    PG8_STAGE(PG8_SB(0, 0), cB, voffB); PG8_STAGE(PG8_SB(0, 1), cB + hstep, voffB); PG8_STAGE(PG8_SA(0, 0), cA, vA[0]); PG8_STAGE(PG8_SA(0, 1), cA, vA[1]);
    if (wr == 1) PG8_BAR;
    PG8_WAIT_V(2); PG8_BAR;
    PG8_STAGE(PG8_SB(1, 0), cB + kstep, voffB); PG8_STAGE(PG8_SA(1, 0), cA + kstep, vA[0]); PG8_STAGE(PG8_SB(1, 1), cB + hstep + kstep, voffB);
    PG8_WAIT_V(6); PG8_BAR;
    for (;;) {
        const bool has_next = S.next(ui + 1, nxt);
        if constexpr (GATHER) { if (has_next) { PG8_AOFF(nvA, nxt); } }
        const char* nA = has_next ? PG8_ABASE(nxt) : cA; const char* nB = has_next ? (const char*)g.Bt + (size_t)nxt.pb * tstep : cB;
        for (int t = 0; t < nt; t += 2) {
            const bool last = (t == nt - 2);
            const char* a1 = cA + (size_t)(t + 1) * kstep;
            const char* a2 = last ? nA : cA + (size_t)(t + 2) * kstep; const char* b2 = last ? nB : cB + (size_t)(t + 2) * kstep;
            const char* a3 = a2 + kstep; const char* b3 = b2 + kstep;
            unsigned sA[2][2];
#pragma unroll
            for (int h_ = 0; h_ < 2; ++h_)
#pragma unroll
                for (int i_ = 0; i_ < 2; ++i_) sA[h_][i_] = (GATHER && last && has_next) ? nvA[h_][i_] : vA[h_][i_];
            PG8_LDB(B0, 0, 0); PG8_LDB(B1, 0, 1); PG8_SCHED; PG8_LDA(At, 0, 0); PG8_STAGE(PG8_SA(1, 1), a1, vA[1]);
            PG8_WAIT_V(8); PG8_WAIT_L(0); PG8_BAR; PG8_MMA(0, 0, At, B0); PG8_MMA(0, 1, At, B1); PG8_BAR; PG8_SCHED;
            PG8_LDA(At, 0, 1); PG8_STAGE(PG8_SB(0, 0), b2, voffB); PG8_STAGE(PG8_SB(0, 1), b2 + hstep, voffB); PG8_STAGE(PG8_SA(0, 0), a2, sA[0]);
            PG8_WAIT_V(8); PG8_WAIT_L(0); PG8_BAR; PG8_MMA(1, 0, At, B0); PG8_MMA(1, 1, At, B1); PG8_BAR; PG8_SCHED;
            PG8_LDB(B0, 1, 0); PG8_LDB(B1, 1, 1); PG8_SCHED; PG8_LDA(At, 1, 0); PG8_STAGE(PG8_SA(0, 1), a2, sA[1]);
            PG8_WAIT_V(8); PG8_WAIT_L(0); PG8_BAR; PG8_MMA(0, 0, At, B0); PG8_MMA(0, 1, At, B1); PG8_BAR; PG8_SCHED;
            PG8_LDA(At, 1, 1); PG8_STAGE(PG8_SB(1, 0), b3, voffB); PG8_STAGE(PG8_SB(1, 1), b3 + hstep, voffB); PG8_STAGE(PG8_SA(1, 0), a3, sA[0]);
            PG8_WAIT_V(8); PG8_WAIT_L(0); PG8_BAR; PG8_MMA(1, 0, At, B0); PG8_MMA(1, 1, At, B1); PG8_BAR; PG8_SCHED;
        }
        if constexpr (ALIGN_EPI) { if (wr == 0) PG8_BAR; }
        E(acc, cur, wr, wc, fr, fq);
        if (!has_next) break;
#pragma unroll
        for (int a = 0; a < 2; ++a)
#pragma unroll
            for (int b = 0; b < 2; ++b)
#pragma unroll
                for (int m = 0; m < 4; ++m)
#pragma unroll
                    for (int n = 0; n < 2; ++n) acc[a][b][m][n] = (f32x4){0.f, 0.f, 0.f, 0.f};
        cur = nxt; cA = nA; cB = nB; ++ui;
        if constexpr (GATHER) {
#pragma unroll
            for (int h_ = 0; h_ < 2; ++h_) { vA[h_][0] = nvA[h_][0]; vA[h_][1] = nvA[h_][1]; } }
        if constexpr (ALIGN_EPI) { if (wr == 1) PG8_BAR; }
    }
    PG8_WAIT_V(0);
    if constexpr (!ALIGN_EPI) { if (wr == 0) PG8_BAR; }
    PG8_BAR;
#undef PG8_SA
#undef PG8_SB
#undef PG8_STAGE
#undef PG8_LDA
#undef PG8_LDB
#undef PG8_MMA
#undef PG8_WAIT_V
#undef PG8_WAIT_L
#undef PG8_BAR
#undef PG8_SCHED
#undef PG8_AOFF
#undef PG8_ABASE
}
}

constexpr int NWAVES = 8, NTHR = 512;
constexpr int NTOK = 32768, DM = 1024, SEQ = 16384, CH = 64, NCH = SEQ / CH, NCHT = 2 * NCH;
constexpr int PW = 3072;
constexpr int C_GQ = 0, C_GK = 256, C_GV = 512, C_OG = 1024, C_AQ = 1536, C_AK = 2048, C_AV = 2560;
constexpr int NIN = 3328;
constexpr int W_IN_COLS = 3088;
constexpr int NEXP = 32, TOPK = 4, DFF = 1024;
constexpr int PSLOTS = 139264;
constexpr float EPS = 1e-6f;
constexpr float LOG2E = 1.4426950408889634f;
constexpr float C2 = 0.125f * LOG2E;

constexpr size_t MiB = 1u << 20;
constexpr size_t WS_CTL = 0, CTL_ZERO_BYTES = 1 * MiB;
constexpr size_t WS_RWP = 1 * MiB;
constexpr size_t WS_TOPE = 2 * MiB, WS_TOPG = 3 * MiB, WS_RANK = 4 * MiB, WS_SLOTOF = 5 * MiB;
constexpr size_t WS_HIST = 6 * MiB;
constexpr size_t WS_TILEE = 6 * MiB + 65536;
constexpr size_t WS_BUFTOK = 7 * MiB, WS_GATESLOT = 8 * MiB;
constexpr size_t WS_DEC = 9 * MiB;
constexpr size_t WS_WIN = 10 * MiB;
constexpr size_t WS_WOUT = 17 * MiB;
constexpr size_t WS_WMIN = 20 * MiB;
constexpr size_t WS_WMOUT = 148 * MiB;
constexpr size_t WS_H2 = 212 * MiB;
constexpr size_t WS_Y = 276 * MiB;
constexpr size_t WS_H1 = 548 * MiB;
constexpr size_t WS_PROJ = 612 * MiB;
constexpr size_t WS_GATE = 804 * MiB;
constexpr size_t WS_US = 836 * MiB;
constexpr size_t WS_MIX = 900 * MiB;
constexpr size_t WS_ACT = 548 * MiB;
constexpr size_t WS_END = 964 * MiB;
static_assert(WS_Y + (size_t)PSLOTS * 1024 * 2 <= WS_H1 && WS_ACT + (size_t)PSLOTS * 1024 * 2 <= WS_US && WS_MIX + (size_t)NTOK * 1024 * 2 <= WS_END, "ws map");
static_assert(WS_WIN + (size_t)NIN * 1024 * 2 <= WS_WOUT && WS_WMIN + (size_t)32 * 2048 * 1024 * 2 <= WS_WMOUT && WS_WMOUT + (size_t)32 * 1024 * 1024 * 2 <= WS_H2, "ws map 2");

constexpr int CW_BAR = 4096;
constexpr int RING_BYTES = 131072, LDSCTL_OFF = RING_BYTES, MISC_OFF = LDSCTL_OFF + 320, LDS_BYTES = 147456;

#define GAS __attribute__((address_space(1)))
#define LAS __attribute__((address_space(3)))
typedef unsigned short bf16;
typedef unsigned v4u __attribute__((ext_vector_type(4)));
typedef unsigned v2u __attribute__((ext_vector_type(2)));
typedef float f32x4 __attribute__((ext_vector_type(4)));
typedef float f32x16 __attribute__((ext_vector_type(16)));
#define LDS_WAIT() asm volatile("s_waitcnt lgkmcnt(0)" ::: "memory")
__device__ __forceinline__ unsigned f2bf(float f) { unsigned u = __builtin_bit_cast(unsigned, f); return (u + 0x7fffu + ((u >> 16) & 1u)) >> 16; }
__device__ __forceinline__ unsigned pk2(float lo, float hi) { return f2bf(lo) | (f2bf(hi) << 16); }
__device__ __forceinline__ float bflo(unsigned w) { return __builtin_bit_cast(float, w << 16); }
__device__ __forceinline__ float bfhi(unsigned w) { return __builtin_bit_cast(float, w & 0xffff0000u); }

#define XB_TMO      128
#define XB_XCNT(j)  (256  + 64 * (j))
#define XB_XSUB(j)  (1280 + 64 * (j))
#define XB_XGEN(j)  (2304 + 64 * (j))
#define XB_TOP      3328
#define XB_TOPGEN   3392
#define XCD_BAR_WORDS 3456
#define XB_SPIN_CAP (1u << 18)
__device__ __forceinline__ unsigned xb_ld(unsigned* p)              { return __hip_atomic_load(p, __ATOMIC_RELAXED, __HIP_MEMORY_SCOPE_AGENT); }
__device__ __forceinline__ unsigned xb_add(unsigned* p, unsigned v) { return __hip_atomic_fetch_add(p, v, __ATOMIC_RELAXED, __HIP_MEMORY_SCOPE_AGENT); }
__device__ __forceinline__ unsigned xb_xcc_id() { return (unsigned)__builtin_amdgcn_s_getreg((3 << 11) | 20) & 0xFu; }
#define XB_SPIN(cond, bar) do { unsigned _sp = 0; while (cond) { __builtin_amdgcn_s_sleep(1); \
    if ((++_sp & 255u) == 0u) { if (xb_ld(&(bar)[XB_TMO])) break; if (_sp > XB_SPIN_CAP) { atomicAdd(&(bar)[XB_TMO], 1u); break; } } } } while (0)
struct XcdBarrier { unsigned* bar; unsigned x; volatile LAS unsigned* st; };
__device__ __forceinline__ XcdBarrier xcd_barrier_post(unsigned* bar, volatile LAS unsigned* st) {
    XcdBarrier b; b.bar = bar; b.x = xb_xcc_id(); b.st = st;
    if (threadIdx.x == 0) (void)xb_add(&bar[XB_XCNT(b.x)], 1u);
    return b;
}
__device__ __forceinline__ void xcd_barrier_complete(unsigned* bar, unsigned x, unsigned& nloc, unsigned& nx) {
    const unsigned G = gridDim.x * gridDim.y * gridDim.z;
    unsigned sum, cnt, mine, sp = 0u;
    for (;;) {
        sum = 0u; cnt = 0u; mine = 0u;
#pragma unroll
        for (unsigned j = 0; j < 16; ++j) { const unsigned c = xb_ld(&bar[XB_XCNT(j)]); sum += c; cnt += (c > 0u) ? 1u : 0u; mine = (j == x) ? c : mine; }
        if (sum == G) break;
        __builtin_amdgcn_s_sleep(1);
        if ((++sp & 255u) == 0u) { if (xb_ld(&bar[XB_TMO])) break; if (sp > XB_SPIN_CAP) { atomicAdd(&bar[XB_TMO], 1u); break; } }
    }
    nloc = mine > 0u ? mine : 1u; nx = cnt > 0u ? cnt : 1u;
}
__device__ __forceinline__ void xcd_barrier(const XcdBarrier& b) {
    asm volatile("s_waitcnt vmcnt(0)" ::: "memory");
    __syncthreads();
    if (threadIdx.x == 0) {
        unsigned* bar = b.bar;
        __builtin_amdgcn_s_waitcnt(0);
        unsigned nloc = b.st[0], nx = b.st[1];
        if (nloc == 0u) { xcd_barrier_complete(bar, b.x, nloc, nx); b.st[0] = nloc; b.st[1] = nx; }
        const unsigned old = xb_add(&bar[XB_XSUB(b.x)], 1u);
        const unsigned gen = old / nloc;
        if (old + 1u == (gen + 1u) * nloc) {
            __builtin_amdgcn_fence(__ATOMIC_RELEASE, "agent");
            asm volatile("s_waitcnt vmcnt(0)" ::: "memory");
            const unsigned og = xb_add(&bar[XB_TOP], 1u);
            const unsigned tg = og / nx;
            if (og + 1u == (tg + 1u) * nx) xb_add(&bar[XB_TOPGEN], 1u);
            else XB_SPIN(xb_ld(&bar[XB_TOPGEN]) == tg, bar);
            __builtin_amdgcn_fence(__ATOMIC_ACQUIRE, "agent");
            xb_add(&bar[XB_XGEN(b.x)], 1u);
            asm volatile("s_waitcnt vmcnt(0)" ::: "memory");
        } else {
            XB_SPIN(xb_ld(&bar[XB_XGEN(b.x)]) == gen, bar);
            __builtin_amdgcn_fence(__ATOMIC_ACQUIRE, "agent");
            asm volatile("s_waitcnt vmcnt(0)" ::: "memory");
        }
    }
    __syncthreads();
}

using pg8::Unit; using pg8::cvt_pk_bf16;
struct EpiProj {
    static constexpr bool PERM = true;
    bf16* P; float* G; const float* gbias;
    __device__ __forceinline__ void operator()(const f32x4 (&acc)[2][2][4][2], const Unit& u, int wr, int wc, int fr, int fq) const {
        const int row0 = u.pm * 256 + wr * 64 + fr;
        if (u.pn < 12) {
            const int col0 = u.pn * 256 + wc * 32 + 8 * fq;
#pragma unroll
            for (int ai = 0; ai < 2; ++ai)
#pragma unroll
                for (int m = 0; m < 4; ++m) { bf16* rowp = P + (size_t)(row0 + ai * 128 + m * 16) * PW + col0;
#pragma unroll
                    for (int bj = 0; bj < 2; ++bj) { const f32x4 v0 = acc[ai][bj][m][0], v1 = acc[ai][bj][m][1];
                        v4u w; w.x = cvt_pk_bf16(v0[0], v0[1]); w.y = cvt_pk_bf16(v0[2], v0[3]); w.z = cvt_pk_bf16(v1[0], v1[1]); w.w = cvt_pk_bf16(v1[2], v1[3]);
                        *(v4u*)(rowp + bj * 128) = w; } }
        } else {
            const int col0 = wc * 32 + 8 * fq;
            f32x4 bv[2][2];
#pragma unroll
            for (int bj = 0; bj < 2; ++bj)
#pragma unroll
                for (int n = 0; n < 2; ++n) bv[bj][n] = *(const f32x4*)(gbias + col0 + bj * 128 + 4 * n);
#pragma unroll
            for (int ai = 0; ai < 2; ++ai)
#pragma unroll
                for (int m = 0; m < 4; ++m) { float* rowp = G + (size_t)(row0 + ai * 128 + m * 16) * 256 + col0;
#pragma unroll
                    for (int bj = 0; bj < 2; ++bj)
#pragma unroll
                        for (int n = 0; n < 2; ++n) { const f32x4 z = acc[ai][bj][m][n] + bv[bj][n]; f32x4 o;
#pragma unroll
                            for (int i = 0; i < 4; ++i) { const float zz = z[i]; const float t = __logf(1.f + __expf(-fabsf(zz))); o[i] = (fminf(zz, 0.f) - t) * (1.f / 16.f); }
                            *(f32x4*)(rowp + bj * 128 + 4 * n) = o; } }
        }
    }
};
struct EpiResid {
    static constexpr bool PERM = false;
    const float* X; float* O;
    __device__ __forceinline__ void operator()(const f32x4 (&acc)[2][2][4][2], const Unit& u, int wr, int wc, int fr, int fq) const {
        const int row0 = u.pm * 256 + wr * 64 + fr, col0 = u.pn * 256 + wc * 32 + 4 * fq;
#pragma unroll
        for (int ai = 0; ai < 2; ++ai)
#pragma unroll
            for (int m = 0; m < 4; ++m) { const size_t off = (size_t)(row0 + ai * 128 + m * 16) * DM + col0;
#pragma unroll
                for (int bj = 0; bj < 2; ++bj)
#pragma unroll
                    for (int n = 0; n < 2; ++n) { const f32x4 xv = *(const f32x4*)(X + off + bj * 128 + n * 16); *(f32x4*)(O + off + bj * 128 + n * 16) = acc[ai][bj][m][n] + xv; } }
    }
};
struct EpiSwiglu {
    static constexpr bool PERM = true;
    bf16* ACT; const float* bin;
    __device__ __forceinline__ void operator()(const f32x4 (&acc)[2][2][4][2], const Unit& u, int wr, int wc, int fr, int fq) const {
        const int row0 = u.pm * 256 + wr * 64 + fr, f0 = u.pn * 128 + wc * 32 + 8 * fq;
        const float* bg = bin + (size_t)u.e * 2048 + f0; const float* bl = bg + 1024;
        f32x4 bgv[2], blv[2];
#pragma unroll
        for (int n = 0; n < 2; ++n) { bgv[n] = *(const f32x4*)(bg + 4 * n); blv[n] = *(const f32x4*)(bl + 4 * n); }
#pragma unroll
        for (int ai = 0; ai < 2; ++ai)
#pragma unroll
            for (int m = 0; m < 4; ++m) { float a[8];
#pragma unroll
                for (int n = 0; n < 2; ++n) { const f32x4 gl = acc[ai][0][m][n] + bgv[n], li = acc[ai][1][m][n] + blv[n];
#pragma unroll
                    for (int i = 0; i < 4; ++i) { const float gg = fminf(gl[i], 7.f), ll = fminf(fmaxf(li[i], -7.f), 7.f);
                        const float sg = __builtin_amdgcn_rcpf(1.f + __builtin_amdgcn_exp2f(-1.702f * LOG2E * gg)); a[4 * n + i] = gg * sg * (ll + 1.f); } }
                v4u w; w.x = cvt_pk_bf16(a[0], a[1]); w.y = cvt_pk_bf16(a[2], a[3]); w.z = cvt_pk_bf16(a[4], a[5]); w.w = cvt_pk_bf16(a[6], a[7]);
                *(v4u*)(ACT + (size_t)(row0 + ai * 128 + m * 16) * 1024 + f0) = w; }
    }
};
struct EpiY {
    static constexpr bool PERM = true;
    bf16* Y; const float* bout; const float* gslot;
    __device__ __forceinline__ void operator()(const f32x4 (&acc)[2][2][4][2], const Unit& u, int wr, int wc, int fr, int fq) const {
        const int row0 = u.pm * 256 + wr * 64 + fr, col0 = u.pn * 256 + wc * 32 + 8 * fq;
        const float* bb = bout + (size_t)u.e * 1024 + col0;
        f32x4 bv[2][2];
#pragma unroll
        for (int bj = 0; bj < 2; ++bj)
#pragma unroll
            for (int n = 0; n < 2; ++n) bv[bj][n] = *(const f32x4*)(bb + bj * 128 + 4 * n);
#pragma unroll
        for (int ai = 0; ai < 2; ++ai)
#pragma unroll
            for (int m = 0; m < 4; ++m) { const int row = row0 + ai * 128 + m * 16; const float gt = gslot[row]; bf16* rowp = Y + (size_t)row * 1024 + col0;
#pragma unroll
                for (int bj = 0; bj < 2; ++bj) { const f32x4 v0 = (acc[ai][bj][m][0] + bv[bj][0]) * gt, v1 = (acc[ai][bj][m][1] + bv[bj][1]) * gt;
                    v4u w; w.x = cvt_pk_bf16(v0[0], v0[1]); w.y = cvt_pk_bf16(v0[2], v0[3]); w.z = cvt_pk_bf16(v1[0], v1[1]); w.w = cvt_pk_bf16(v1[2], v1[3]);
                    *(v4u*)(rowp + bj * 128) = w; } }
    }
};

__device__ __forceinline__ float wave_sum(float v) {
#pragma unroll
    for (int o = 1; o < 64; o <<= 1) v += __shfl_xor(v, o);
    return v;
}
__device__ __forceinline__ void p0_transpose_item(const float* W, int Nsrc, bf16* WT, int Kp, int k0, int ns0, int nd0, LAS float* scr, int lane) {
#pragma unroll 8
    for (int i = 0; i < 32; ++i) { const int kk = 2 * i + (lane >> 5); scr[kk * 33 + (lane & 31)] = W[(size_t)(k0 + kk) * Nsrc + ns0 + (lane & 31)]; }
    LDS_WAIT(); asm volatile("" ::: "memory");
    const int c = lane & 7;
#pragma unroll
    for (int j = 0; j < 4; ++j) { const int n = (lane >> 3) + 8 * j; const LAS float* s = scr + (8 * c) * 33 + n;
        v4u o; o.x = pk2(s[0 * 33], s[1 * 33]); o.y = pk2(s[2 * 33], s[3 * 33]); o.z = pk2(s[4 * 33], s[5 * 33]); o.w = pk2(s[6 * 33], s[7 * 33]);
        *(v4u*)(WT + (size_t)(nd0 + n) * Kp + k0 + 8 * c) = o; }
    LDS_WAIT(); asm volatile("" ::: "memory");
}

struct Args { const float* in[17]; float* out; unsigned char* ws; int ph_lo, ph_hi, li, pad; };
constexpr int NPHASE = 11;

__global__ void __launch_bounds__(NTHR, 2) fwd(Args args) {
    extern __shared__ __attribute__((aligned(16))) unsigned char lds_raw[];
    LAS unsigned char* lds = (LAS unsigned char*)lds_raw;
    LAS float* ldsf = (LAS float*)lds_raw;
    volatile LAS unsigned* MISC = (volatile LAS unsigned*)(lds + MISC_OFF);
    const int tid = threadIdx.x, lane = tid & 63, wave = __builtin_amdgcn_readfirstlane(tid >> 6);
    const int G = gridDim.x, bx = blockIdx.x;
    unsigned char* ws = args.ws;
    unsigned* ctl = (unsigned*)(ws + WS_CTL);
    const float* x = args.in[0]; const float* g1 = args.in[1]; const float* w_in = args.in[2]; const float* gate_up = args.in[3]; const float* gate_bias = args.in[4];
    const float* gla_ng = args.in[5]; const float* qng = args.in[6]; const float* kng = args.in[7]; const float* rel_bias = args.in[8]; const float* w_out = args.in[9];
    const float* g2 = args.in[10]; const float* router_w = args.in[11]; const float* router_b = args.in[12]; const float* moe_w_in = args.in[13]; const float* moe_b_in = args.in[14];
    const float* moe_w_out = args.in[15]; const float* moe_b_out = args.in[16];
    float* out = args.out;
    float* RWP = (float*)(ws + WS_RWP); int* TOPE = (int*)(ws + WS_TOPE); float* TOPG = (float*)(ws + WS_TOPG); int* RANK = (int*)(ws + WS_RANK); int* SLOTOF = (int*)(ws + WS_SLOTOF);
    int* HIST = (int*)(ws + WS_HIST); int* TILEE = (int*)(ws + WS_TILEE); int* BUFTOK = (int*)(ws + WS_BUFTOK); float* GATESLOT = (float*)(ws + WS_GATESLOT); float* DEC = (float*)(ws + WS_DEC);
    bf16* WIN = (bf16*)(ws + WS_WIN); bf16* WOUT = (bf16*)(ws + WS_WOUT); bf16* WMIN = (bf16*)(ws + WS_WMIN); bf16* WMOUT = (bf16*)(ws + WS_WMOUT);
    bf16* H2 = (bf16*)(ws + WS_H2); bf16* YB = (bf16*)(ws + WS_Y); bf16* H1 = (bf16*)(ws + WS_H1); bf16* PROJ = (bf16*)(ws + WS_PROJ); float* GATE = (float*)(ws + WS_GATE);
    float* US = (float*)(ws + WS_US); bf16* MIX = (bf16*)(ws + WS_MIX); bf16* ACT = (bf16*)(ws + WS_ACT);

    for (int u = tid; u < (LDS_BYTES - LDSCTL_OFF) / 4; u += NTHR) ((LAS unsigned*)(lds + LDSCTL_OFF))[u] = 0u;
    __syncthreads();
    XcdBarrier bar; bar.bar = ctl + CW_BAR; bar.x = 0; bar.st = nullptr;
#if MK_ONE_LAUNCH
    bar = xcd_barrier_post(ctl + CW_BAR, MISC + 8);
#define GRID_BAR() xcd_barrier(bar)
#else
#define GRID_BAR() do { } while (0)
#endif
    const int lo = args.ph_lo, hi = args.ph_hi;
#define IN(k) (lo <= (k) && (k) < hi)
#define BOTH(k) (IN(k) && IN((k) + 1))
    const int gw = bx * NWAVES + wave, NGW = G * NWAVES;
    const int gthr = bx * NTHR + tid, NGT = G * NTHR;

    if (IN(0)) {
        LAS float* scr = (LAS float*)(lds + wave * 16384);
        constexpr int I_IN = 16 * 96, I_OUT = 16 * 32, I_MIN = 32 * 16 * 64, I_MOUT = 32 * 16 * 32, NITEMS = I_IN + I_OUT + I_MIN + I_MOUT;
        for (int it = gw; it < NITEMS; it += NGW) {
            int r = it;
            if (r < I_MIN) { const int e = r / 1024, q = r % 1024, kb = q / 64, nb = q % 64, ns0 = 32 * nb, f = ns0 & 1023, nd0 = 256 * (f >> 7) + ((ns0 >= 1024) ? 128 : 0) + (f & 127);
                p0_transpose_item(moe_w_in + (size_t)e * 1024 * 2048, 2048, WMIN + (size_t)e * 2048 * 1024, 1024, 64 * kb, ns0, nd0, scr, lane); continue; } r -= I_MIN;
            if (r < I_MOUT) { const int e = r / 512, q = r % 512, kb = q / 32, nb = q % 32;
                p0_transpose_item(moe_w_out + (size_t)e * 1024 * 1024, 1024, WMOUT + (size_t)e * 1024 * 1024, 1024, 64 * kb, 32 * nb, 32 * nb, scr, lane); continue; } r -= I_MOUT;
            if (r < I_IN) { const int kb = r / 96, nb = r % 96, nd0 = 32 * nb, ns0 = nd0 < 1024 ? nd0 : nd0 + 16;
                p0_transpose_item(w_in, W_IN_COLS, WIN, 1024, 64 * kb, ns0, nd0, scr, lane); continue; } r -= I_IN;
            { const int kb = r / 32, nb = r % 32; p0_transpose_item(w_out, 1024, WOUT, 1024, 64 * kb, 32 * nb, 32 * nb, scr, lane); }
        }
        for (int idx = gthr; idx < 256 * 1024; idx += NGT) { const int j = idx >> 10, d = idx & 1023; const float* wr_ = w_in + (size_t)d * W_IN_COLS + 1024; float s = 0.f;
#pragma unroll
            for (int r = 0; r < 16; ++r) s += wr_[r] * gate_up[r * 256 + j];
            WIN[(size_t)(3072 + j) * 1024 + d] = (bf16)f2bf(s); }
        for (int idx = gthr; idx < 1024 * 32; idx += NGT) RWP[idx] = router_w[idx] * g2[idx >> 5];
        for (int m = gw; m < NTOK; m += NGW) {
            const f32x4* xr = (const f32x4*)(x + (size_t)m * DM) + lane; const f32x4* gr = (const f32x4*)g1 + lane;
            f32x4 v[4]; float s = 0.f;
#pragma unroll
            for (int j = 0; j < 4; ++j) { v[j] = xr[64 * j]; s += (v[j].x * v[j].x + v[j].y * v[j].y) + (v[j].z * v[j].z + v[j].w * v[j].w); }
            const float r = 1.f / sqrtf(wave_sum(s) * (1.f / DM) + EPS);
            unsigned long long* o8 = (unsigned long long*)(H1 + (size_t)m * DM) + lane;
#pragma unroll
            for (int j = 0; j < 4; ++j) { const f32x4 gg = gr[64 * j]; o8[64 * j] = (unsigned long long)pk2(v[j].x * r * gg.x, v[j].y * r * gg.y) | ((unsigned long long)pk2(v[j].z * r * gg.z, v[j].w * r * gg.w) << 32); }
        }
        if (BOTH(0)) GRID_BAR();
    }

    if (IN(1)) {
        pg8::Gemm g{H1, WIN, 1024, nullptr}; pg8::StaticOrder S; S.init(NTOK / 256, NIN / 256, G, bx);
        EpiProj E{PROJ, GATE, gate_bias};
        pg8::gemm_phase<EpiProj, pg8::StaticOrder, true, false>(lds, g, S, E);
        if (BOTH(1)) GRID_BAR();
    }

    if (IN(2)) {
        LAS float* cum = ldsf;
        LAS float* kd = ldsf + 4096;
        LAS float* vs = ldsf + 8192;
        LAS float* segs = ldsf + 16384;
        LAS float* tot = ldsf + 16384 + 512;
        for (int un = bx; un < NCHT * 4; un += G) {
            const int chunk = un >> 2, h = un & 3; const size_t tok0 = (size_t)chunk * 64;
#pragma unroll
            for (int j = 0; j < 8; ++j) { const int idx = tid + 512 * j, c = idx >> 6, k = idx & 63; cum[idx] = GATE[(tok0 + c) * 256 + h * 64 + k]; }
            __syncthreads();
            { const int seg = tid >> 6, k = tid & 63; float run = 0.f;
#pragma unroll
              for (int i = 0; i < 8; ++i) { run += cum[(seg * 8 + i) * 64 + k]; cum[(seg * 8 + i) * 64 + k] = run; }
              segs[seg * 64 + k] = run; }
            __syncthreads();
            { const int seg = tid >> 6, k = tid & 63; float off = 0.f;
              for (int s = 0; s < seg; ++s) off += segs[s * 64 + k];
#pragma unroll
              for (int i = 0; i < 8; ++i) cum[(seg * 8 + i) * 64 + k] += off;
              if (seg == 7) tot[k] = off + segs[7 * 64 + k]; }
            __syncthreads();
#pragma unroll
            for (int j = 0; j < 2; ++j) { const int idx4 = tid + 512 * j, c = idx4 >> 4, k4 = (idx4 & 15) * 4;
                const v2u kw = *(const v2u*)(PROJ + (tok0 + c) * PW + C_GK + h * 64 + k4);
                const float kv[4] = {bflo(kw.x), bfhi(kw.x), bflo(kw.y), bfhi(kw.y)};
#pragma unroll
                for (int i = 0; i < 4; ++i) kd[c * 64 + k4 + i] = kv[i] * __expf(tot[k4 + i] - cum[c * 64 + k4 + i]); }
#pragma unroll
            for (int j = 0; j < 4; ++j) { const int idx4 = tid + 512 * j, c = idx4 >> 5, v4 = (idx4 & 31) * 4;
                const v2u vw = *(const v2u*)(PROJ + (tok0 + c) * PW + C_GV + h * 128 + v4);
                *(LAS f32x4*)(vs + c * 128 + v4) = (f32x4){bflo(vw.x), bfhi(vw.x), bflo(vw.y), bfhi(vw.y)}; }
            if (tid < 64) DEC[(size_t)chunk * 256 + h * 64 + tid] = __expf(tot[tid]);
            __syncthreads();
            { const int v0 = (tid >> 4) * 4, k0 = (tid & 15) * 4; f32x4 a0 = {0, 0, 0, 0}, a1 = a0, a2 = a0, a3 = a0;
#pragma unroll 8
              for (int c = 0; c < 64; ++c) { const f32x4 vv = *(const LAS f32x4*)(vs + c * 128 + v0), kk = *(const LAS f32x4*)(kd + c * 64 + k0);
                  a0 += kk * vv.x; a1 += kk * vv.y; a2 += kk * vv.z; a3 += kk * vv.w; }
              float* up = US + ((size_t)un * 128 + v0) * 64 + k0;
              *(f32x4*)(up) = a0; *(f32x4*)(up + 64) = a1; *(f32x4*)(up + 128) = a2; *(f32x4*)(up + 192) = a3; }
            __syncthreads();
        }
        for (int m = gw; m < NTOK; m += NGW) {
            bf16* p = PROJ + (size_t)m * PW + C_AQ + 16 * lane;
            const v4u w0 = *(const v4u*)p, w1 = *(const v4u*)(p + 8);
            float v[16] = {bflo(w0.x), bfhi(w0.x), bflo(w0.y), bfhi(w0.y), bflo(w0.z), bfhi(w0.z), bflo(w0.w), bfhi(w0.w), bflo(w1.x), bfhi(w1.x), bflo(w1.y), bfhi(w1.y), bflo(w1.z), bfhi(w1.z), bflo(w1.w), bfhi(w1.w)};
            float s = 0.f;
#pragma unroll
            for (int i = 0; i < 16; ++i) s += v[i] * v[i];
            s += __shfl_xor(s, 1); s += __shfl_xor(s, 2);
            const float r = 1.f / sqrtf(s * (1.f / 64.f) + EPS);
            const int d0 = (16 * lane) & 63;
#pragma unroll
            for (int i = 0; i < 16; ++i) { const float sc = (lane < 32) ? r * qng[d0 + i] * kng[d0 + i] * C2 : r; v[i] *= sc; }
            v4u o0, o1; o0.x = pk2(v[0], v[1]); o0.y = pk2(v[2], v[3]); o0.z = pk2(v[4], v[5]); o0.w = pk2(v[6], v[7]); o1.x = pk2(v[8], v[9]); o1.y = pk2(v[10], v[11]); o1.z = pk2(v[12], v[13]); o1.w = pk2(v[14], v[15]);
            *(v4u*)p = o0; *(v4u*)(p + 8) = o1;
        }
        if (BOTH(2)) GRID_BAR();
    }

    if (IN(3)) {
        for (int e = gthr; e < 65536; e += NGT) {
            const int b = e >> 15, idx = e & 32767, hk = ((idx >> 13) << 6) + (idx & 63);
            float* up = US + (size_t)b * 256 * 32768 + idx; const float* dp = DEC + (size_t)b * 256 * 256 + hk;
            float s = 0.f;
            for (int n = 0; n < 256; n += 8) { float uu[8], dd[8];
#pragma unroll
                for (int i = 0; i < 8; ++i) { uu[i] = up[(size_t)(n + i) * 32768]; dd[i] = dp[(size_t)(n + i) * 256]; }
#pragma unroll
                for (int i = 0; i < 8; ++i) { s = dd[i] * s + uu[i]; up[(size_t)(n + i) * 32768] = s; } }
        }
        LAS float* Ks = ldsf;
        LAS float* Vs = ldsf + 64 * 68;
        LAS float* Ps = Vs + 64 * 64;
        LAS float* bT = Ps + 64 * 68;
        for (int un = bx; un < NCHT * 8; un += G) {
            const int h = un & 7, chunk = un >> 3, b = chunk >> 8, n = chunk & 255; const size_t tok0 = (size_t)chunk * 64, btok0 = (size_t)b * SEQ;
            const int qi = tid >> 3, kg = tid & 7;
            for (int i = tid; i < 513; i += NTHR) bT[i] = rel_bias[h * 513 + i] * LOG2E;
            float q[64];
            { const bf16* qp = PROJ + (tok0 + qi) * PW + C_AQ + h * 64;
#pragma unroll
              for (int j = 0; j < 8; ++j) { const v4u w = *(const v4u*)(qp + 8 * j); q[8 * j] = bflo(w.x); q[8 * j + 1] = bfhi(w.x); q[8 * j + 2] = bflo(w.y); q[8 * j + 3] = bfhi(w.y); q[8 * j + 4] = bflo(w.z); q[8 * j + 5] = bfhi(w.z); q[8 * j + 6] = bflo(w.w); q[8 * j + 7] = bfhi(w.w); } }
            float mrun = -1e30f, lsum = 0.f, o[8];
#pragma unroll
            for (int i = 0; i < 8; ++i) o[i] = 0.f;
            const int jc0 = n >= 8 ? n - 8 : 0;
            for (int jc = jc0; jc <= n; ++jc) {
                __syncthreads();
                { const int key = tid >> 3, d8 = (tid & 7) * 8; const size_t kr = (btok0 + (size_t)jc * 64 + key) * PW + h * 64 + d8;
                  const v4u kw = *(const v4u*)(PROJ + kr + C_AK), vw = *(const v4u*)(PROJ + kr + C_AV);
                  *(LAS f32x4*)(Ks + key * 68 + d8) = (f32x4){bflo(kw.x), bfhi(kw.x), bflo(kw.y), bfhi(kw.y)}; *(LAS f32x4*)(Ks + key * 68 + d8 + 4) = (f32x4){bflo(kw.z), bfhi(kw.z), bflo(kw.w), bfhi(kw.w)};
                  *(LAS f32x4*)(Vs + key * 64 + d8) = (f32x4){bflo(vw.x), bfhi(vw.x), bflo(vw.y), bfhi(vw.y)}; *(LAS f32x4*)(Vs + key * 64 + d8 + 4) = (f32x4){bflo(vw.z), bfhi(vw.z), bflo(vw.w), bfhi(vw.w)}; }
                __syncthreads();
                float s[8]; float mt = -1e30f;
#pragma unroll
                for (int j = 0; j < 8; ++j) { const int key = kg + 8 * j; float a = 0.f;
#pragma unroll
                    for (int d = 0; d < 64; d += 4) { const f32x4 kk = *(const LAS f32x4*)(Ks + key * 68 + d); a += q[d] * kk.x + q[d + 1] * kk.y + q[d + 2] * kk.z + q[d + 3] * kk.w; }
                    int rel = 64 * (n - jc) + qi - key; rel = rel > 256 ? 256 : rel; a += bT[rel + 256]; s[j] = a; mt = fmaxf(mt, a); }
                mt = fmaxf(mt, __shfl_xor(mt, 1)); mt = fmaxf(mt, __shfl_xor(mt, 2)); mt = fmaxf(mt, __shfl_xor(mt, 4));
                const float mnew = fmaxf(mrun, mt), sc = __builtin_amdgcn_exp2f(mrun - mnew); mrun = mnew; lsum *= sc;
#pragma unroll
                for (int i = 0; i < 8; ++i) o[i] *= sc;
#pragma unroll
                for (int j = 0; j < 8; ++j) { const float p = __builtin_amdgcn_exp2f(s[j] - mnew); lsum += p; Ps[qi * 68 + kg + 8 * j] = p; }
                __syncthreads();
#pragma unroll 4
                for (int key = 0; key < 64; key += 4) { const f32x4 pp = *(const LAS f32x4*)(Ps + qi * 68 + key);
#pragma unroll
                    for (int kk = 0; kk < 4; ++kk) { const f32x4 v0 = *(const LAS f32x4*)(Vs + (key + kk) * 64 + kg * 8), v1 = *(const LAS f32x4*)(Vs + (key + kk) * 64 + kg * 8 + 4); const float pv = pp[kk];
                        o[0] += pv * v0.x; o[1] += pv * v0.y; o[2] += pv * v0.z; o[3] += pv * v0.w; o[4] += pv * v1.x; o[5] += pv * v1.y; o[6] += pv * v1.z; o[7] += pv * v1.w; } }
            }
            lsum += __shfl_xor(lsum, 1); lsum += __shfl_xor(lsum, 2); lsum += __shfl_xor(lsum, 4);
            const float inv = 1.f / lsum;
            v4u w; w.x = pk2(o[0] * inv, o[1] * inv); w.y = pk2(o[2] * inv, o[3] * inv); w.z = pk2(o[4] * inv, o[5] * inv); w.w = pk2(o[6] * inv, o[7] * inv);
            *(v4u*)(MIX + (tok0 + qi) * DM + 512 + h * 64 + kg * 8) = w;
            __syncthreads();
        }
        if (BOTH(3)) GRID_BAR();
    }

    if (IN(4)) {
        LAS float* qT = ldsf;
        LAS float* ST = ldsf + 64 * 68;
        for (int un = bx; un < NCHT * 4; un += G) {
            const int chunk = un >> 2, h = un & 3; const size_t tok0 = (size_t)chunk * 64;
#pragma unroll
            for (int j = 0; j < 2; ++j) { const int idx4 = tid + 512 * j, c = idx4 >> 4, k4 = (idx4 & 15) * 4;
                const v2u qw = *(const v2u*)(PROJ + (tok0 + c) * PW + C_GQ + h * 64 + k4);
                qT[(k4 + 0) * 68 + c] = bflo(qw.x) * 0.125f; qT[(k4 + 1) * 68 + c] = bfhi(qw.x) * 0.125f; qT[(k4 + 2) * 68 + c] = bflo(qw.y) * 0.125f; qT[(k4 + 3) * 68 + c] = bfhi(qw.y) * 0.125f; }
#pragma unroll
            for (int j = 0; j < 4; ++j) { const int idx4 = tid + 512 * j, v = idx4 >> 4, k4 = (idx4 & 15) * 4;
                const f32x4 sv = *(const f32x4*)(US + ((size_t)un * 128 + v) * 64 + k4);
                ST[(k4 + 0) * 132 + v] = sv.x; ST[(k4 + 1) * 132 + v] = sv.y; ST[(k4 + 2) * 132 + v] = sv.z; ST[(k4 + 3) * 132 + v] = sv.w; }
            __syncthreads();
            const int c0 = (tid >> 5) * 4, v0 = (tid & 31) * 4; f32x4 a[4]; a[0] = (f32x4){0, 0, 0, 0}; a[1] = a[0]; a[2] = a[0]; a[3] = a[0];
#pragma unroll 8
            for (int k = 0; k < 64; ++k) { const f32x4 qq = *(const LAS f32x4*)(qT + k * 68 + c0), ss = *(const LAS f32x4*)(ST + k * 132 + v0);
                a[0] += ss * qq.x; a[1] += ss * qq.y; a[2] += ss * qq.z; a[3] += ss * qq.w; }
            const f32x4 gn = *(const f32x4*)(gla_ng + v0);
#pragma unroll
            for (int i = 0; i < 4; ++i) { float ssq = (a[i].x * a[i].x + a[i].y * a[i].y) + (a[i].z * a[i].z + a[i].w * a[i].w);
                ssq += __shfl_xor(ssq, 1); ssq += __shfl_xor(ssq, 2); ssq += __shfl_xor(ssq, 4); ssq += __shfl_xor(ssq, 8); ssq += __shfl_xor(ssq, 16);
                const float r = 1.f / sqrtf(ssq * (1.f / 128.f) + EPS);
                const v2u gw_ = *(const v2u*)(PROJ + (tok0 + c0 + i) * PW + C_OG + h * 128 + v0);
                const float og[4] = {bflo(gw_.x), bfhi(gw_.x), bflo(gw_.y), bfhi(gw_.y)}; float ov[4];
#pragma unroll
                for (int j = 0; j < 4; ++j) { const float sg = og[j] / (1.f + __expf(-og[j])); ov[j] = a[i][j] * r * gn[j] * sg; }
                v2u w; w.x = pk2(ov[0], ov[1]); w.y = pk2(ov[2], ov[3]);
                *(v2u*)(MIX + (tok0 + c0 + i) * DM + h * 128 + v0) = w; }
            __syncthreads();
        }
        if (BOTH(4)) GRID_BAR();
    }

    if (IN(5)) {
        pg8::Gemm g{MIX, WOUT, 1024, nullptr}; pg8::StaticOrder S; S.init(NTOK / 256, 4, G, bx);
        EpiResid E{x, out};
        pg8::gemm_phase<EpiResid, pg8::StaticOrder, true, false>(lds, g, S, E);
        if (BOTH(5)) GRID_BAR();
    }

    if (IN(6)) {
        LAS float* rstd = ldsf;
        LAS int* lh = (LAS int*)(ldsf + 128);
        for (int blk = bx; blk < 256; blk += G) {
            const int t0 = blk * 128;
            if (tid < 32) lh[tid] = 0;
            f32x16 acc;
#pragma unroll
            for (int i = 0; i < 16; ++i) acc[i] = 0.f;
            if (wave >= 4) {
                const f32x4* gr = (const f32x4*)g2 + lane;
                for (int j = 0; j < 32; ++j) { const int tl = (wave - 4) * 32 + j; const size_t m = (size_t)t0 + tl;
                    const f32x4* xr = (const f32x4*)(out + m * DM) + lane; f32x4 v[4]; float s = 0.f;
#pragma unroll
                    for (int jj = 0; jj < 4; ++jj) { v[jj] = xr[64 * jj]; s += (v[jj].x * v[jj].x + v[jj].y * v[jj].y) + (v[jj].z * v[jj].z + v[jj].w * v[jj].w); }
                    const float r = 1.f / sqrtf(wave_sum(s) * (1.f / DM) + EPS);
                    unsigned long long* o8 = (unsigned long long*)(H2 + m * DM) + lane;
#pragma unroll
                    for (int jj = 0; jj < 4; ++jj) { const f32x4 gg = gr[64 * jj]; o8[64 * jj] = (unsigned long long)pk2(v[jj].x * r * gg.x, v[jj].y * r * gg.y) | ((unsigned long long)pk2(v[jj].z * r * gg.z, v[jj].w * r * gg.w) << 32); }
                    if (lane == 0) rstd[tl] = r; }
            } else {
                const int half = lane >> 5, l31 = lane & 31; const size_t m = (size_t)t0 + wave * 32 + l31;
                const float* xp = out + m * DM + 4 * half; const float* wp = RWP + (4 * half) * 32 + l31;
                for (int mm = 0; mm < 128; ++mm) { const f32x4 xv = *(const f32x4*)(xp + 8 * mm);
#pragma unroll
                    for (int i = 0; i < 4; ++i) { const float a = wp[(8 * mm + i) * 32]; acc = __builtin_amdgcn_mfma_f32_32x32x2f32(a, xv[i], acc, 0, 0, 0); } }
            }
            __syncthreads();
            if (wave < 4) {
                const int half = lane >> 5, l31 = lane & 31, tl = wave * 32 + l31; const float r = rstd[tl];
                float bv[4] = {-3e38f, -3e38f, -3e38f, -3e38f}; int bi[4] = {0, 0, 0, 0};
#pragma unroll
                for (int reg = 0; reg < 16; ++reg) { const int e = (reg & 3) + 8 * (reg >> 2) + 4 * half; float v = acc[reg] * r + router_b[e]; int id = e;
#pragma unroll
                    for (int s = 0; s < 4; ++s) { const bool gt = v > bv[s]; const float tv = gt ? bv[s] : v; const int ti = gt ? bi[s] : id; bv[s] = gt ? v : bv[s]; bi[s] = gt ? id : bi[s]; v = tv; id = ti; } }
                float ov[4]; int oi[4];
#pragma unroll
                for (int s = 0; s < 4; ++s) { ov[s] = __shfl_xor(bv[s], 32); oi[s] = __shfl_xor(bi[s], 32); }
#pragma unroll
                for (int c = 0; c < 4; ++c) { float v = ov[c]; int id = oi[c];
#pragma unroll
                    for (int s = 0; s < 4; ++s) { const bool gt = (v > bv[s]) || (v == bv[s] && id < bi[s]); const float tv = gt ? bv[s] : v; const int ti = gt ? bi[s] : id; bv[s] = gt ? v : bv[s]; bi[s] = gt ? id : bi[s]; v = tv; id = ti; } }
                if (half == 0) {
                    const float e1 = __expf(bv[1] - bv[0]), e2 = __expf(bv[2] - bv[0]), e3 = __expf(bv[3] - bv[0]); const float inv = 1.f / (1.f + e1 + e2 + e3);
                    const size_t m = (size_t)t0 + tl;
                    *(f32x4*)(TOPG + m * 4) = (f32x4){inv, e1 * inv, e2 * inv, e3 * inv};
                    int rk[4];
#pragma unroll
                    for (int s = 0; s < 4; ++s) rk[s] = atomicAdd((int*)&lh[bi[s]], 1);
                    *(v4u*)(TOPE + m * 4) = (v4u){(unsigned)bi[0], (unsigned)bi[1], (unsigned)bi[2], (unsigned)bi[3]};
                    *(v4u*)(RANK + m * 4) = (v4u){(unsigned)rk[0], (unsigned)rk[1], (unsigned)rk[2], (unsigned)rk[3]};
                }
            }
            __syncthreads();
            if (tid < 32) HIST[blk * 32 + tid] = lh[tid];
            __syncthreads();
        }
        if (BOTH(6)) GRID_BAR();
    }

    if (IN(7)) {
        LAS int* ptot = (LAS int*)ldsf;
        LAS int* pbase = ptot + 512;
        LAS int* tot = pbase + 512;
        LAS int* pstart = tot + 32;
        LAS int* sbase = pstart + 32;
        for (int blk = bx; blk < 256; blk += G) {
            { const int e = tid & 31, part = tid >> 5; int a = 0, b = 0;
              for (int i = 0; i < 16; ++i) { const int bb = part * 16 + i; const int hv = HIST[bb * 32 + e]; a += hv; b += (bb < blk) ? hv : 0; }
              ptot[part * 32 + e] = a; pbase[part * 32 + e] = b; }
            __syncthreads();
            if (tid < 32) { int a = 0, b = 0; for (int p = 0; p < 16; ++p) { a += ptot[p * 32 + tid]; b += pbase[p * 32 + tid]; } tot[tid] = a; sbase[tid] = b; }
            __syncthreads();
            if (tid < 32) { int ps = 0; for (int e = 0; e < tid; ++e) ps += (tot[e] + 255) & ~255; pstart[tid] = ps; sbase[tid] += ps; }
            __syncthreads();
            { const int tl = tid >> 2, k = tid & 3; const size_t m = (size_t)blk * 128 + tl; const int e = TOPE[m * 4 + k]; const int slot = sbase[e] + RANK[m * 4 + k];
              BUFTOK[slot] = (int)m; GATESLOT[slot] = TOPG[m * 4 + k]; SLOTOF[m * 4 + k] = slot; }
            if (blk < 32) { const int e = blk, ps = pstart[e], te = tot[e], pe = (te + 255) & ~255;
                if (tid < 256 && te + tid < pe) { BUFTOK[ps + te + tid] = 0; GATESLOT[ps + te + tid] = 0.f; }
                for (int t = tid; t < pe / 256; t += NTHR) TILEE[ps / 256 + t] = e;
                if (e == 31 && tid == 0) TILEE[1023] = (ps + pe) / 256; }
            __syncthreads();
        }
        if (BOTH(7)) GRID_BAR();
    }

    if (IN(8)) {
        const int nT = TILEE[1023];
        pg8::Gemm g{H2, WMIN, 1024, BUFTOK}; pg8::MoeOrder S; S.init(nT, 8, G, bx, TILEE);
        EpiSwiglu E{ACT, moe_b_in};
        pg8::gemm_phase<EpiSwiglu, pg8::MoeOrder, true, true>(lds, g, S, E);
        if (BOTH(8)) GRID_BAR();
    }

    if (IN(9)) {
        const int nT = TILEE[1023];
        pg8::Gemm g{ACT, WMOUT, 1024, nullptr}; pg8::MoeOrder S; S.init(nT, 4, G, bx, TILEE);
        EpiY E{YB, moe_b_out, GATESLOT};
        pg8::gemm_phase<EpiY, pg8::MoeOrder, true, false>(lds, g, S, E);
        if (BOTH(9)) GRID_BAR();
    }

    if (IN(10)) {
        for (int m = gw; m < NTOK; m += NGW) {
            const v4u sl = *(const v4u*)(SLOTOF + (size_t)m * 4);
            float* op = out + (size_t)m * DM;
#pragma unroll
            for (int j = 0; j < 2; ++j) { const int col = 8 * lane + 512 * j;
                f32x4 a0 = *(const f32x4*)(op + col), a1 = *(const f32x4*)(op + col + 4);
#pragma unroll
                for (int k = 0; k < 4; ++k) { const v4u w = *(const v4u*)(YB + (size_t)sl[k] * 1024 + col);
                    a0.x += bflo(w.x); a0.y += bfhi(w.x); a0.z += bflo(w.y); a0.w += bfhi(w.y); a1.x += bflo(w.z); a1.y += bfhi(w.z); a1.z += bflo(w.w); a1.w += bfhi(w.w); }
                *(f32x4*)(op + col) = a0; *(f32x4*)(op + col + 4) = a1; }
        }
    }
#undef IN
#undef BOTH
}

extern "C" void kernel_launch(void* const* d_in, const int* in_sizes, int n_in, void* d_out, int out_size, void* d_ws, size_t ws_size, hipStream_t stream) {
    static int grid = 0;
    if (grid == 0) {
        if (n_in != 17 || in_sizes[0] != NTOK * DM || out_size != NTOK * DM || ws_size < WS_END) { fprintf(stderr, "kernel_launch: unexpected shapes (n_in %d, in0 %d, out %d, ws %zu)\n", n_in, n_in > 0 ? in_sizes[0] : -1, out_size, ws_size); grid = -1; return; }
        int dev = 0, cus = 0, per_cu = 0;
        if (hipGetDevice(&dev) != hipSuccess || hipDeviceGetAttribute(&cus, hipDeviceAttributeMultiprocessorCount, dev) != hipSuccess) { grid = -1; return; }
        if (hipFuncSetAttribute((const void*)fwd, hipFuncAttributeMaxDynamicSharedMemorySize, LDS_BYTES) != hipSuccess) { fprintf(stderr, "kernel_launch: hipFuncSetAttribute failed\n"); grid = -1; return; }
        if (hipOccupancyMaxActiveBlocksPerMultiprocessor(&per_cu, (const void*)fwd, NTHR, LDS_BYTES) != hipSuccess || per_cu < 1) fprintf(stderr, "kernel_launch: occupancy query reports %d\n", per_cu);
        (void)hipGetLastError();
        grid = cus;
    }
    if (grid < 0) return;
    (void)hipMemsetAsync((char*)d_ws + WS_CTL, 0, CTL_ZERO_BYTES, stream);
    Args a{};
    for (int i = 0; i < 17; ++i) a.in[i] = (const float*)d_in[i];
    a.out = (float*)d_out; a.ws = (unsigned char*)d_ws; a.li = 0; a.pad = 0;
#if MK_ONE_LAUNCH
    a.ph_lo = 0; a.ph_hi = NPHASE;
    hipLaunchKernelGGL(fwd, dim3(grid), dim3(NTHR), LDS_BYTES, stream, a);
#else
    for (int p = 0; p < NPHASE; ++p) { a.ph_lo = p; a.ph_hi = p + 1; hipLaunchKernelGGL(fwd, dim3(grid), dim3(NTHR), LDS_BYTES, stream, a); }
#endif
}
```

```cpp
#include <hip/hip_runtime.h>
#include <cstdio>
#include <cstdint>

#ifndef MK_ONE_LAUNCH
#define MK_ONE_LAUNCH 1
#endif

namespace pg8 {
#define PG8_LAS __attribute__((address_space(3)))
typedef unsigned short bf16_t;
typedef short bf16x8 __attribute__((ext_vector_type(8)));
typedef float f32x4 __attribute__((ext_vector_type(4)));
typedef unsigned u32x4 __attribute__((ext_vector_type(4)));
constexpr int BM = 256, BK = 64, HALF = 128, HTB = HALF * BK * 2, STAGE_BYTES = 8 * HTB, NXCD = 8, WGM = 8;

__host__ __device__ __forceinline__ int lds_byte(int r, int c) { const int st = (r >> 4) * 2 + (c >> 5), rr = r & 15, cc = c & 31, ob = rr * 64 + cc * 2; return st * 1024 + (ob ^ (((ob >> 9) & 1) << 5)); }
__host__ __device__ __forceinline__ void stage_rc(int b, int& R, int& C) { const int st = b / 1024, sb = b % 1024, swz = sb ^ (((sb >> 9) & 1) << 5); R = (st >> 1) * 16 + swz / 64; C = (st & 1) * 32 + (swz % 64) / 2; }
__host__ __device__ __forceinline__ int perm32(int rho) { const int n = rho >> 4, i = rho & 15; return 8 * (i >> 2) + 4 * n + (i & 3); }

struct Unit { int pm, pn, pb, e; };
struct Gemm { const bf16_t* A; const bf16_t* Bt; int K; const int* rowtok; };

__device__ __forceinline__ bool tile_of(long L, int nM, int nN, int& pm, int& pn) {
    const int nwg = nM * nN; if (L >= nwg) return false;
    int wgid = (int)L; { const int q = nwg / NXCD, r = nwg % NXCD, xcd = wgid % NXCD, off = wgid / NXCD; wgid = (xcd < r ? xcd * (q + 1) : r * (q + 1) + (xcd - r) * q) + off; }
    const int nig = WGM * nN, gid = wgid / nig, fm = gid * WGM, gsz = (nM - fm) < WGM ? (nM - fm) : WGM;
    pm = fm + ((wgid % nig) % gsz); pn = (wgid % nig) / gsz; return true;
}
struct StaticOrder {
    int nM, nN, G, c;
    __device__ void init(int nM_, int nN_, int G_, int c_) { nM = nM_; nN = nN_; G = G_; c = c_; }
    __device__ __forceinline__ bool next(int i, Unit& u) const { if (!tile_of((long)i * G + c, nM, nN, u.pm, u.pn)) return false; u.pb = u.pn; u.e = 0; return true; }
};
struct MoeOrder {
    int nM, nN, G, c; const int* tile_e;
    __device__ void init(int nM_, int nN_, int G_, int c_, const int* te) { nM = nM_; nN = nN_; G = G_; c = c_; tile_e = te; }
    __device__ __forceinline__ bool next(int i, Unit& u) const { if (!tile_of((long)i * G + c, nM, nN, u.pm, u.pn)) return false; u.e = tile_e[u.pm]; u.pb = u.e * nN + u.pn; return true; }
};

__device__ __forceinline__ unsigned cvt_pk_bf16(float lo, float hi) { unsigned r; asm volatile("v_cvt_pk_bf16_f32 %0, %1, %2" : "=v"(r) : "v"(lo), "v"(hi)); return r; }

template <class Epi, class Sched, bool ALIGN_EPI, bool GATHER>
__device__ __forceinline__ void gemm_phase(PG8_LAS unsigned char* lds, const Gemm g, const Sched& S, const Epi& E) {
    const int tid = threadIdx.x, wid = __builtin_amdgcn_readfirstlane(tid >> 6), lane = tid & 63, wr = wid >> 2, wc = wid & 3, fr = lane & 15, fq = lane >> 4;
    const int K = g.K, nt = K / BK;
    const size_t kstep = (size_t)(BK * 2);
    const size_t hstep = (size_t)HALF * K * 2;
    const size_t tstep = 2 * hstep;
    int RA[2]; unsigned CA2[2], voffB[2];
#pragma unroll
    for (int i = 0; i < 2; ++i) { int R, C; stage_rc(tid * 16 + i * 8192, R, C); const int Rb = Epi::PERM ? ((R & ~31) + perm32(R & 31)) : R;
        RA[i] = R; CA2[i] = (unsigned)C * 2u; voffB[i] = (unsigned)(Rb * K + C) * 2u; }
    const unsigned ldsw = (unsigned)wid * 1024u;
    const int aoff = lds_byte(wr * 64 + fr, fq * 8), boff = lds_byte(wc * 32 + fr, fq * 8);
#define PG8_SA(b, h) (((b) * 2 + (h)) * HTB)
#define PG8_SB(b, h) ((4 + (b) * 2 + (h)) * HTB)
#define PG8_STAGE(bufoff, gbase, voff) do { _Pragma("unroll") for (int _i = 0; _i < 2; ++_i) \
        __builtin_amdgcn_global_load_lds((const unsigned*)((const char*)(gbase) + (voff)[_i]), (PG8_LAS unsigned*)(lds + (bufoff) + ldsw + _i * 8192), 16, 0, 0); } while (0)
#define PG8_LDA(dst, b, h) do { _Pragma("unroll") for (int m = 0; m < 4; ++m) _Pragma("unroll") for (int k = 0; k < 2; ++k) dst[m][k] = *(const PG8_LAS bf16x8*)(lds + PG8_SA(b, h) + aoff + m * 2048 + k * 1024); } while (0)
#define PG8_LDB(dst, b, h) do { _Pragma("unroll") for (int n = 0; n < 2; ++n) _Pragma("unroll") for (int k = 0; k < 2; ++k) dst[n][k] = *(const PG8_LAS bf16x8*)(lds + PG8_SB(b, h) + boff + n * 2048 + k * 1024); } while (0)
#define PG8_MMA(ai, bj, At, Bt) do { __builtin_amdgcn_s_setprio(1); _Pragma("unroll") for (int m = 0; m < 4; ++m) _Pragma("unroll") for (int n = 0; n < 2; ++n) _Pragma("unroll") for (int k = 0; k < 2; ++k) \
        acc[ai][bj][m][n] = __builtin_amdgcn_mfma_f32_16x16x32_bf16(Bt[n][k], At[m][k], acc[ai][bj][m][n], 0, 0, 0); __builtin_amdgcn_s_setprio(0); } while (0)
#define PG8_WAIT_V(n) asm volatile("s_waitcnt vmcnt(" #n ")" ::: "memory")
#define PG8_WAIT_L(n) asm volatile("s_waitcnt lgkmcnt(" #n ")" ::: "memory")
#define PG8_BAR __builtin_amdgcn_s_barrier()
#define PG8_SCHED __builtin_amdgcn_sched_barrier(0)
#define PG8_AOFF(dst, u) do { _Pragma("unroll") for (int h_ = 0; h_ < 2; ++h_) _Pragma("unroll") for (int i_ = 0; i_ < 2; ++i_) { \
        if constexpr (GATHER) { const int tok_ = g.rowtok[(u).pm * BM + h_ * HALF + RA[i_]]; dst[h_][i_] = (unsigned)tok_ * (unsigned)(K * 2) + CA2[i_]; } \
        else { dst[h_][i_] = (unsigned)(RA[i_] * K) * 2u + CA2[i_] + (unsigned)(h_ * (int)hstep); } } } while (0)
#define PG8_ABASE(u) ((const char*)g.A + (GATHER ? (size_t)0 : (size_t)(u).pm * tstep))
    Unit cur, nxt; int ui = 0;
    if (!S.next(0, cur)) return;
    f32x4 acc[2][2][4][2];
#pragma unroll
    for (int a = 0; a < 2; ++a)
#pragma unroll
        for (int b = 0; b < 2; ++b)
#pragma unroll
            for (int m = 0; m < 4; ++m)
#pragma unroll
                for (int n = 0; n < 2; ++n) acc[a][b][m][n] = (f32x4){0.f, 0.f, 0.f, 0.f};
    bf16x8 At[4][2], B0[2][2], B1[2][2];
    unsigned vA[2][2], nvA[2][2];
    PG8_AOFF(vA, cur);
#pragma unroll
    for (int h_ = 0; h_ < 2; ++h_) { nvA[h_][0] = vA[h_][0]; nvA[h_][1] = vA[h_][1]; }
    const char* cA = PG8_ABASE(cur); const char* cB = (const char*)g.Bt + (size_t)cur.pb * tstep;
    PG8_STAGE(PG8_SB(0, 0), cB, voffB); PG8_STAGE(PG8_SB(0, 1), cB + hstep, voffB); PG8_STAGE(PG8_SA(0, 0), cA, vA[0]); PG8_STAGE(PG8_SA(0, 1), cA, vA[1]);
    if (wr == 1) PG8_BAR;
    PG8_WAIT_V(2); PG8_BAR;
    PG8_STAGE(PG8_SB(1, 0), cB + kstep, voffB); PG8_STAGE(PG8_SA(1, 0), cA + kstep, vA[0]); PG8_STAGE(PG8_SB(1, 1), cB + hstep + kstep, voffB);
    PG8_WAIT_V(6); PG8_BAR;
    for (;;) {
        const bool has_next = S.next(ui + 1, nxt);
        if constexpr (GATHER) { if (has_next) { PG8_AOFF(nvA, nxt); } }
        const char* nA = has_next ? PG8_ABASE(nxt) : cA; const char* nB = has_next ? (const char*)g.Bt + (size_t)nxt.pb * tstep : cB;
        for (int t = 0; t < nt; t += 2) {
            const bool last = (t == nt - 2);
            const char* a1 = cA + (size_t)(t + 1) * kstep;
            const char* a2 = last ? nA : cA + (size_t)(t + 2) * kstep; const char* b2 = last ? nB : cB + (size_t)(t + 2) * kstep;
            const char* a3 = a2 + kstep; const char* b3 = b2 + kstep;
            unsigned sA[2][2];
#pragma unroll
            for (int h_ = 0; h_ < 2; ++h_)
#pragma unroll
                for (int i_ = 0; i_ < 2; ++i_) sA[h_][i_] = (GATHER && last && has_next) ? nvA[h_][i_] : vA[h_][i_];
            PG8_LDB(B0, 0, 0); PG8_LDB(B1, 0, 1); PG8_SCHED; PG8_LDA(At, 0, 0); PG8_STAGE(PG8_SA(1, 1), a1, vA[1]);
            PG8_WAIT_V(8); PG8_WAIT_L(0); PG8_BAR; PG8_MMA(0, 0, At, B0); PG8_MMA(0, 1, At, B1); PG8_BAR; PG8_SCHED;
            PG8_LDA(At, 0, 1); PG8_STAGE(PG8_SB(0, 0), b2, voffB); PG8_STAGE(PG8_SB(0, 1), b2 + hstep, voffB); PG8_STAGE(PG8_SA(0, 0), a2, sA[0]);
            PG8_WAIT_V(8); PG8_WAIT_L(0); PG8_BAR; PG8_MMA(1, 0, At, B0); PG8_MMA(1, 1, At, B1); PG8_BAR; PG8_SCHED;
            PG8_LDB(B0, 1, 0); PG8_LDB(B1, 1, 1); PG8_SCHED; PG8_LDA(At, 1, 0); PG8_STAGE(PG8_SA(0, 1), a2, sA[1]);
            PG8_WAIT_V(8); PG8_WAIT_L(0); PG8_BAR; PG8_MMA(0, 0, At, B0); PG8_MMA(0, 1, At, B1); PG8_BAR; PG8_SCHED;
            PG8_LDA(At, 1, 1); PG8_STAGE(PG8_SB(1, 0), b3, voffB); PG8_STAGE(PG8_SB(1, 1), b3 + hstep, voffB); PG8_STAGE(PG8_SA(1, 0), a3, sA[0]);
            PG8_WAIT_V(8); PG8_WAIT_L(0); PG8_BAR; PG8_MMA(1, 0, At, B0); PG8_MMA(1, 1, At, B1); PG8_BAR; PG8_SCHED;
        }
        if constexpr (ALIGN_EPI) { if (wr == 0) PG8_BAR; }
        E(acc, cur, wr, wc, fr, fq);
        if (!has_next) break;
#pragma unroll
        for (int a = 0; a < 2; ++a)
#pragma unroll
            for (int b = 0; b < 2; ++b)
#pragma unroll
                for (int m = 0; m < 4; ++m)
#pragma unroll
                    for (int n = 0; n < 2; ++n) acc[a][b][m][n] = (f32x4){0.f, 0.f, 0.f, 0.f};
        cur = nxt; cA = nA; cB = nB; ++ui;
        if constexpr (GATHER) {
#pragma unroll
            for (int h_ = 0; h_ < 2; ++h_) { vA[h_][0] = nvA[h_][0]; vA[h_][1] = nvA[h_][1]; } }
        if constexpr (ALIGN_EPI) { if (wr == 1) PG8_BAR; }
    }
    PG8_WAIT_V(0);
    if constexpr (!ALIGN_EPI) { if (wr == 0) PG8_BAR; }
    PG8_BAR;
#undef PG8_SA
#undef PG8_SB
#undef PG8_STAGE
#undef PG8_LDA
#undef PG8_LDB
#undef PG8_MMA
#undef PG8_WAIT_V
#undef PG8_WAIT_L
#undef PG8_BAR
#undef PG8_SCHED
#undef PG8_AOFF
#undef PG8_ABASE
}
}

constexpr int NWAVES = 8, NTHR = 512;
constexpr int NTOK = 32768, DM = 1024, SEQ = 16384, CH = 64, NCH = SEQ / CH, NCHT = 2 * NCH;
constexpr int PW = 3072;
constexpr int C_GQ = 0, C_GK = 256, C_GV = 512, C_OG = 1024, C_AQ = 1536, C_AK = 2048, C_AV = 2560;
constexpr int NIN = 3328;
constexpr int W_IN_COLS = 3088;
constexpr int NEXP = 32, TOPK = 4, DFF = 1024;
constexpr int PSLOTS = 139264;
constexpr float EPS = 1e-6f;
constexpr float LOG2E = 1.4426950408889634f;
constexpr float C2 = 0.125f * LOG2E;

constexpr size_t MiB = 1u << 20;
constexpr size_t WS_CTL = 0, CTL_ZERO_BYTES = 1 * MiB;
constexpr size_t WS_RWP = 1 * MiB;
constexpr size_t WS_TOPE = 2 * MiB, WS_TOPG = 3 * MiB, WS_RANK = 4 * MiB, WS_SLOTOF = 5 * MiB;
constexpr size_t WS_HIST = 6 * MiB;
constexpr size_t WS_TILEE = 6 * MiB + 65536;
constexpr size_t WS_BUFTOK = 7 * MiB, WS_GATESLOT = 8 * MiB;
constexpr size_t WS_DEC = 9 * MiB;
constexpr size_t WS_WIN = 10 * MiB;
constexpr size_t WS_WOUT = 17 * MiB;
constexpr size_t WS_WMIN = 20 * MiB;
constexpr size_t WS_WMOUT = 148 * MiB;
constexpr size_t WS_H2 = 212 * MiB;
constexpr size_t WS_Y = 276 * MiB;
constexpr size_t WS_H1 = 548 * MiB;
constexpr size_t WS_PROJ = 612 * MiB;
constexpr size_t WS_GATE = 804 * MiB;
constexpr size_t WS_US = 836 * MiB;
constexpr size_t WS_MIX = 900 * MiB;
constexpr size_t WS_ACT = 548 * MiB;
constexpr size_t WS_END = 964 * MiB;
static_assert(WS_Y + (size_t)PSLOTS * 1024 * 2 <= WS_H1 && WS_ACT + (size_t)PSLOTS * 1024 * 2 <= WS_US && WS_MIX + (size_t)NTOK * 1024 * 2 <= WS_END, "ws map");
static_assert(WS_WIN + (size_t)NIN * 1024 * 2 <= WS_WOUT && WS_WMIN + (size_t)32 * 2048 * 1024 * 2 <= WS_WMOUT && WS_WMOUT + (size_t)32 * 1024 * 1024 * 2 <= WS_H2, "ws map 2");

constexpr int CW_BAR = 4096;
constexpr int RING_BYTES = 131072, LDSCTL_OFF = RING_BYTES, MISC_OFF = LDSCTL_OFF + 320, LDS_BYTES = 147456;

#define GAS __attribute__((address_space(1)))
#define LAS __attribute__((address_space(3)))
typedef unsigned short bf16;
typedef unsigned v4u __attribute__((ext_vector_type(4)));
typedef unsigned v2u __attribute__((ext_vector_type(2)));
typedef float f32x4 __attribute__((ext_vector_type(4)));
typedef float f32x16 __attribute__((ext_vector_type(16)));
#define LDS_WAIT() asm volatile("s_waitcnt lgkmcnt(0)" ::: "memory")
__device__ __forceinline__ unsigned f2bf(float f) { unsigned u = __builtin_bit_cast(unsigned, f); return (u + 0x7fffu + ((u >> 16) & 1u)) >> 16; }
__device__ __forceinline__ unsigned pk2(float lo, float hi) { return f2bf(lo) | (f2bf(hi) << 16); }
__device__ __forceinline__ float bflo(unsigned w) { return __builtin_bit_cast(float, w << 16); }
__device__ __forceinline__ float bfhi(unsigned w) { return __builtin_bit_cast(float, w & 0xffff0000u); }

#define XB_TMO      128
#define XB_XCNT(j)  (256  + 64 * (j))
#define XB_XSUB(j)  (1280 + 64 * (j))
#define XB_XGEN(j)  (2304 + 64 * (j))
#define XB_TOP      3328
#define XB_TOPGEN   3392
#define XCD_BAR_WORDS 3456
#define XB_SPIN_CAP (1u << 18)
__device__ __forceinline__ unsigned xb_ld(unsigned* p)              { return __hip_atomic_load(p, __ATOMIC_RELAXED, __HIP_MEMORY_SCOPE_AGENT); }
__device__ __forceinline__ unsigned xb_add(unsigned* p, unsigned v) { return __hip_atomic_fetch_add(p, v, __ATOMIC_RELAXED, __HIP_MEMORY_SCOPE_AGENT); }
__device__ __forceinline__ unsigned xb_xcc_id() { return (unsigned)__builtin_amdgcn_s_getreg((3 << 11) | 20) & 0xFu; }
#define XB_SPIN(cond, bar) do { unsigned _sp = 0; while (cond) { __builtin_amdgcn_s_sleep(1); \
    if ((++_sp & 255u) == 0u) { if (xb_ld(&(bar)[XB_TMO])) break; if (_sp > XB_SPIN_CAP) { atomicAdd(&(bar)[XB_TMO], 1u); break; } } } } while (0)
struct XcdBarrier { unsigned* bar; unsigned x; volatile LAS unsigned* st; };
__device__ __forceinline__ XcdBarrier xcd_barrier_post(unsigned* bar, volatile LAS unsigned* st) {
    XcdBarrier b; b.bar = bar; b.x = xb_xcc_id(); b.st = st;
    if (threadIdx.x == 0) (void)xb_add(&bar[XB_XCNT(b.x)], 1u);
    return b;
}
__device__ __forceinline__ void xcd_barrier_complete(unsigned* bar, unsigned x, unsigned& nloc, unsigned& nx) {
    const unsigned G = gridDim.x * gridDim.y * gridDim.z;
    unsigned sum, cnt, mine, sp = 0u;
    for (;;) {
        sum = 0u; cnt = 0u; mine = 0u;
#pragma unroll
        for (unsigned j = 0; j < 16; ++j) { const unsigned c = xb_ld(&bar[XB_XCNT(j)]); sum += c; cnt += (c > 0u) ? 1u : 0u; mine = (j == x) ? c : mine; }
        if (sum == G) break;
        __builtin_amdgcn_s_sleep(1);
        if ((++sp & 255u) == 0u) { if (xb_ld(&bar[XB_TMO])) break; if (sp > XB_SPIN_CAP) { atomicAdd(&bar[XB_TMO], 1u); break; } }
    }
    nloc = mine > 0u ? mine : 1u; nx = cnt > 0u ? cnt : 1u;
}
__device__ __forceinline__ void xcd_barrier(const XcdBarrier& b) {
    asm volatile("s_waitcnt vmcnt(0)" ::: "memory");
    __syncthreads();
    if (threadIdx.x == 0) {
        unsigned* bar = b.bar;
        __builtin_amdgcn_s_waitcnt(0);
        unsigned nloc = b.st[0], nx = b.st[1];
        if (nloc == 0u) { xcd_barrier_complete(bar, b.x, nloc, nx); b.st[0] = nloc; b.st[1] = nx; }
        const unsigned old = xb_add(&bar[XB_XSUB(b.x)], 1u);
        const unsigned gen = old / nloc;
        if (old + 1u == (gen + 1u) * nloc) {
            __builtin_amdgcn_fence(__ATOMIC_RELEASE, "agent");
            asm volatile("s_waitcnt vmcnt(0)" ::: "memory");
            const unsigned og = xb_add(&bar[XB_TOP], 1u);
            const unsigned tg = og / nx;
            if (og + 1u == (tg + 1u) * nx) xb_add(&bar[XB_TOPGEN], 1u);
            else XB_SPIN(xb_ld(&bar[XB_TOPGEN]) == tg, bar);
            __builtin_amdgcn_fence(__ATOMIC_ACQUIRE, "agent");
            xb_add(&bar[XB_XGEN(b.x)], 1u);
            asm volatile("s_waitcnt vmcnt(0)" ::: "memory");
        } else {
            XB_SPIN(xb_ld(&bar[XB_XGEN(b.x)]) == gen, bar);
            __builtin_amdgcn_fence(__ATOMIC_ACQUIRE, "agent");
            asm volatile("s_waitcnt vmcnt(0)" ::: "memory");
        }
    }
    __syncthreads();
}

using pg8::Unit; using pg8::cvt_pk_bf16;
struct EpiProj {
    static constexpr bool PERM = true;
    bf16* P; float* G; const float* gbias;
    __device__ __forceinline__ void operator()(const f32x4 (&acc)[2][2][4][2], const Unit& u, int wr, int wc, int fr, int fq) const {
        const int row0 = u.pm * 256 + wr * 64 + fr;
        if (u.pn < 12) {
            const int col0 = u.pn * 256 + wc * 32 + 8 * fq;
#pragma unroll
            for (int ai = 0; ai < 2; ++ai)
#pragma unroll
                for (int m = 0; m < 4; ++m) { bf16* rowp = P + (size_t)(row0 + ai * 128 + m * 16) * PW + col0;
#pragma unroll
                    for (int bj = 0; bj < 2; ++bj) { const f32x4 v0 = acc[ai][bj][m][0], v1 = acc[ai][bj][m][1];
                        v4u w; w.x = cvt_pk_bf16(v0[0], v0[1]); w.y = cvt_pk_bf16(v0[2], v0[3]); w.z = cvt_pk_bf16(v1[0], v1[1]); w.w = cvt_pk_bf16(v1[2], v1[3]);
                        *(v4u*)(rowp + bj * 128) = w; } }
        } else {
            const int col0 = wc * 32 + 8 * fq;
            f32x4 bv[2][2];
#pragma unroll
            for (int bj = 0; bj < 2; ++bj)
#pragma unroll
                for (int n = 0; n < 2; ++n) bv[bj][n] = *(const f32x4*)(gbias + col0 + bj * 128 + 4 * n);
#pragma unroll
            for (int ai = 0; ai < 2; ++ai)
#pragma unroll
                for (int m = 0; m < 4; ++m) { float* rowp = G + (size_t)(row0 + ai * 128 + m * 16) * 256 + col0;
#pragma unroll
                    for (int bj = 0; bj < 2; ++bj)
#pragma unroll
                        for (int n = 0; n < 2; ++n) { const f32x4 z = acc[ai][bj][m][n] + bv[bj][n]; f32x4 o;
#pragma unroll
                            for (int i = 0; i < 4; ++i) { const float zz = z[i]; const float t = __logf(1.f + __expf(-fabsf(zz))); o[i] = (fminf(zz, 0.f) - t) * (1.f / 16.f); }
                            *(f32x4*)(rowp + bj * 128 + 4 * n) = o; } }
        }
    }
};
struct EpiResid {
    static constexpr bool PERM = false;
    const float* X; float* O;
    __device__ __forceinline__ void operator()(const f32x4 (&acc)[2][2][4][2], const Unit& u, int wr, int wc, int fr, int fq) const {
        const int row0 = u.pm * 256 + wr * 64 + fr, col0 = u.pn * 256 + wc * 32 + 4 * fq;
#pragma unroll
        for (int ai = 0; ai < 2; ++ai)
#pragma unroll
            for (int m = 0; m < 4; ++m) { const size_t off = (size_t)(row0 + ai * 128 + m * 16) * DM + col0;
#pragma unroll
                for (int bj = 0; bj < 2; ++bj)
#pragma unroll
                    for (int n = 0; n < 2; ++n) { const f32x4 xv = *(const f32x4*)(X + off + bj * 128 + n * 16); *(f32x4*)(O + off + bj * 128 + n * 16) = acc[ai][bj][m][n] + xv; } }
    }
};
struct EpiSwiglu {
    static constexpr bool PERM = true;
    bf16* ACT; const float* bin;
    __device__ __forceinline__ void operator()(const f32x4 (&acc)[2][2][4][2], const Unit& u, int wr, int wc, int fr, int fq) const {
        const int row0 = u.pm * 256 + wr * 64 + fr, f0 = u.pn * 128 + wc * 32 + 8 * fq;
        const float* bg = bin + (size_t)u.e * 2048 + f0; const float* bl = bg + 1024;
        f32x4 bgv[2], blv[2];
#pragma unroll
        for (int n = 0; n < 2; ++n) { bgv[n] = *(const f32x4*)(bg + 4 * n); blv[n] = *(const f32x4*)(bl + 4 * n); }
#pragma unroll
        for (int ai = 0; ai < 2; ++ai)
#pragma unroll
            for (int m = 0; m < 4; ++m) { float a[8];
#pragma unroll
                for (int n = 0; n < 2; ++n) { const f32x4 gl = acc[ai][0][m][n] + bgv[n], li = acc[ai][1][m][n] + blv[n];
#pragma unroll
                    for (int i = 0; i < 4; ++i) { const float gg = fminf(gl[i], 7.f), ll = fminf(fmaxf(li[i], -7.f), 7.f);
                        const float sg = __builtin_amdgcn_rcpf(1.f + __builtin_amdgcn_exp2f(-1.702f * LOG2E * gg)); a[4 * n + i] = gg * sg * (ll + 1.f); } }
                v4u w; w.x = cvt_pk_bf16(a[0], a[1]); w.y = cvt_pk_bf16(a[2], a[3]); w.z = cvt_pk_bf16(a[4], a[5]); w.w = cvt_pk_bf16(a[6], a[7]);
                *(v4u*)(ACT + (size_t)(row0 + ai * 128 + m * 16) * 1024 + f0) = w; }
    }
};
struct EpiY {
    static constexpr bool PERM = true;
    bf16* Y; const float* bout; const float* gslot;
    __device__ __forceinline__ void operator()(const f32x4 (&acc)[2][2][4][2], const Unit& u, int wr, int wc, int fr, int fq) const {
        const int row0 = u.pm * 256 + wr * 64 + fr, col0 = u.pn * 256 + wc * 32 + 8 * fq;
        const float* bb = bout + (size_t)u.e * 1024 + col0;
        f32x4 bv[2][2];
#pragma unroll
        for (int bj = 0; bj < 2; ++bj)
#pragma unroll
            for (int n = 0; n < 2; ++n) bv[bj][n] = *(const f32x4*)(bb + bj * 128 + 4 * n);
#pragma unroll
        for (int ai = 0; ai < 2; ++ai)
#pragma unroll
            for (int m = 0; m < 4; ++m) { const int row = row0 + ai * 128 + m * 16; const float gt = gslot[row]; bf16* rowp = Y + (size_t)row * 1024 + col0;
#pragma unroll
                for (int bj = 0; bj < 2; ++bj) { const f32x4 v0 = (acc[ai][bj][m][0] + bv[bj][0]) * gt, v1 = (acc[ai][bj][m][1] + bv[bj][1]) * gt;
                    v4u w; w.x = cvt_pk_bf16(v0[0], v0[1]); w.y = cvt_pk_bf16(v0[2], v0[3]); w.z = cvt_pk_bf16(v1[0], v1[1]); w.w = cvt_pk_bf16(v1[2], v1[3]);
                    *(v4u*)(rowp + bj * 128) = w; } }
    }
};

__device__ __forceinline__ float wave_sum(float v) {
#pragma unroll
    for (int o = 1; o < 64; o <<= 1) v += __shfl_xor(v, o);
    return v;
}
__device__ __forceinline__ void p0_transpose_item(const float* W, int Nsrc, bf16* WT, int Kp, int k0, int ns0, int nd0, LAS float* scr, int lane) {
#pragma unroll 8
    for (int i = 0; i < 32; ++i) { const int kk = 2 * i + (lane >> 5); scr[kk * 33 + (lane & 31)] = W[(size_t)(k0 + kk) * Nsrc + ns0 + (lane & 31)]; }
    LDS_WAIT(); asm volatile("" ::: "memory");
    const int c = lane & 7;
#pragma unroll
    for (int j = 0; j < 4; ++j) { const int n = (lane >> 3) + 8 * j; const LAS float* s = scr + (8 * c) * 33 + n;
        v4u o; o.x = pk2(s[0 * 33], s[1 * 33]); o.y = pk2(s[2 * 33], s[3 * 33]); o.z = pk2(s[4 * 33], s[5 * 33]); o.w = pk2(s[6 * 33], s[7 * 33]);
        *(v4u*)(WT + (size_t)(nd0 + n) * Kp + k0 + 8 * c) = o; }
    LDS_WAIT(); asm volatile("" ::: "memory");
}

struct Args { const float* in[17]; float* out; unsigned char* ws; int ph_lo, ph_hi, li, pad; };
constexpr int NPHASE = 11;

__global__ void __launch_bounds__(NTHR, 2) fwd(Args args) {
    extern __shared__ __attribute__((aligned(16))) unsigned char lds_raw[];
    LAS unsigned char* lds = (LAS unsigned char*)lds_raw;
    LAS float* ldsf = (LAS float*)lds_raw;
    volatile LAS unsigned* MISC = (volatile LAS unsigned*)(lds + MISC_OFF);
    const int tid = threadIdx.x, lane = tid & 63, wave = __builtin_amdgcn_readfirstlane(tid >> 6);
    const int G = gridDim.x, bx = blockIdx.x;
    unsigned char* ws = args.ws;
    unsigned* ctl = (unsigned*)(ws + WS_CTL);
    const float* x = args.in[0]; const float* g1 = args.in[1]; const float* w_in = args.in[2]; const float* gate_up = args.in[3]; const float* gate_bias = args.in[4];
    const float* gla_ng = args.in[5]; const float* qng = args.in[6]; const float* kng = args.in[7]; const float* rel_bias = args.in[8]; const float* w_out = args.in[9];
    const float* g2 = args.in[10]; const float* router_w = args.in[11]; const float* router_b = args.in[12]; const float* moe_w_in = args.in[13]; const float* moe_b_in = args.in[14];
    const float* moe_w_out = args.in[15]; const float* moe_b_out = args.in[16];
    float* out = args.out;
    float* RWP = (float*)(ws + WS_RWP); int* TOPE = (int*)(ws + WS_TOPE); float* TOPG = (float*)(ws + WS_TOPG); int* RANK = (int*)(ws + WS_RANK); int* SLOTOF = (int*)(ws + WS_SLOTOF);
    int* HIST = (int*)(ws + WS_HIST); int* TILEE = (int*)(ws + WS_TILEE); int* BUFTOK = (int*)(ws + WS_BUFTOK); float* GATESLOT = (float*)(ws + WS_GATESLOT); float* DEC = (float*)(ws + WS_DEC);
    bf16* WIN = (bf16*)(ws + WS_WIN); bf16* WOUT = (bf16*)(ws + WS_WOUT); bf16* WMIN = (bf16*)(ws + WS_WMIN); bf16* WMOUT = (bf16*)(ws + WS_WMOUT);
    bf16* H2 = (bf16*)(ws + WS_H2); bf16* YB = (bf16*)(ws + WS_Y); bf16* H1 = (bf16*)(ws + WS_H1); bf16* PROJ = (bf16*)(ws + WS_PROJ); float* GATE = (float*)(ws + WS_GATE);
    float* US = (float*)(ws + WS_US); bf16* MIX = (bf16*)(ws + WS_MIX); bf16* ACT = (bf16*)(ws + WS_ACT);

    for (int u = tid; u < (LDS_BYTES - LDSCTL_OFF) / 4; u += NTHR) ((LAS unsigned*)(lds + LDSCTL_OFF))[u] = 0u;
    __syncthreads();
    XcdBarrier bar; bar.bar = ctl + CW_BAR; bar.x = 0; bar.st = nullptr;
#if MK_ONE_LAUNCH
    bar = xcd_barrier_post(ctl + CW_BAR, MISC + 8);
#define GRID_BAR() xcd_barrier(bar)
#else
#define GRID_BAR() do { } while (0)
#endif
    const int lo = args.ph_lo, hi = args.ph_hi;
#define IN(k) (lo <= (k) && (k) < hi)
#define BOTH(k) (IN(k) && IN((k) + 1))
    const int gw = bx * NWAVES + wave, NGW = G * NWAVES;
    const int gthr = bx * NTHR + tid, NGT = G * NTHR;

    if (IN(0)) {
        LAS float* scr = (LAS float*)(lds + wave * 16384);
        constexpr int I_IN = 16 * 96, I_OUT = 16 * 32, I_MIN = 32 * 16 * 64, I_MOUT = 32 * 16 * 32, NITEMS = I_IN + I_OUT + I_MIN + I_MOUT;
        for (int it = gw; it < NITEMS; it += NGW) {
            int r = it;
            if (r < I_MIN) { const int e = r / 1024, q = r % 1024, kb = q / 64, nb = q % 64, ns0 = 32 * nb, f = ns0 & 1023, nd0 = 256 * (f >> 7) + ((ns0 >= 1024) ? 128 : 0) + (f & 127);
                p0_transpose_item(moe_w_in + (size_t)e * 1024 * 2048, 2048, WMIN + (size_t)e * 2048 * 1024, 1024, 64 * kb, ns0, nd0, scr, lane); continue; } r -= I_MIN;
            if (r < I_MOUT) { const int e = r / 512, q = r % 512, kb = q / 32, nb = q % 32;
                p0_transpose_item(moe_w_out + (size_t)e * 1024 * 1024, 1024, WMOUT + (size_t)e * 1024 * 1024, 1024, 64 * kb, 32 * nb, 32 * nb, scr, lane); continue; } r -= I_MOUT;
            if (r < I_IN) { const int kb = r / 96, nb = r % 96, nd0 = 32 * nb, ns0 = nd0 < 1024 ? nd0 : nd0 + 16;
                p0_transpose_item(w_in, W_IN_COLS, WIN, 1024, 64 * kb, ns0, nd0, scr, lane); continue; } r -= I_IN;
            { const int kb = r / 32, nb = r % 32; p0_transpose_item(w_out, 1024, WOUT, 1024, 64 * kb, 32 * nb, 32 * nb, scr, lane); }
        }
        for (int idx = gthr; idx < 256 * 1024; idx += NGT) { const int j = idx >> 10, d = idx & 1023; const float* wr_ = w_in + (size_t)d * W_IN_COLS + 1024; float s = 0.f;
#pragma unroll
            for (int r = 0; r < 16; ++r) s += wr_[r] * gate_up[r * 256 + j];
            WIN[(size_t)(3072 + j) * 1024 + d] = (bf16)f2bf(s); }
        for (int idx = gthr; idx < 1024 * 32; idx += NGT) RWP[idx] = router_w[idx] * g2[idx >> 5];
        for (int m = gw; m < NTOK; m += NGW) {
            const f32x4* xr = (const f32x4*)(x + (size_t)m * DM) + lane; const f32x4* gr = (const f32x4*)g1 + lane;
            f32x4 v[4]; float s = 0.f;
#pragma unroll
            for (int j = 0; j < 4; ++j) { v[j] = xr[64 * j]; s += (v[j].x * v[j].x + v[j].y * v[j].y) + (v[j].z * v[j].z + v[j].w * v[j].w); }
            const float r = 1.f / sqrtf(wave_sum(s) * (1.f / DM) + EPS);
            unsigned long long* o8 = (unsigned long long*)(H1 + (size_t)m * DM) + lane;
#pragma unroll
            for (int j = 0; j < 4; ++j) { const f32x4 gg = gr[64 * j]; o8[64 * j] = (unsigned long long)pk2(v[j].x * r * gg.x, v[j].y * r * gg.y) | ((unsigned long long)pk2(v[j].z * r * gg.z, v[j].w * r * gg.w) << 32); }
        }
        if (BOTH(0)) GRID_BAR();
    }

    if (IN(1)) {
        pg8::Gemm g{H1, WIN, 1024, nullptr}; pg8::StaticOrder S; S.init(NTOK / 256, NIN / 256, G, bx);
        EpiProj E{PROJ, GATE, gate_bias};
        pg8::gemm_phase<EpiProj, pg8::StaticOrder, true, false>(lds, g, S, E);
        if (BOTH(1)) GRID_BAR();
    }

    if (IN(2)) {
        LAS float* cum = ldsf;
        LAS float* kd = ldsf + 4096;
        LAS float* vs = ldsf + 8192;
        LAS float* segs = ldsf + 16384;
        LAS float* tot = ldsf + 16384 + 512;
        for (int un = bx; un < NCHT * 4; un += G) {
            const int chunk = un >> 2, h = un & 3; const size_t tok0 = (size_t)chunk * 64;
#pragma unroll
            for (int j = 0; j < 8; ++j) { const int idx = tid + 512 * j, c = idx >> 6, k = idx & 63; cum[idx] = GATE[(tok0 + c) * 256 + h * 64 + k]; }
            __syncthreads();
            { const int seg = tid >> 6, k = tid & 63; float run = 0.f;
#pragma unroll
              for (int i = 0; i < 8; ++i) { run += cum[(seg * 8 + i) * 64 + k]; cum[(seg * 8 + i) * 64 + k] = run; }
              segs[seg * 64 + k] = run; }
            __syncthreads();
            { const int seg = tid >> 6, k = tid & 63; float off = 0.f;
              for (int s = 0; s < seg; ++s) off += segs[s * 64 + k];
#pragma unroll
              for (int i = 0; i < 8; ++i) cum[(seg * 8 + i) * 64 + k] += off;
              if (seg == 7) tot[k] = off + segs[7 * 64 + k]; }
            __syncthreads();
#pragma unroll
            for (int j = 0; j < 2; ++j) { const int idx4 = tid + 512 * j, c = idx4 >> 4, k4 = (idx4 & 15) * 4;
                const v2u kw = *(const v2u*)(PROJ + (tok0 + c) * PW + C_GK + h * 64 + k4);
                const float kv[4] = {bflo(kw.x), bfhi(kw.x), bflo(kw.y), bfhi(kw.y)};
#pragma unroll
                for (int i = 0; i < 4; ++i) kd[c * 64 + k4 + i] = kv[i] * __expf(tot[k4 + i] - cum[c * 64 + k4 + i]); }
#pragma unroll
            for (int j = 0; j < 4; ++j) { const int idx4 = tid + 512 * j, c = idx4 >> 5, v4 = (idx4 & 31) * 4;
                const v2u vw = *(const v2u*)(PROJ + (tok0 + c) * PW + C_GV + h * 128 + v4);
                *(LAS f32x4*)(vs + c * 128 + v4) = (f32x4){bflo(vw.x), bfhi(vw.x), bflo(vw.y), bfhi(vw.y)}; }
            if (tid < 64) DEC[(size_t)chunk * 256 + h * 64 + tid] = __expf(tot[tid]);
            __syncthreads();
            { const int v0 = (tid >> 4) * 4, k0 = (tid & 15) * 4; f32x4 a0 = {0, 0, 0, 0}, a1 = a0, a2 = a0, a3 = a0;
#pragma unroll 8
              for (int c = 0; c < 64; ++c) { const f32x4 vv = *(const LAS f32x4*)(vs + c * 128 + v0), kk = *(const LAS f32x4*)(kd + c * 64 + k0);
                  a0 += kk * vv.x; a1 += kk * vv.y; a2 += kk * vv.z; a3 += kk * vv.w; }
              float* up = US + ((size_t)un * 128 + v0) * 64 + k0;
              *(f32x4*)(up) = a0; *(f32x4*)(up + 64) = a1; *(f32x4*)(up + 128) = a2; *(f32x4*)(up + 192) = a3; }
            __syncthreads();
        }
        for (int m = gw; m < NTOK; m += NGW) {
            bf16* p = PROJ + (size_t)m * PW + C_AQ + 16 * lane;
            const v4u w0 = *(const v4u*)p, w1 = *(const v4u*)(p + 8);
            float v[16] = {bflo(w0.x), bfhi(w0.x), bflo(w0.y), bfhi(w0.y), bflo(w0.z), bfhi(w0.z), bflo(w0.w), bfhi(w0.w), bflo(w1.x), bfhi(w1.x), bflo(w1.y), bfhi(w1.y), bflo(w1.z), bfhi(w1.z), bflo(w1.w), bfhi(w1.w)};
            float s = 0.f;
#pragma unroll
            for (int i = 0; i < 16; ++i) s += v[i] * v[i];
            s += __shfl_xor(s, 1); s += __shfl_xor(s, 2);
            const float r = 1.f / sqrtf(s * (1.f / 64.f) + EPS);
            const int d0 = (16 * lane) & 63;
#pragma unroll
            for (int i = 0; i < 16; ++i) { const float sc = (lane < 32) ? r * qng[d0 + i] * kng[d0 + i] * C2 : r; v[i] *= sc; }
            v4u o0, o1; o0.x = pk2(v[0], v[1]); o0.y = pk2(v[2], v[3]); o0.z = pk2(v[4], v[5]); o0.w = pk2(v[6], v[7]); o1.x = pk2(v[8], v[9]); o1.y = pk2(v[10], v[11]); o1.z = pk2(v[12], v[13]); o1.w = pk2(v[14], v[15]);
            *(v4u*)p = o0; *(v4u*)(p + 8) = o1;
        }
        if (BOTH(2)) GRID_BAR();
    }

    if (IN(3)) {
        for (int e = gthr; e < 65536; e += NGT) {
            const int b = e >> 15, idx = e & 32767, hk = ((idx >> 13) << 6) + (idx & 63);
            float* up = US + (size_t)b * 256 * 32768 + idx; const float* dp = DEC + (size_t)b * 256 * 256 + hk;
            float s = 0.f;
            for (int n = 0; n < 256; n += 8) { float uu[8], dd[8];
#pragma unroll
                for (int i = 0; i < 8; ++i) { uu[i] = up[(size_t)(n + i) * 32768]; dd[i] = dp[(size_t)(n + i) * 256]; }
#pragma unroll
                for (int i = 0; i < 8; ++i) { s = dd[i] * s + uu[i]; up[(size_t)(n + i) * 32768] = s; } }
        }
        LAS float* Ks = ldsf;
        LAS float* Vs = ldsf + 64 * 68;
        LAS float* Ps = Vs + 64 * 64;
        LAS float* bT = Ps + 64 * 68;
        for (int un = bx; un < NCHT * 8; un += G) {
            const int h = un & 7, chunk = un >> 3, b = chunk >> 8, n = chunk & 255; const size_t tok0 = (size_t)chunk * 64, btok0 = (size_t)b * SEQ;
            const int qi = tid >> 3, kg = tid & 7;
            for (int i = tid; i < 513; i += NTHR) bT[i] = rel_bias[h * 513 + i] * LOG2E;
            float q[64];
            { const bf16* qp = PROJ + (tok0 + qi) * PW + C_AQ + h * 64;
#pragma unroll
              for (int j = 0; j < 8; ++j) { const v4u w = *(const v4u*)(qp + 8 * j); q[8 * j] = bflo(w.x); q[8 * j + 1] = bfhi(w.x); q[8 * j + 2] = bflo(w.y); q[8 * j + 3] = bfhi(w.y); q[8 * j + 4] = bflo(w.z); q[8 * j + 5] = bfhi(w.z); q[8 * j + 6] = bflo(w.w); q[8 * j + 7] = bfhi(w.w); } }
            float mrun = -1e30f, lsum = 0.f, o[8];
#pragma unroll
            for (int i = 0; i < 8; ++i) o[i] = 0.f;
            const int jc0 = n >= 8 ? n - 8 : 0;
            for (int jc = jc0; jc <= n; ++jc) {
                __syncthreads();
                { const int key = tid >> 3, d8 = (tid & 7) * 8; const size_t kr = (btok0 + (size_t)jc * 64 + key) * PW + h * 64 + d8;
                  const v4u kw = *(const v4u*)(PROJ + kr + C_AK), vw = *(const v4u*)(PROJ + kr + C_AV);
                  *(LAS f32x4*)(Ks + key * 68 + d8) = (f32x4){bflo(kw.x), bfhi(kw.x), bflo(kw.y), bfhi(kw.y)}; *(LAS f32x4*)(Ks + key * 68 + d8 + 4) = (f32x4){bflo(kw.z), bfhi(kw.z), bflo(kw.w), bfhi(kw.w)};
                  *(LAS f32x4*)(Vs + key * 64 + d8) = (f32x4){bflo(vw.x), bfhi(vw.x), bflo(vw.y), bfhi(vw.y)}; *(LAS f32x4*)(Vs + key * 64 + d8 + 4) = (f32x4){bflo(vw.z), bfhi(vw.z), bflo(vw.w), bfhi(vw.w)}; }
                __syncthreads();
                float s[8]; float mt = -1e30f;
#pragma unroll
                for (int j = 0; j < 8; ++j) { const int key = kg + 8 * j; float a = 0.f;
#pragma unroll
                    for (int d = 0; d < 64; d += 4) { const f32x4 kk = *(const LAS f32x4*)(Ks + key * 68 + d); a += q[d] * kk.x + q[d + 1] * kk.y + q[d + 2] * kk.z + q[d + 3] * kk.w; }
                    int rel = 64 * (n - jc) + qi - key; rel = rel > 256 ? 256 : rel; a += bT[rel + 256]; s[j] = a; mt = fmaxf(mt, a); }
                mt = fmaxf(mt, __shfl_xor(mt, 1)); mt = fmaxf(mt, __shfl_xor(mt, 2)); mt = fmaxf(mt, __shfl_xor(mt, 4));
                const float mnew = fmaxf(mrun, mt), sc = __builtin_amdgcn_exp2f(mrun - mnew); mrun = mnew; lsum *= sc;
#pragma unroll
                for (int i = 0; i < 8; ++i) o[i] *= sc;
#pragma unroll
                for (int j = 0; j < 8; ++j) { const float p = __builtin_amdgcn_exp2f(s[j] - mnew); lsum += p; Ps[qi * 68 + kg + 8 * j] = p; }
                __syncthreads();
#pragma unroll 4
                for (int key = 0; key < 64; key += 4) { const f32x4 pp = *(const LAS f32x4*)(Ps + qi * 68 + key);
#pragma unroll
                    for (int kk = 0; kk < 4; ++kk) { const f32x4 v0 = *(const LAS f32x4*)(Vs + (key + kk) * 64 + kg * 8), v1 = *(const LAS f32x4*)(Vs + (key + kk) * 64 + kg * 8 + 4); const float pv = pp[kk];
                        o[0] += pv * v0.x; o[1] += pv * v0.y; o[2] += pv * v0.z; o[3] += pv * v0.w; o[4] += pv * v1.x; o[5] += pv * v1.y; o[6] += pv * v1.z; o[7] += pv * v1.w; } }
            }
            lsum += __shfl_xor(lsum, 1); lsum += __shfl_xor(lsum, 2); lsum += __shfl_xor(lsum, 4);
            const float inv = 1.f / lsum;
            v4u w; w.x = pk2(o[0] * inv, o[1] * inv); w.y = pk2(o[2] * inv, o[3] * inv); w.z = pk2(o[4] * inv, o[5] * inv); w.w = pk2(o[6] * inv, o[7] * inv);
            *(v4u*)(MIX + (tok0 + qi) * DM + 512 + h * 64 + kg * 8) = w;
            __syncthreads();
        }
        if (BOTH(3)) GRID_BAR();
    }

    if (IN(4)) {
        LAS float* qT = ldsf;
        LAS float* ST = ldsf + 64 * 68;
        for (int un = bx; un < NCHT * 4; un += G) {
            const int chunk = un >> 2, h = un & 3; const size_t tok0 = (size_t)chunk * 64;
#pragma unroll
            for (int j = 0; j < 2; ++j) { const int idx4 = tid + 512 * j, c = idx4 >> 4, k4 = (idx4 & 15) * 4;
                const v2u qw = *(const v2u*)(PROJ + (tok0 + c) * PW + C_GQ + h * 64 + k4);
                qT[(k4 + 0) * 68 + c] = bflo(qw.x) * 0.125f; qT[(k4 + 1) * 68 + c] = bfhi(qw.x) * 0.125f; qT[(k4 + 2) * 68 + c] = bflo(qw.y) * 0.125f; qT[(k4 + 3) * 68 + c] = bfhi(qw.y) * 0.125f; }
#pragma unroll
            for (int j = 0; j < 4; ++j) { const int idx4 = tid + 512 * j, v = idx4 >> 4, k4 = (idx4 & 15) * 4;
                const f32x4 sv = *(const f32x4*)(US + ((size_t)un * 128 + v) * 64 + k4);
                ST[(k4 + 0) * 132 + v] = sv.x; ST[(k4 + 1) * 132 + v] = sv.y; ST[(k4 + 2) * 132 + v] = sv.z; ST[(k4 + 3) * 132 + v] = sv.w; }
            __syncthreads();
            const int c0 = (tid >> 5) * 4, v0 = (tid & 31) * 4; f32x4 a[4]; a[0] = (f32x4){0, 0, 0, 0}; a[1] = a[0]; a[2] = a[0]; a[3] = a[0];
#pragma unroll 8
            for (int k = 0; k < 64; ++k) { const f32x4 qq = *(const LAS f32x4*)(qT + k * 68 + c0), ss = *(const LAS f32x4*)(ST + k * 132 + v0);
                a[0] += ss * qq.x; a[1] += ss * qq.y; a[2] += ss * qq.z; a[3] += ss * qq.w; }
            const f32x4 gn = *(const f32x4*)(gla_ng + v0);
#pragma unroll
            for (int i = 0; i < 4; ++i) { float ssq = (a[i].x * a[i].x + a[i].y * a[i].y) + (a[i].z * a[i].z + a[i].w * a[i].w);
                ssq += __shfl_xor(ssq, 1); ssq += __shfl_xor(ssq, 2); ssq += __shfl_xor(ssq, 4); ssq += __shfl_xor(ssq, 8); ssq += __shfl_xor(ssq, 16);
                const float r = 1.f / sqrtf(ssq * (1.f / 128.f) + EPS);
                const v2u gw_ = *(const v2u*)(PROJ + (tok0 + c0 + i) * PW + C_OG + h * 128 + v0);
                const float og[4] = {bflo(gw_.x), bfhi(gw_.x), bflo(gw_.y), bfhi(gw_.y)}; float ov[4];
#pragma unroll
                for (int j = 0; j < 4; ++j) { const float sg = og[j] / (1.f + __expf(-og[j])); ov[j] = a[i][j] * r * gn[j] * sg; }
                v2u w; w.x = pk2(ov[0], ov[1]); w.y = pk2(ov[2], ov[3]);
                *(v2u*)(MIX + (tok0 + c0 + i) * DM + h * 128 + v0) = w; }
            __syncthreads();
        }
        if (BOTH(4)) GRID_BAR();
    }

    if (IN(5)) {
        pg8::Gemm g{MIX, WOUT, 1024, nullptr}; pg8::StaticOrder S; S.init(NTOK / 256, 4, G, bx);
        EpiResid E{x, out};
        pg8::gemm_phase<EpiResid, pg8::StaticOrder, true, false>(lds, g, S, E);
        if (BOTH(5)) GRID_BAR();
    }

    if (IN(6)) {
        LAS float* rstd = ldsf;
        LAS int* lh = (LAS int*)(ldsf + 128);
        for (int blk = bx; blk < 256; blk += G) {
            const int t0 = blk * 128;
            if (tid < 32) lh[tid] = 0;
            f32x16 acc;
#pragma unroll
            for (int i = 0; i < 16; ++i) acc[i] = 0.f;
            if (wave >= 4) {
                const f32x4* gr = (const f32x4*)g2 + lane;
                for (int j = 0; j < 32; ++j) { const int tl = (wave - 4) * 32 + j; const size_t m = (size_t)t0 + tl;
                    const f32x4* xr = (const f32x4*)(out + m * DM) + lane; f32x4 v[4]; float s = 0.f;
#pragma unroll
                    for (int jj = 0; jj < 4; ++jj) { v[jj] = xr[64 * jj]; s += (v[jj].x * v[jj].x + v[jj].y * v[jj].y) + (v[jj].z * v[jj].z + v[jj].w * v[jj].w); }
                    const float r = 1.f / sqrtf(wave_sum(s) * (1.f / DM) + EPS);
                    unsigned long long* o8 = (unsigned long long*)(H2 + m * DM) + lane;
#pragma unroll
                    for (int jj = 0; jj < 4; ++jj) { const f32x4 gg = gr[64 * jj]; o8[64 * jj] = (unsigned long long)pk2(v[jj].x * r * gg.x, v[jj].y * r * gg.y) | ((unsigned long long)pk2(v[jj].z * r * gg.z, v[jj].w * r * gg.w) << 32); }
                    if (lane == 0) rstd[tl] = r; }
            } else {
                const int half = lane >> 5, l31 = lane & 31; const size_t m = (size_t)t0 + wave * 32 + l31;
                const float* xp = out + m * DM + 4 * half; const float* wp = RWP + (4 * half) * 32 + l31;
                for (int mm = 0; mm < 128; ++mm) { const f32x4 xv = *(const f32x4*)(xp + 8 * mm);
#pragma unroll
                    for (int i = 0; i < 4; ++i) { const float a = wp[(8 * mm + i) * 32]; acc = __builtin_amdgcn_mfma_f32_32x32x2f32(a, xv[i], acc, 0, 0, 0); } }
            }
            __syncthreads();
            if (wave < 4) {
                const int half = lane >> 5, l31 = lane & 31, tl = wave * 32 + l31; const float r = rstd[tl];
                float bv[4] = {-3e38f, -3e38f, -3e38f, -3e38f}; int bi[4] = {0, 0, 0, 0};
#pragma unroll
                for (int reg = 0; reg < 16; ++reg) { const int e = (reg & 3) + 8 * (reg >> 2) + 4 * half; float v = acc[reg] * r + router_b[e]; int id = e;
#pragma unroll
                    for (int s = 0; s < 4; ++s) { const bool gt = v > bv[s]; const float tv = gt ? bv[s] : v; const int ti = gt ? bi[s] : id; bv[s] = gt ? v : bv[s]; bi[s] = gt ? id : bi[s]; v = tv; id = ti; } }
                float ov[4]; int oi[4];
#pragma unroll
                for (int s = 0; s < 4; ++s) { ov[s] = __shfl_xor(bv[s], 32); oi[s] = __shfl_xor(bi[s], 32); }
#pragma unroll
                for (int c = 0; c < 4; ++c) { float v = ov[c]; int id = oi[c];
#pragma unroll
                    for (int s = 0; s < 4; ++s) { const bool gt = (v > bv[s]) || (v == bv[s] && id < bi[s]); const float tv = gt ? bv[s] : v; const int ti = gt ? bi[s] : id; bv[s] = gt ? v : bv[s]; bi[s] = gt ? id : bi[s]; v = tv; id = ti; } }
                if (half == 0) {
                    const float e1 = __expf(bv[1] - bv[0]), e2 = __expf(bv[2] - bv[0]), e3 = __expf(bv[3] - bv[0]); const float inv = 1.f / (1.f + e1 + e2 + e3);
                    const size_t m = (size_t)t0 + tl;
                    *(f32x4*)(TOPG + m * 4) = (f32x4){inv, e1 * inv, e2 * inv, e3 * inv};
                    int rk[4];
#pragma unroll
                    for (int s = 0; s < 4; ++s) rk[s] = atomicAdd((int*)&lh[bi[s]], 1);
                    *(v4u*)(TOPE + m * 4) = (v4u){(unsigned)bi[0], (unsigned)bi[1], (unsigned)bi[2], (unsigned)bi[3]};
                    *(v4u*)(RANK + m * 4) = (v4u){(unsigned)rk[0], (unsigned)rk[1], (unsigned)rk[2], (unsigned)rk[3]};
                }
            }
            __syncthreads();
            if (tid < 32) HIST[blk * 32 + tid] = lh[tid];
            __syncthreads();
        }
        if (BOTH(6)) GRID_BAR();
    }

    if (IN(7)) {
        LAS int* ptot = (LAS int*)ldsf;
        LAS int* pbase = ptot + 512;
        LAS int* tot = pbase + 512;
        LAS int* pstart = tot + 32;
        LAS int* sbase = pstart + 32;
        for (int blk = bx; blk < 256; blk += G) {
            { const int e = tid & 31, part = tid >> 5; int a = 0, b = 0;
              for (int i = 0; i < 16; ++i) { const int bb = part * 16 + i; const int hv = HIST[bb * 32 + e]; a += hv; b += (bb < blk) ? hv : 0; }
              ptot[part * 32 + e] = a; pbase[part * 32 + e] = b; }
            __syncthreads();
            if (tid < 32) { int a = 0, b = 0; for (int p = 0; p < 16; ++p) { a += ptot[p * 32 + tid]; b += pbase[p * 32 + tid]; } tot[tid] = a; sbase[tid] = b; }
            __syncthreads();
            if (tid < 32) { int ps = 0; for (int e = 0; e < tid; ++e) ps += (tot[e] + 255) & ~255; pstart[tid] = ps; sbase[tid] += ps; }
            __syncthreads();
            { const int tl = tid >> 2, k = tid & 3; const size_t m = (size_t)blk * 128 + tl; const int e = TOPE[m * 4 + k]; const int slot = sbase[e] + RANK[m * 4 + k];
              BUFTOK[slot] = (int)m; GATESLOT[slot] = TOPG[m * 4 + k]; SLOTOF[m * 4 + k] = slot; }
            if (blk < 32) { const int e = blk, ps = pstart[e], te = tot[e], pe = (te + 255) & ~255;
                if (tid < 256 && te + tid < pe) { BUFTOK[ps + te + tid] = 0; GATESLOT[ps + te + tid] = 0.f; }
                for (int t = tid; t < pe / 256; t += NTHR) TILEE[ps / 256 + t] = e;
                if (e == 31 && tid == 0) TILEE[1023] = (ps + pe) / 256; }
            __syncthreads();
        }
        if (BOTH(7)) GRID_BAR();
    }

    if (IN(8)) {
        const int nT = TILEE[1023];
        pg8::Gemm g{H2, WMIN, 1024, BUFTOK}; pg8::MoeOrder S; S.init(nT, 8, G, bx, TILEE);
        EpiSwiglu E{ACT, moe_b_in};
        pg8::gemm_phase<EpiSwiglu, pg8::MoeOrder, true, true>(lds, g, S, E);
        if (BOTH(8)) GRID_BAR();
    }

    if (IN(9)) {
        const int nT = TILEE[1023];
        pg8::Gemm g{ACT, WMOUT, 1024, nullptr}; pg8::MoeOrder S; S.init(nT, 4, G, bx, TILEE);
        EpiY E{YB, moe_b_out, GATESLOT};
        pg8::gemm_phase<EpiY, pg8::MoeOrder, true, false>(lds, g, S, E);
        if (BOTH(9)) GRID_BAR();
    }

    if (IN(10)) {
        for (int m = gw; m < NTOK; m += NGW) {
            const v4u sl = *(const v4u*)(SLOTOF + (size_t)m * 4);
            float* op = out + (size_t)m * DM;
#pragma unroll
            for (int j = 0; j < 2; ++j) { const int col = 8 * lane + 512 * j;
                f32x4 a0 = *(const f32x4*)(op + col), a1 = *(const f32x4*)(op + col + 4);
#pragma unroll
                for (int k = 0; k < 4; ++k) { const v4u w = *(const v4u*)(YB + (size_t)sl[k] * 1024 + col);
                    a0.x += bflo(w.x); a0.y += bfhi(w.x); a0.z += bflo(w.y); a0.w += bfhi(w.y); a1.x += bflo(w.z); a1.y += bfhi(w.z); a1.z += bflo(w.w); a1.w += bfhi(w.w); }
                *(f32x4*)(op + col) = a0; *(f32x4*)(op + col + 4) = a1; }
        }
    }
#undef IN
#undef BOTH
}

extern "C" void kernel_launch(void* const* d_in, const int* in_sizes, int n_in, void* d_out, int out_size, void* d_ws, size_t ws_size, hipStream_t stream) {
    static int grid = 0;
    if (grid == 0) {
        if (n_in != 17 || in_sizes[0] != NTOK * DM || out_size != NTOK * DM || ws_size < WS_END) { fprintf(stderr, "kernel_launch: unexpected shapes (n_in %d, in0 %d, out %d, ws %zu)\n", n_in, n_in > 0 ? in_sizes[0] : -1, out_size, ws_size); grid = -1; return; }
        int dev = 0, cus = 0, per_cu = 0;
        if (hipGetDevice(&dev) != hipSuccess || hipDeviceGetAttribute(&cus, hipDeviceAttributeMultiprocessorCount, dev) != hipSuccess) { grid = -1; return; }
        if (hipFuncSetAttribute((const void*)fwd, hipFuncAttributeMaxDynamicSharedMemorySize, LDS_BYTES) != hipSuccess) { fprintf(stderr, "kernel_launch: hipFuncSetAttribute failed\n"); grid = -1; return; }
        if (hipOccupancyMaxActiveBlocksPerMultiprocessor(&per_cu, (const void*)fwd, NTHR, LDS_BYTES) != hipSuccess || per_cu < 1) fprintf(stderr, "kernel_launch: occupancy query reports %d\n", per_cu);
        (void)hipGetLastError();
        grid = cus;
    }
    if (grid < 0) return;
    (void)hipMemsetAsync((char*)d_ws + WS_CTL, 0, CTL_ZERO_BYTES, stream);
    Args a{};
    for (int i = 0; i < 17; ++i) a.in[i] = (const float*)d_in[i];
    a.out = (float*)d_out; a.ws = (unsigned char*)d_ws; a.li = 0; a.pad = 0;
#if MK_ONE_LAUNCH
    a.ph_lo = 0; a.ph_hi = NPHASE;
    hipLaunchKernelGGL(fwd, dim3(grid), dim3(NTHR), LDS_BYTES, stream, a);
#else
    for (int p = 0; p < NPHASE; ++p) { a.ph_lo = p; a.ph_hi = p + 1; hipLaunchKernelGGL(fwd, dim3(grid), dim3(NTHR), LDS_BYTES, stream, a); }
#endif
}
```

```cpp
#include <hip/hip_runtime.h>
#include <cstdio>
#include <cstdint>

#ifndef MK_ONE_LAUNCH
#define MK_ONE_LAUNCH 1
#endif

namespace pg8 {
#define PG8_LAS __attribute__((address_space(3)))
typedef unsigned short bf16_t;
typedef short bf16x8 __attribute__((ext_vector_type(8)));
typedef float f32x4 __attribute__((ext_vector_type(4)));
typedef unsigned u32x4 __attribute__((ext_vector_type(4)));
constexpr int BM = 256, BK = 64, HALF = 128, HTB = HALF * BK * 2, STAGE_BYTES = 8 * HTB, NXCD = 8, WGM = 8;

__host__ __device__ __forceinline__ int lds_byte(int r, int c) { const int st = (r >> 4) * 2 + (c >> 5), rr = r & 15, cc = c & 31, ob = rr * 64 + cc * 2; return st * 1024 + (ob ^ (((ob >> 9) & 1) << 5)); }
__host__ __device__ __forceinline__ void stage_rc(int b, int& R, int& C) { const int st = b / 1024, sb = b % 1024, swz = sb ^ (((sb >> 9) & 1) << 5); R = (st >> 1) * 16 + swz / 64; C = (st & 1) * 32 + (swz % 64) / 2; }
__host__ __device__ __forceinline__ int perm32(int rho) { const int n = rho >> 4, i = rho & 15; return 8 * (i >> 2) + 4 * n + (i & 3); }

struct Unit { int pm, pn, pb, e; };
struct Gemm { const bf16_t* A; const bf16_t* Bt; int K; const int* rowtok; };

__device__ __forceinline__ bool tile_of(long L, int nM, int nN, int& pm, int& pn) {
    const int nwg = nM * nN; if (L >= nwg) return false;
    int wgid = (int)L; { const int q = nwg / NXCD, r = nwg % NXCD, xcd = wgid % NXCD, off = wgid / NXCD; wgid = (xcd < r ? xcd * (q + 1) : r * (q + 1) + (xcd - r) * q) + off; }
    const int nig = WGM * nN, gid = wgid / nig, fm = gid * WGM, gsz = (nM - fm) < WGM ? (nM - fm) : WGM;
    pm = fm + ((wgid % nig) % gsz); pn = (wgid % nig) / gsz; return true;
}
struct StaticOrder {
    int nM, nN, G, c;
    __device__ void init(int nM_, int nN_, int G_, int c_) { nM = nM_; nN = nN_; G = G_; c = c_; }
    __device__ __forceinline__ bool next(int i, Unit& u) const { if (!tile_of((long)i * G + c, nM, nN, u.pm, u.pn)) return false; u.pb = u.pn; u.e = 0; return true; }
};
struct MoeOrder {
    int nM, nN, G, c; const int* tile_e;
    __device__ void init(int nM_, int nN_, int G_, int c_, const int* te) { nM = nM_; nN = nN_; G = G_; c = c_; tile_e = te; }
    __device__ __forceinline__ bool next(int i, Unit& u) const { if (!tile_of((long)i * G + c, nM, nN, u.pm, u.pn)) return false; u.e = tile_e[u.pm]; u.pb = u.e * nN + u.pn; return true; }
};

__device__ __forceinline__ unsigned cvt_pk_bf16(float lo, float hi) { unsigned r; asm volatile("v_cvt_pk_bf16_f32 %0, %1, %2" : "=v"(r) : "v"(lo), "v"(hi)); return r; }

template <class Epi, class Sched, bool ALIGN_EPI, bool GATHER>
__device__ __forceinline__ void gemm_phase(PG8_LAS unsigned char* lds, const Gemm g, const Sched& S, const Epi& E) {
    const int tid = threadIdx.x, wid = __builtin_amdgcn_readfirstlane(tid >> 6), lane = tid & 63, wr = wid >> 2, wc = wid & 3, fr = lane & 15, fq = lane >> 4;
    const int K = g.K, nt = K / BK;
    const size_t kstep = (size_t)(BK * 2);
    const size_t hstep = (size_t)HALF * K * 2;
    const size_t tstep = 2 * hstep;
    int RA[2]; unsigned CA2[2], voffB[2];
#pragma unroll
    for (int i = 0; i < 2; ++i) { int R, C; stage_rc(tid * 16 + i * 8192, R, C); const int Rb = Epi::PERM ? ((R & ~31) + perm32(R & 31)) : R;
        RA[i] = R; CA2[i] = (unsigned)C * 2u; voffB[i] = (unsigned)(Rb * K + C) * 2u; }
    const unsigned ldsw = (unsigned)wid * 1024u;
    const int aoff = lds_byte(wr * 64 + fr, fq * 8), boff = lds_byte(wc * 32 + fr, fq * 8);
#define PG8_SA(b, h) (((b) * 2 + (h)) * HTB)
#define PG8_SB(b, h) ((4 + (b) * 2 + (h)) * HTB)
#define PG8_STAGE(bufoff, gbase, voff) do { _Pragma("unroll") for (int _i = 0; _i < 2; ++_i) \
        __builtin_amdgcn_global_load_lds((const unsigned*)((const char*)(gbase) + (voff)[_i]), (PG8_LAS unsigned*)(lds + (bufoff) + ldsw + _i * 8192), 16, 0, 0); } while (0)
#define PG8_LDA(dst, b, h) do { _Pragma("unroll") for (int m = 0; m < 4; ++m) _Pragma("unroll") for (int k = 0; k < 2; ++k) dst[m][k] = *(const PG8_LAS bf16x8*)(lds + PG8_SA(b, h) + aoff + m * 2048 + k * 1024); } while (0)
#define PG8_LDB(dst, b, h) do { _Pragma("unroll") for (int n = 0; n < 2; ++n) _Pragma("unroll") for (int k = 0; k < 2; ++k) dst[n][k] = *(const PG8_LAS bf16x8*)(lds + PG8_SB(b, h) + boff + n * 2048 + k * 1024); } while (0)
#define PG8_MMA(ai, bj, At, Bt) do { __builtin_amdgcn_s_setprio(1); _Pragma("unroll") for (int m = 0; m < 4; ++m) _Pragma("unroll") for (int n = 0; n < 2; ++n) _Pragma("unroll") for (int k = 0; k < 2; ++k) \
        acc[ai][bj][m][n] = __builtin_amdgcn_mfma_f32_16x16x32_bf16(Bt[n][k], At[m][k], acc[ai][bj][m][n], 0, 0, 0); __builtin_amdgcn_s_setprio(0); } while (0)
#define PG8_WAIT_V(n) asm volatile("s_waitcnt vmcnt(" #n ")" ::: "memory")
#define PG8_WAIT_L(n) asm volatile("s_waitcnt lgkmcnt(" #n ")" ::: "memory")
#define PG8_BAR __builtin_amdgcn_s_barrier()
#define PG8_SCHED __builtin_amdgcn_sched_barrier(0)
#define PG8_AOFF(dst, u) do { _Pragma("unroll") for (int h_ = 0; h_ < 2; ++h_) _Pragma("unroll") for (int i_ = 0; i_ < 2; ++i_) { \
        if constexpr (GATHER) { const int tok_ = g.rowtok[(u).pm * BM + h_ * HALF + RA[i_]]; dst[h_][i_] = (unsigned)tok_ * (unsigned)(K * 2) + CA2[i_]; } \
        else { dst[h_][i_] = (unsigned)(RA[i_] * K) * 2u + CA2[i_] + (unsigned)(h_ * (int)hstep); } } } while (0)
#define PG8_ABASE(u) ((const char*)g.A + (GATHER ? (size_t)0 : (size_t)(u).pm * tstep))
    Unit cur, nxt; int ui = 0;
    if (!S.next(0, cur)) return;
    f32x4 acc[2][2][4][2];
#pragma unroll
    for (int a = 0; a < 2; ++a)
#pragma unroll
        for (int b = 0; b < 2; ++b)
#pragma unroll
            for (int m = 0; m < 4; ++m)
#pragma unroll
                for (int n = 0; n < 2; ++n) acc[a][b][m][n] = (f32x4){0.f, 0.f, 0.f, 0.f};
    bf16x8 At[4][2], B0[2][2], B1[2][2];
    unsigned vA[2][2], nvA[2][2];
    PG8_AOFF(vA, cur);
#pragma unroll
    for (int h_ = 0; h_ < 2; ++h_) { nvA[h_][0] = vA[h_][0]; nvA[h_][1] = vA[h_][1]; }
    const char* cA = PG8_ABASE(cur); const char* cB = (const char*)g.Bt + (size_t)cur.pb * tstep;
    PG8_STAGE(PG8_SB(0, 0), cB, voffB); PG8_STAGE(PG8_SB(0, 1), cB + hstep, voffB); PG8_STAGE(PG8_SA(0, 0), cA, vA[0]); PG8_STAGE(PG8_SA(0, 1), cA, vA[1]);
    if (wr == 1) PG8_BAR;
    PG8_WAIT_V(2); PG8_BAR;
    PG8_STAGE(PG8_SB(1, 0), cB + kstep, voffB); PG8_STAGE(PG8_SA(1, 0), cA + kstep, vA[0]); PG8_STAGE(PG8_SB(1, 1), cB + hstep + kstep, voffB);
    PG8_WAIT_V(6); PG8_BAR;
    for (;;) {
        const bool has_next = S.next(ui + 1, nxt);
        if constexpr (GATHER) { if (has_next) { PG8_AOFF(nvA, nxt); } }
        const char* nA = has_next ? PG8_ABASE(nxt) : cA; const char* nB = has_next ? (const char*)g.Bt + (size_t)nxt.pb * tstep : cB;
        for (int t = 0; t < nt; t += 2) {
            const bool last = (t == nt - 2);
            const char* a1 = cA + (size_t)(t + 1) * kstep;
            const char* a2 = last ? nA : cA + (size_t)(t + 2) * kstep; const char* b2 = last ? nB : cB + (size_t)(t + 2) * kstep;
            const char* a3 = a2 + kstep; const char* b3 = b2 + kstep;
            unsigned sA[2][2];
#pragma unroll
            for (int h_ = 0; h_ < 2; ++h_)
#pragma unroll
                for (int i_ = 0; i_ < 2; ++i_) sA[h_][i_] = (GATHER && last && has_next) ? nvA[h_][i_] : vA[h_][i_];
            PG8_LDB(B0, 0, 0); PG8_LDB(B1, 0, 1); PG8_SCHED; PG8_LDA(At, 0, 0); PG8_STAGE(PG8_SA(1, 1), a1, vA[1]);
            PG8_WAIT_V(8); PG8_WAIT_L(0); PG8_BAR; PG8_MMA(0, 0, At, B0); PG8_MMA(0, 1, At, B1); PG8_BAR; PG8_SCHED;
            PG8_LDA(At, 0, 1); PG8_STAGE(PG8_SB(0, 0), b2, voffB); PG8_STAGE(PG8_SB(0, 1), b2 + hstep, voffB); PG8_STAGE(PG8_SA(0, 0), a2, sA[0]);
            PG8_WAIT_V(8); PG8_WAIT_L(0); PG8_BAR; PG8_MMA(1, 0, At, B0); PG8_MMA(1, 1, At, B1); PG8_BAR; PG8_SCHED;
            PG8_LDB(B0, 1, 0); PG8_LDB(B1, 1, 1); PG8_SCHED; PG8_LDA(At, 1, 0); PG8_STAGE(PG8_SA(0, 1), a2, sA[1]);
            PG8_WAIT_V(8); PG8_WAIT_L(0); PG8_BAR; PG8_MMA(0, 0, At, B0); PG8_MMA(0, 1, At, B1); PG8_BAR; PG8_SCHED;
            PG8_LDA(At, 1, 1); PG8_STAGE(PG8_SB(1, 0), b3, voffB); PG8_STAGE(PG8_SB(1, 1), b3 + hstep, voffB); PG8_STAGE(PG8_SA(1, 0), a3, sA[0]);
            PG8_WAIT_V(8); PG8_WAIT_L(0); PG8_BAR; PG8_MMA(1, 0, At, B0); PG8_MMA(1, 1, At, B1); PG8_BAR; PG8_SCHED;
        }
        if constexpr (ALIGN_EPI) { if (wr == 0) PG8_BAR; }
        E(acc, cur, wr, wc, fr, fq);
        if (!has_next) break;
#pragma unroll
        for (int a = 0; a < 2; ++a)
#pragma unroll
            for (int b = 0; b < 2; ++b)
#pragma unroll
                for (int m = 0; m < 4; ++m)
#pragma unroll
                    for (int n = 0; n < 2; ++n) acc[a][b][m][n] = (f32x4){0.f, 0.f, 0.f, 0.f};
        cur = nxt; cA = nA; cB = nB; ++ui;
        if constexpr (GATHER) {
#pragma unroll
            for (int h_ = 0; h_ < 2; ++h_) { vA[h_][0] = nvA[h_][0]; vA[h_][1] = nvA[h_][1]; } }
        if constexpr (ALIGN_EPI) { if (wr == 1) PG8_BAR; }
    }
    PG8_WAIT_V(0);
    if constexpr (!ALIGN_EPI) { if (wr == 0) PG8_BAR; }
    PG8_BAR;
#undef PG8_SA
#undef PG8_SB
#undef PG8_STAGE
#undef PG8_LDA
#undef PG8_LDB
#undef PG8_MMA
#undef PG8_WAIT_V
#undef PG8_WAIT_L
#undef PG8_BAR
#undef PG8_SCHED
#undef PG8_AOFF
#undef PG8_ABASE
}
}

#include <hip/hip_bf16.h>
#include <cmath>
namespace attn_body {
using bf16=__hip_bfloat16;
using bf16x8=__attribute__((ext_vector_type(8)))short;
using s16x4=__attribute__((ext_vector_type(4)))short;
using f32x16=__attribute__((ext_vector_type(16)))float;
using u32x4=__attribute__((ext_vector_type(4)))unsigned;
constexpr int BATCH=2,NHEAD=8,SEQ=16384,D=64,DM=3072,OP=1024;
constexpr int NW=8,QBLK=32,QB=QBLK*NW,KVBLK=64,NQB=SEQ/QB;
constexpr int ATTN_PITCH=DM, ATTN_UNIT_ROWS=QB;
__device__ __forceinline__ int crow(int r,int hi){return (r&3)+8*(r>>2)+4*hi;}
#define SBAR() __builtin_amdgcn_sched_barrier(0)
__device__ __forceinline__ void cmask(f32x16&p0,f32x16&p1,int jb,int qrel,int hi){
  const float NEG=-INFINITY; int kb=64*jb+4*hi;
  #pragma unroll
  for(int r=0;r<16;++r){int kv=kb+(r&3)+8*(r>>2); if(kv>qrel)p0[r]=NEG; if(kv+32>qrel)p1[r]=NEG;}
}

constexpr int NSLOT=3, SLOTB=8192;
constexpr int LDS_K=0, LDS_V=NSLOT*SLOTB, LDS_WS=2*NSLOT*SLOTB, LDS_OST=LDS_WS+NW*64*4, LDS_BIAS=LDS_OST+NW*4096, BIAS_CP=1552, LDS_BYTES=LDS_BIAS+4*BIAS_CP;
constexpr float C2=0.125f*1.4426950408889634f;
__device__ __forceinline__ void glds16(const void*gsrc,unsigned lds_dst){unsigned keep;
  asm volatile("s_mov_b32 %0, m0\n\ts_mov_b32 m0, %2\n\ts_nop 0\n\tglobal_load_lds_dwordx4 %1, off\n\ts_mov_b32 m0, %0":"=&s"(keep):"v"(gsrc),"s"(lds_dst):"memory");}
__device__ __forceinline__ float max3f(float a,float b,float c){float r;asm("v_max3_f32 %0, %1, %2, %3":"=v"(r):"v"(a),"v"(b),"v"(c));return r;}
__device__ __forceinline__ float max2f(float a,float b){float r;asm("v_max_f32_e32 %0, %1, %2":"=v"(r):"v"(a),"v"(b));return r;}
__device__ __forceinline__ float fadd_s(float a,float b){float r;asm("v_add_f32_e32 %0, %1, %2":"=v"(r):"v"(a),"v"(b));return r;}
__device__ __forceinline__ float fsub_s(float a,float b){float r;asm("v_sub_f32_e32 %0, %1, %2":"=v"(r):"v"(a),"v"(b));return r;}
typedef float f32x2_t __attribute__((ext_vector_type(2))); typedef __bf16 bf16x2_t __attribute__((ext_vector_type(2)));
__device__ __forceinline__ unsigned cvtpk_s(float lo,float hi){f32x2_t v={lo,hi};bf16x2_t b=__builtin_convertvector(v,bf16x2_t);return __builtin_bit_cast(unsigned,b);}
#define WAIT_BAR(N) asm volatile("s_waitcnt vmcnt(" #N ") lgkmcnt(0)\n\ts_barrier":::"memory")

__device__ __forceinline__ void qkt(f32x16&p0,f32x16&p1,const char*Kslot,const bf16x8*qr,int r32,int hi){
  const char*kb=Kslot+hi*1024+r32*16;
  #pragma unroll
  for(int d0=0;d0<4;++d0){
    const bf16x8 b0=*reinterpret_cast<const bf16x8*>(kb+d0*2048);
    const bf16x8 b1=*reinterpret_cast<const bf16x8*>(kb+d0*2048+512);
    if(d0==0){p0=__builtin_amdgcn_mfma_f32_32x32x16_bf16(b0,qr[0],f32x16{},0,0,0);p1=__builtin_amdgcn_mfma_f32_32x32x16_bf16(b1,qr[0],f32x16{},0,0,0);}
    else{p0=__builtin_amdgcn_mfma_f32_32x32x16_bf16(b0,qr[d0],p0,0,0,0);p1=__builtin_amdgcn_mfma_f32_32x32x16_bf16(b1,qr[d0],p1,0,0,0);}}
}
typedef __attribute__((address_space(3))) const char* lds_cptr;
typedef short v4i16_t __attribute__((ext_vector_type(4)));
typedef float f32x4_t __attribute__((ext_vector_type(4)));
__device__ __forceinline__ void kload8(bf16x8*kf,lds_cptr kp){
  kf[0]=*(const __attribute__((address_space(3))) bf16x8*)(kp);      kf[1]=*(const __attribute__((address_space(3))) bf16x8*)(kp+512);
  kf[2]=*(const __attribute__((address_space(3))) bf16x8*)(kp+2048); kf[3]=*(const __attribute__((address_space(3))) bf16x8*)(kp+2560);
  kf[4]=*(const __attribute__((address_space(3))) bf16x8*)(kp+4096); kf[5]=*(const __attribute__((address_space(3))) bf16x8*)(kp+4608);
  kf[6]=*(const __attribute__((address_space(3))) bf16x8*)(kp+6144); kf[7]=*(const __attribute__((address_space(3))) bf16x8*)(kp+6656);
}
__device__ __forceinline__ void kload2(bf16x8*kf,lds_cptr kp,int j){ kf[2*j]=*(const __attribute__((address_space(3))) bf16x8*)(kp+j*2048); kf[2*j+1]=*(const __attribute__((address_space(3))) bf16x8*)(kp+j*2048+512); }
__device__ __forceinline__ s16x4 vtr(lds_cptr p){ return __builtin_bit_cast(s16x4,__builtin_amdgcn_ds_read_tr16_b64_v4i16((__attribute__((address_space(3))) v4i16_t*)p)); }
__device__ __forceinline__ float rowmax(const f32x16&p0,const f32x16&p1){
  float a=max3f(p0[0],p0[1],p1[0]),b=max3f(p0[2],p0[3],p1[1]);a=max3f(a,p1[2],p1[3]);
  #pragma unroll
  for(int r=4;r<16;r+=4){a=max3f(a,p0[r],p0[r+1]);b=max3f(b,p0[r+2],p0[r+3]);a=max3f(a,p1[r],p1[r+1]);b=max3f(b,p1[r+2],p1[r+3]);}
  const float m=max2f(a,b);
  auto rr=__builtin_amdgcn_permlane32_swap(__float_as_uint(m),__float_as_uint(m),false,false);
  return max2f(__uint_as_float(rr[0]),__uint_as_float(rr[1]));
}
__device__ __forceinline__ void pv(f32x16*o,int vb,bf16x8 pa0,bf16x8 pa1,bf16x8 pa2,bf16x8 pa3){
  #pragma unroll
  for(int d0=0;d0<2;++d0){s16x4 lo[4],hi[4];
    #pragma unroll
    for(int ks=0;ks<4;++ks){
      asm volatile("ds_read_b64_tr_b16 %0,%1 offset:%c2":"=&v"(lo[ks]):"v"(vb),"i"(d0*4096+ks*1024):"memory");
      asm volatile("ds_read_b64_tr_b16 %0,%1 offset:%c2":"=&v"(hi[ks]):"v"(vb),"i"(d0*4096+ks*1024+512):"memory");}
    asm volatile("s_waitcnt lgkmcnt(0)":::"memory");SBAR();
    #define PK(k) (bf16x8){lo[k][0],lo[k][1],lo[k][2],lo[k][3],hi[k][0],hi[k][1],hi[k][2],hi[k][3]}
    o[d0]=__builtin_amdgcn_mfma_f32_32x32x16_bf16(pa0,PK(0),o[d0],0,0,0);
    o[d0]=__builtin_amdgcn_mfma_f32_32x32x16_bf16(pa1,PK(1),o[d0],0,0,0);
    o[d0]=__builtin_amdgcn_mfma_f32_32x32x16_bf16(pa2,PK(2),o[d0],0,0,0);
    o[d0]=__builtin_amdgcn_mfma_f32_32x32x16_bf16(pa3,PK(3),o[d0],0,0,0);
    #undef PK
  }
}

__device__ __forceinline__ void maskbias(f32x16&p0,f32x16&p1,int dl,lds_cptr bl,float cfar,float mh){
  if(dl<0||dl>8){
    #pragma unroll
    for(int r=0;r<16;++r){p0[r]=-INFINITY;p1[r]=-INFINITY;}
  } else if(dl>=5){
    {const float cc=cfar-mh; _Pragma("unroll") for(int r=0;r<16;++r){p0[r]+=cc;p1[r]+=cc;}}
  } else { const lds_cptr b=bl-256*dl;
    #pragma unroll
    for(int g=0;g<4;++g){ const f32x4_t x0=*(const __attribute__((address_space(3))) f32x4_t*)(b+32*g), x1=*(const __attribute__((address_space(3))) f32x4_t*)(b+32*g+128);
      #pragma unroll
      for(int e=0;e<4;++e){p0[4*g+e]+=x0[e]-mh;p1[4*g+e]+=x1[e]-mh;} } }
}
#ifndef ATTN_STORE16
#define ATTN_STORE16(p,v) (*(u32x4*)(p)=(v))
#endif
template<int THRL> __device__ __forceinline__ void attn_unit(int b,int h,int qb,const bf16*Q,const bf16*__restrict__ K,const bf16*__restrict__ V,bf16*O,const float*relb,char*shm){
  const int tid=threadIdx.x,lane=tid&63,r32=lane&31,hi=lane>>5; const int wid=__builtin_amdgcn_readfirstlane(tid>>6);
  const long rowbase=(long)b*SEQ; const int q0=qb*QB;
  const bf16*Qw=Q+(rowbase+q0+wid*QBLK)*DM+h*D;
  const bf16*Kh=K+rowbase*DM+h*D,*Vh=V+rowbase*DM+h*D;
  const unsigned lds0=(unsigned)(uintptr_t)shm;
  const lds_cptr shm3b=(lds_cptr)shm;
  float*wsf=(float*)(shm+LDS_WS)+wid*64;
  const bf16*ksrc=Kh+(long)lane*DM+wid*8;
  const bf16*vsrc=Vh+(long)(16*(wid&3)+(lane>>2))*DM+(wid>>2)*32+(lane&3)*8;
  const unsigned kdst=lds0+LDS_K+wid*1024, vdst=lds0+LDS_V+wid*1024;
  #define TOFF(t) ((t)==0?0:((t)<=nb?-(t):(t)-nb))
  #define DMA_K(t,slot) glds16(ksrc+(long)(q0+KVBLK*TOFF(t))*DM,(unsigned)__builtin_amdgcn_readfirstlane(kdst+(slot)))
  #define DMA_V(t,slot) glds16(vsrc+(long)(q0+KVBLK*TOFF(t))*DM,(unsigned)__builtin_amdgcn_readfirstlane(vdst+(slot)))
  const int vb0=(int)(lds0+LDS_V)+((lane>>4)&1)*32+(lane&3)*8+(4*hi+((lane&15)>>2))*64;
  const char*Kbase=shm+LDS_K; bf16x8 kf[8];
  const lds_cptr shm3=(lds_cptr)shm; const lds_cptr kp0=shm3+LDS_K+hi*1024+r32*16; const lds_cptr vp0=shm3+LDS_V+((lane>>4)&1)*32+(lane&3)*8+(4*hi+((lane&15)>>2))*64;
  const int nb=(4*qb<8)?4*qb:8; const int NT=4+nb;
  const int pw_=wid>>1, qi_=32*(wid&1)+r32, al_=(3-qi_)&3;
  { __attribute__((address_space(3))) float* bc=(__attribute__((address_space(3))) float*)(shm3b+LDS_BIAS);
    for(int j=tid;j<4*388;j+=512){const int a=j/388,jj=j-a*388,rel=319-jj-a; bc[j]=(rel>=-63)?relb[(rel>256?256:rel)+256]*1.4426950408889634f:0.f;} }
  const float cfar=relb[512]*1.4426950408889634f;
  const lds_cptr bl_=shm3b+LDS_BIAS+al_*BIAS_CP+(319-qi_+4*hi-al_)*4;
  DMA_K(0,0);DMA_V(0,0);DMA_K(1,SLOTB);
  bf16x8 qr[4];
  #pragma unroll
  for(int d0=0;d0<4;++d0)qr[d0]=*reinterpret_cast<const bf16x8*>(&Qw[(long)r32*DM+d0*16+hi*8]);
  float mhat=0.f,l_reg=0.f;f32x16 o[2];o[0]=f32x16{};o[1]=f32x16{};
  const int qrel=wid*QBLK+r32;
  #define CMASK(P0,P1,t) maskbias(P0,P1,pw_-TOFF(t),bl_,cfar,mhat)
  bool resc=false;
  #define START(P0,P1) do{ const float rm=rowmax(P0,P1); resc=false; \
    { const float dl=rm; mhat=fadd_s(mhat,dl); \
      _Pragma("unroll") for(int r=0;r<16;++r){P0[r]=fsub_s(P0[r],dl);P1[r]=fsub_s(P1[r],dl);} } \
    _Pragma("unroll") for(int r=0;r<16;++r)P0[r]=__builtin_amdgcn_exp2f(P0[r]); }while(0)
  #define RESC() do{ if(resc){ asm volatile("s_waitcnt lgkmcnt(0)":::"memory"); \
      _Pragma("unroll") for(int d_=0;d_<2;++d_) _Pragma("unroll") for(int r=0;r<16;++r)o[d_][r]*=wsf[crow(r,hi)]; } }while(0)
  f32x16 pA0,pA1,pB0,pB1;
  int sl_prev=0,sl_cur=0,sl_next=SLOTB;
  #define ROT() do{sl_prev=sl_cur;sl_cur=sl_next;sl_next=(sl_next==(NSLOT-1)*SLOTB)?0:sl_next+SLOTB;}while(0)
  DMA_K(2,2*SLOTB);
  WAIT_BAR(3);
  qkt(pA0,pA1,Kbase,qr,r32,hi);asm volatile("s_nop 15\n\ts_nop 7":"+v"(pA0),"+v"(pA1));CMASK(pA0,pA1,0);
  START(pA0,pA1);
  _Pragma("unroll") for(int r=0;r<16;++r)pA1[r]=__builtin_amdgcn_exp2f(pA1[r]);
  WAIT_BAR(0);
  DMA_K(3,0);DMA_V(1,SLOTB);
  ROT();
  kload8(kf,kp0+sl_cur);
  WAIT_BAR(2);
  s16x4 vlo[8],vhi[8]; u32x4 pw0,pw1,pw2,pw3;
  #define PKW(P,B) cvtpk_s(P[B],P[B+1])
  #define PAF(k) __builtin_bit_cast(bf16x8,pw##k)
  #define VFR(i) (bf16x8){vlo[i][0],vlo[i][1],vlo[i][2],vlo[i][3],vhi[i][0],vhi[i][1],vhi[i][2],vhi[i][3]}
  #define PIN(x) asm volatile("":"+v"(x))
  #define MX3(a,b,c) __builtin_fmaxf(__builtin_fmaxf((a),(b)),(c))
  #define GAPA(MF,A0,A1,A2,A3,W0,W1,PW) do{ MF; sacc+=A0; sacc+=A1; sacc+=A2; sacc+=A3; PIN(sacc); W0; W1; PIN(PW); SBAR(); }while(0)
  #define EX(v) __builtin_amdgcn_exp2f(v)
  #define GAPB(MF,X,B) do{ MF; X[B]=EX(X[B]); X[B+1]=EX(X[B+1]); X[B+2]=EX(X[B+2]); X[B+3]=EX(X[B+3]); PIN(X); SBAR(); }while(0)
  #define VRD(i) do{ vlo[i]=vtr(vp_+(((i)>>2)*4096+((i)&3)*1024)); vhi[i]=vtr(vp_+(((i)>>2)*4096+((i)&3)*1024+512)); }while(0)
  #define KRD(G,j) do{ if(G){ kload2(kf,kp0+sl_next,j); SBAR(); } }while(0)
  #define STEP(C0,C1,P0,P1,t,GK,GV,GL) do{ SBAR(); \
    const lds_cptr vp_=vp0+sl_prev; \
    VRD(0); SBAR(); float sacc=(P0[0]+P0[1]); \
    GAPA(C0=__builtin_amdgcn_mfma_f32_32x32x16_bf16(kf[0],qr[0],f32x16{},0,0,0), P0[2],P0[3],P0[4],P0[5],     pw0[0]=PKW(P0,0), pw0[1]=PKW(P0,2), pw0); \
    VRD(4); SBAR(); GAPA(C1=__builtin_amdgcn_mfma_f32_32x32x16_bf16(kf[1],qr[0],f32x16{},0,0,0), P0[6],P0[7],P0[8],P0[9],     pw0[2]=PKW(P0,4), pw0[3]=PKW(P0,6), pw0); \
    VRD(1); SBAR(); GAPA(C0=__builtin_amdgcn_mfma_f32_32x32x16_bf16(kf[2],qr[1],C0,0,0,0),   P0[10],P0[11],P0[12],P0[13], pw1[0]=PKW(P0,8), pw1[1]=PKW(P0,10), pw1); \
    VRD(5); SBAR(); GAPA(C1=__builtin_amdgcn_mfma_f32_32x32x16_bf16(kf[3],qr[1],C1,0,0,0),   P0[14],P0[15],P1[0],P1[1],   pw1[2]=PKW(P0,12),pw1[3]=PKW(P0,14), pw1); \
    VRD(2); SBAR(); GAPA(C0=__builtin_amdgcn_mfma_f32_32x32x16_bf16(kf[4],qr[2],C0,0,0,0),   P1[2],P1[3],P1[4],P1[5],     pw2[0]=PKW(P1,0), pw2[1]=PKW(P1,2), pw2); \
    VRD(6); SBAR(); GAPA(C1=__builtin_amdgcn_mfma_f32_32x32x16_bf16(kf[5],qr[2],C1,0,0,0),   P1[6],P1[7],P1[8],P1[9],     pw2[2]=PKW(P1,4), pw2[3]=PKW(P1,6), pw2); \
    VRD(3); SBAR(); GAPA(C0=__builtin_amdgcn_mfma_f32_32x32x16_bf16(kf[6],qr[3],C0,0,0,0),   P1[10],P1[11],P1[12],P1[13], pw3[0]=PKW(P1,8), pw3[1]=PKW(P1,10), pw3); \
    VRD(7); SBAR(); GAPA(C1=__builtin_amdgcn_mfma_f32_32x32x16_bf16(kf[7],qr[3],C1,0,0,0),   P1[14],P1[15],0.f,0.f,       pw3[2]=PKW(P1,12),pw3[3]=PKW(P1,14), pw3); \
    l_reg+=sacc; \
    if(GK){DMA_K((t)+3,sl_cur);} if(GV){DMA_V((t)+1,sl_next);} \
    CMASK(C0,C1,t); \
    { float a=MX3(C0[0],C0[1],C1[0]),b=MX3(C0[2],C0[3],C1[1]); a=MX3(a,C1[2],C1[3]); \
      _Pragma("unroll") for(int r=4;r<16;r+=4){a=MX3(a,C0[r],C0[r+1]);b=MX3(b,C0[r+2],C0[r+3]);a=MX3(a,C1[r],C1[r+1]);b=MX3(b,C1[r+2],C1[r+3]);} \
      float rm=__builtin_fmaxf(a,b); { auto rr=__builtin_amdgcn_permlane32_swap(__float_as_uint(rm),__float_as_uint(rm),false,false); rm=__builtin_fmaxf(__uint_as_float(rr[0]),__uint_as_float(rr[1])); } \
      resc=false; \
      if(__builtin_expect(__any(rm>(float)THRL),0)){ const float dl=__builtin_fmaxf(rm,0.f); mhat+=dl; \
        _Pragma("unroll") for(int r=0;r<16;++r){C0[r]-=dl;C1[r]-=dl;} \
        const float f=__builtin_amdgcn_exp2f(-dl); l_reg*=f; if(hi==0)wsf[r32]=f; resc=true; } } \
    SBAR(); \
    GAPB(o[0]=__builtin_amdgcn_mfma_f32_32x32x16_bf16(PAF(0),VFR(0),o[0],0,0,0), C0,0); \
    GAPB(o[1]=__builtin_amdgcn_mfma_f32_32x32x16_bf16(PAF(0),VFR(4),o[1],0,0,0), C0,4); \
    KRD(GL,0); GAPB(o[0]=__builtin_amdgcn_mfma_f32_32x32x16_bf16(PAF(1),VFR(1),o[0],0,0,0), C0,8); \
    KRD(GL,1); GAPB(o[1]=__builtin_amdgcn_mfma_f32_32x32x16_bf16(PAF(1),VFR(5),o[1],0,0,0), C0,12); \
    KRD(GL,2); GAPB(o[0]=__builtin_amdgcn_mfma_f32_32x32x16_bf16(PAF(2),VFR(2),o[0],0,0,0), C1,0); \
    KRD(GL,3); GAPB(o[1]=__builtin_amdgcn_mfma_f32_32x32x16_bf16(PAF(2),VFR(6),o[1],0,0,0), C1,4); \
    GAPB(o[0]=__builtin_amdgcn_mfma_f32_32x32x16_bf16(PAF(3),VFR(3),o[0],0,0,0), C1,8); \
    GAPB(o[1]=__builtin_amdgcn_mfma_f32_32x32x16_bf16(PAF(3),VFR(7),o[1],0,0,0), C1,12); \
    }while(0)
  int t=1;
  for(;t+5<NT;t+=2){
    STEP(pB0,pB1,pA0,pA1,t,true,true,true);     WAIT_BAR(2); RESC(); ROT();
    STEP(pA0,pA1,pB0,pB1,t+1,true,true,true);   WAIT_BAR(2); RESC(); ROT();
  }
  #define ENDW(tt) do{ if((tt)+3<NT){WAIT_BAR(2);} else if((tt)+2<NT){WAIT_BAR(1);} else {WAIT_BAR(0);} }while(0)
  for(;t+1<NT;t+=2){
    STEP(pB0,pB1,pA0,pA1,t,(t+3<NT),(t+1<NT),(t+1<NT));       ENDW(t);   RESC(); ROT();
    STEP(pA0,pA1,pB0,pB1,t+1,(t+4<NT),(t+2<NT),(t+2<NT));     ENDW(t+1); RESC(); ROT();
  }
  STEP(pB0,pB1,pA0,pA1,NT-1,false,false,false); RESC();
  { float sacc=pB0[0]+pB0[1]; _Pragma("unroll") for(int r=2;r<16;++r)sacc+=pB0[r]; _Pragma("unroll") for(int r=0;r<16;++r)sacc+=pB1[r]; l_reg+=sacc;
    pw0=(u32x4){PKW(pB0,0),PKW(pB0,2),PKW(pB0,4),PKW(pB0,6)};pw1=(u32x4){PKW(pB0,8),PKW(pB0,10),PKW(pB0,12),PKW(pB0,14)};pw2=(u32x4){PKW(pB1,0),PKW(pB1,2),PKW(pB1,4),PKW(pB1,6)};pw3=(u32x4){PKW(pB1,8),PKW(pB1,10),PKW(pB1,12),PKW(pB1,14)};
    SBAR(); pv(o,vb0+sl_cur,PAF(0),PAF(1),PAF(2),PAF(3)); }
  #undef PKW
  #undef PAF
  #undef VFR
  #undef PIN
  #undef MX3
  #undef GAPA
  #undef GAPB
  #undef EX
  #undef VRD
  #undef KRD
  #undef STEP
  #undef ENDW
  {auto rr=__builtin_amdgcn_permlane32_swap(__float_as_uint(l_reg),__float_as_uint(l_reg),false,false);l_reg=__uint_as_float(rr[0])+__uint_as_float(rr[1]);}
  if(hi==0)wsf[32+r32]=l_reg;asm volatile("s_waitcnt lgkmcnt(0)":::"memory");
  float rli[16];
  #pragma unroll
  for(int r=0;r<16;++r)rli[r]=__builtin_amdgcn_rcpf(wsf[32+crow(r,hi)]);
  bf16*Ow=O+(rowbase+q0+wid*QBLK)*OP+h*D;
  { bf16*stg=(bf16*)(shm+LDS_OST)+wid*2048;
    #pragma unroll
    for(int r=0;r<16;++r){const int orow=crow(r,hi);
      #pragma unroll
      for(int d0=0;d0<2;++d0)stg[orow*64+d0*32+r32]=__float2bfloat16(o[d0][r]*rli[r]);}
    asm volatile("s_waitcnt lgkmcnt(0)":::"memory");
    #pragma unroll
    for(int i=0;i<4;++i){const int row=i*8+(lane>>3),ch=lane&7; const u32x4 v=*(const u32x4*)(stg+row*64+ch*8); ATTN_STORE16(Ow+(long)row*OP+ch*8,v);} }
  asm volatile("s_waitcnt lgkmcnt(0)\n\ts_barrier":::"memory");
  #undef DMA_K
  #undef TOFF
  #undef DMA_V
  #undef CMASK
  #undef START
  #undef RESC
  #undef ROT
}
constexpr int ATTN_LDS_BYTES=LDS_BYTES;
struct AttnTensors { const bf16* Q; const bf16* K; const bf16* V; bf16* O; const float* relb; };
struct AttnUnit { int bh; int qb; };
struct StaticOrder {
  int vcu,upb;
  __device__ __forceinline__ explicit StaticOrder(int grid,int block):vcu((grid%8==0)?(block%8)*(grid/8)+block/8:block),upb((BATCH*NHEAD*NQB+grid-1)/grid){}
  __device__ __forceinline__ bool next(int i,AttnUnit&u)const{ const int un=vcu*upb+i; if(i>=upb||un>=BATCH*NHEAD*NQB)return false; u.bh=un/NQB; u.qb=un%NQB; return true; }
  __device__ __forceinline__ void a_ready(const AttnUnit&)const{}
  __device__ __forceinline__ void done(const AttnUnit&)const{}
};
template<class Sched,int THRL=8> __device__ __forceinline__ void attn_phase(char*lds,const AttnTensors&T,const Sched&S){
  AttnUnit u;
  for(int i=0;S.next(i,u);++i){ S.a_ready(u); attn_unit<THRL>(u.bh/NHEAD,u.bh%NHEAD,u.qb,T.Q,T.K,T.V,T.O,T.relb+(u.bh%NHEAD)*513,lds); S.done(u); }
}
#undef SBAR
#undef WAIT_BAR
}
constexpr int NWAVES = 8, NTHR = 512;
constexpr int NTOK = 32768, DM = 1024, SEQ = 16384, CH = 64, NCH = SEQ / CH, NCHT = 2 * NCH;
constexpr int PW = 3072;
constexpr int C_GQ = 0, C_GK = 256, C_GV = 512, C_OG = 1024, C_AQ = 1536, C_AK = 2048, C_AV = 2560;
constexpr int NIN = 3328;
constexpr int W_IN_COLS = 3088;
constexpr int NEXP = 32, TOPK = 4, DFF = 1024;
constexpr int PSLOTS = 139264;
constexpr float EPS = 1e-6f;
constexpr float LOG2E = 1.4426950408889634f;
constexpr float C2 = 0.125f * LOG2E;

constexpr size_t MiB = 1u << 20;
constexpr size_t WS_CTL = 0, CTL_ZERO_BYTES = 1 * MiB;
constexpr size_t WS_RWP = 1 * MiB;
constexpr size_t WS_TOPE = 2 * MiB, WS_TOPG = 3 * MiB, WS_RANK = 4 * MiB, WS_SLOTOF = 5 * MiB;
constexpr size_t WS_HIST = 6 * MiB;
constexpr size_t WS_TILEE = 6 * MiB + 65536;
constexpr size_t WS_BUFTOK = 7 * MiB, WS_GATESLOT = 8 * MiB;
constexpr size_t WS_DEC = 9 * MiB;
constexpr size_t WS_WIN = 10 * MiB;
constexpr size_t WS_WOUT = 17 * MiB;
constexpr size_t WS_WMIN = 20 * MiB;
constexpr size_t WS_WMOUT = 148 * MiB;
constexpr size_t WS_H2 = 212 * MiB;
constexpr size_t WS_Y = 276 * MiB;
constexpr size_t WS_H1 = 548 * MiB;
constexpr size_t WS_PROJ = 612 * MiB;
constexpr size_t WS_GATE = 804 * MiB;
constexpr size_t WS_US = 836 * MiB;
constexpr size_t WS_MIX = 900 * MiB;
constexpr size_t WS_ACT = 548 * MiB;
constexpr size_t WS_END = 964 * MiB;
static_assert(WS_Y + (size_t)PSLOTS * 1024 * 2 <= WS_H1 && WS_ACT + (size_t)PSLOTS * 1024 * 2 <= WS_US && WS_MIX + (size_t)NTOK * 1024 * 2 <= WS_END, "ws map");
static_assert(WS_WIN + (size_t)NIN * 1024 * 2 <= WS_WOUT && WS_WMIN + (size_t)32 * 2048 * 1024 * 2 <= WS_WMOUT && WS_WMOUT + (size_t)32 * 1024 * 1024 * 2 <= WS_H2, "ws map 2");

constexpr int CW_BAR = 4096;
constexpr int RING_BYTES = 131072, LDSCTL_OFF = RING_BYTES, MISC_OFF = LDSCTL_OFF + 320, LDS_BYTES = 147456;

#define GAS __attribute__((address_space(1)))
#define LAS __attribute__((address_space(3)))
typedef unsigned short bf16;
typedef unsigned v4u __attribute__((ext_vector_type(4)));
typedef unsigned v2u __attribute__((ext_vector_type(2)));
typedef float f32x4 __attribute__((ext_vector_type(4)));
typedef float f32x16 __attribute__((ext_vector_type(16)));
#define LDS_WAIT() asm volatile("s_waitcnt lgkmcnt(0)" ::: "memory")
__device__ __forceinline__ unsigned f2bf(float f) { unsigned u = __builtin_bit_cast(unsigned, f); return (u + 0x7fffu + ((u >> 16) & 1u)) >> 16; }
__device__ __forceinline__ unsigned pk2(float lo, float hi) { return f2bf(lo) | (f2bf(hi) << 16); }
__device__ __forceinline__ float bflo(unsigned w) { return __builtin_bit_cast(float, w << 16); }
__device__ __forceinline__ float bfhi(unsigned w) { return __builtin_bit_cast(float, w & 0xffff0000u); }

#define XB_TMO      128
#define XB_XCNT(j)  (256  + 64 * (j))
#define XB_XSUB(j)  (1280 + 64 * (j))
#define XB_XGEN(j)  (2304 + 64 * (j))
#define XB_TOP      3328
#define XB_TOPGEN   3392
#define XCD_BAR_WORDS 3456
#define XB_SPIN_CAP (1u << 18)
__device__ __forceinline__ unsigned xb_ld(unsigned* p)              { return __hip_atomic_load(p, __ATOMIC_RELAXED, __HIP_MEMORY_SCOPE_AGENT); }
__device__ __forceinline__ unsigned xb_add(unsigned* p, unsigned v) { return __hip_atomic_fetch_add(p, v, __ATOMIC_RELAXED, __HIP_MEMORY_SCOPE_AGENT); }
__device__ __forceinline__ unsigned xb_xcc_id() { return (unsigned)__builtin_amdgcn_s_getreg((3 << 11) | 20) & 0xFu; }
#define XB_SPIN(cond, bar) do { unsigned _sp = 0; while (cond) { __builtin_amdgcn_s_sleep(1); \
    if ((++_sp & 255u) == 0u) { if (xb_ld(&(bar)[XB_TMO])) break; if (_sp > XB_SPIN_CAP) { atomicAdd(&(bar)[XB_TMO], 1u); break; } } } } while (0)
struct XcdBarrier { unsigned* bar; unsigned x; volatile LAS unsigned* st; };
__device__ __forceinline__ XcdBarrier xcd_barrier_post(unsigned* bar, volatile LAS unsigned* st) {
    XcdBarrier b; b.bar = bar; b.x = xb_xcc_id(); b.st = st;
    if (threadIdx.x == 0) (void)xb_add(&bar[XB_XCNT(b.x)], 1u);
    return b;
}
__device__ __forceinline__ void xcd_barrier_complete(unsigned* bar, unsigned x, unsigned& nloc, unsigned& nx) {
    const unsigned G = gridDim.x * gridDim.y * gridDim.z;
    unsigned sum, cnt, mine, sp = 0u;
    for (;;) {
        sum = 0u; cnt = 0u; mine = 0u;
#pragma unroll
        for (unsigned j = 0; j < 16; ++j) { const unsigned c = xb_ld(&bar[XB_XCNT(j)]); sum += c; cnt += (c > 0u) ? 1u : 0u; mine = (j == x) ? c : mine; }
        if (sum == G) break;
        __builtin_amdgcn_s_sleep(1);
        if ((++sp & 255u) == 0u) { if (xb_ld(&bar[XB_TMO])) break; if (sp > XB_SPIN_CAP) { atomicAdd(&bar[XB_TMO], 1u); break; } }
    }
    nloc = mine > 0u ? mine : 1u; nx = cnt > 0u ? cnt : 1u;
}
__device__ __forceinline__ void xcd_barrier(const XcdBarrier& b) {
    asm volatile("s_waitcnt vmcnt(0)" ::: "memory");
    __syncthreads();
    if (threadIdx.x == 0) {
        unsigned* bar = b.bar;
        __builtin_amdgcn_s_waitcnt(0);
        unsigned nloc = b.st[0], nx = b.st[1];
        if (nloc == 0u) { xcd_barrier_complete(bar, b.x, nloc, nx); b.st[0] = nloc; b.st[1] = nx; }
        const unsigned old = xb_add(&bar[XB_XSUB(b.x)], 1u);
        const unsigned gen = old / nloc;
        if (old + 1u == (gen + 1u) * nloc) {
            __builtin_amdgcn_fence(__ATOMIC_RELEASE, "agent");
            asm volatile("s_waitcnt vmcnt(0)" ::: "memory");
            const unsigned og = xb_add(&bar[XB_TOP], 1u);
            const unsigned tg = og / nx;
            if (og + 1u == (tg + 1u) * nx) xb_add(&bar[XB_TOPGEN], 1u);
            else XB_SPIN(xb_ld(&bar[XB_TOPGEN]) == tg, bar);
            __builtin_amdgcn_fence(__ATOMIC_ACQUIRE, "agent");
            xb_add(&bar[XB_XGEN(b.x)], 1u);
            asm volatile("s_waitcnt vmcnt(0)" ::: "memory");
        } else {
            XB_SPIN(xb_ld(&bar[XB_XGEN(b.x)]) == gen, bar);
            __builtin_amdgcn_fence(__ATOMIC_ACQUIRE, "agent");
            asm volatile("s_waitcnt vmcnt(0)" ::: "memory");
        }
    }
    __syncthreads();
}

using pg8::Unit; using pg8::cvt_pk_bf16;
struct EpiProj {
    static constexpr bool PERM = true;
    bf16* P; float* G; const float* gbias;
    __device__ __forceinline__ void operator()(const f32x4 (&acc)[2][2][4][2], const Unit& u, int wr, int wc, int fr, int fq) const {
        const int row0 = u.pm * 256 + wr * 64 + fr;
        if (u.pn < 12) {
            const int col0 = u.pn * 256 + wc * 32 + 8 * fq;
#pragma unroll
            for (int ai = 0; ai < 2; ++ai)
#pragma unroll
                for (int m = 0; m < 4; ++m) { bf16* rowp = P + (size_t)(row0 + ai * 128 + m * 16) * PW + col0;
#pragma unroll
                    for (int bj = 0; bj < 2; ++bj) { const f32x4 v0 = acc[ai][bj][m][0], v1 = acc[ai][bj][m][1];
                        v4u w; w.x = cvt_pk_bf16(v0[0], v0[1]); w.y = cvt_pk_bf16(v0[2], v0[3]); w.z = cvt_pk_bf16(v1[0], v1[1]); w.w = cvt_pk_bf16(v1[2], v1[3]);
                        *(v4u*)(rowp + bj * 128) = w; } }
        } else {
            const int col0 = wc * 32 + 8 * fq;
            f32x4 bv[2][2];
#pragma unroll
            for (int bj = 0; bj < 2; ++bj)
#pragma unroll
                for (int n = 0; n < 2; ++n) bv[bj][n] = *(const f32x4*)(gbias + col0 + bj * 128 + 4 * n);
#pragma unroll
            for (int ai = 0; ai < 2; ++ai)
#pragma unroll
                for (int m = 0; m < 4; ++m) { float* rowp = G + (size_t)(row0 + ai * 128 + m * 16) * 256 + col0;
#pragma unroll
                    for (int bj = 0; bj < 2; ++bj)
#pragma unroll
                        for (int n = 0; n < 2; ++n) { const f32x4 z = acc[ai][bj][m][n] + bv[bj][n]; f32x4 o;
#pragma unroll
                            for (int i = 0; i < 4; ++i) { const float zz = z[i]; const float t = __logf(1.f + __expf(-fabsf(zz))); o[i] = (fminf(zz, 0.f) - t) * (1.f / 16.f); }
                            *(f32x4*)(rowp + bj * 128 + 4 * n) = o; } }
        }
    }
};
struct EpiResid {
    static constexpr bool PERM = false;
    const float* X; float* O;
    __device__ __forceinline__ void operator()(const f32x4 (&acc)[2][2][4][2], const Unit& u, int wr, int wc, int fr, int fq) const {
        const int row0 = u.pm * 256 + wr * 64 + fr, col0 = u.pn * 256 + wc * 32 + 4 * fq;
#pragma unroll
        for (int ai = 0; ai < 2; ++ai)
#pragma unroll
            for (int m = 0; m < 4; ++m) { const size_t off = (size_t)(row0 + ai * 128 + m * 16) * DM + col0;
#pragma unroll
                for (int bj = 0; bj < 2; ++bj)
#pragma unroll
                    for (int n = 0; n < 2; ++n) { const f32x4 xv = *(const f32x4*)(X + off + bj * 128 + n * 16); *(f32x4*)(O + off + bj * 128 + n * 16) = acc[ai][bj][m][n] + xv; } }
    }
};
struct EpiSwiglu {
    static constexpr bool PERM = true;
    bf16* ACT; const float* bin;
    __device__ __forceinline__ void operator()(const f32x4 (&acc)[2][2][4][2], const Unit& u, int wr, int wc, int fr, int fq) const {
        const int row0 = u.pm * 256 + wr * 64 + fr, f0 = u.pn * 128 + wc * 32 + 8 * fq;
        const float* bg = bin + (size_t)u.e * 2048 + f0; const float* bl = bg + 1024;
        f32x4 bgv[2], blv[2];
#pragma unroll
        for (int n = 0; n < 2; ++n) { bgv[n] = *(const f32x4*)(bg + 4 * n); blv[n] = *(const f32x4*)(bl + 4 * n); }
#pragma unroll
        for (int ai = 0; ai < 2; ++ai)
#pragma unroll
            for (int m = 0; m < 4; ++m) { float a[8];
#pragma unroll
                for (int n = 0; n < 2; ++n) { const f32x4 gl = acc[ai][0][m][n] + bgv[n], li = acc[ai][1][m][n] + blv[n];
#pragma unroll
                    for (int i = 0; i < 4; ++i) { const float gg = fminf(gl[i], 7.f), ll = fminf(fmaxf(li[i], -7.f), 7.f);
                        const float sg = __builtin_amdgcn_rcpf(1.f + __builtin_amdgcn_exp2f(-1.702f * LOG2E * gg)); a[4 * n + i] = gg * sg * (ll + 1.f); } }
                v4u w; w.x = cvt_pk_bf16(a[0], a[1]); w.y = cvt_pk_bf16(a[2], a[3]); w.z = cvt_pk_bf16(a[4], a[5]); w.w = cvt_pk_bf16(a[6], a[7]);
                *(v4u*)(ACT + (size_t)(row0 + ai * 128 + m * 16) * 1024 + f0) = w; }
    }
};
struct EpiY {
    static constexpr bool PERM = true;
    bf16* Y; const float* bout; const float* gslot;
    __device__ __forceinline__ void operator()(const f32x4 (&acc)[2][2][4][2], const Unit& u, int wr, int wc, int fr, int fq) const {
        const int row0 = u.pm * 256 + wr * 64 + fr, col0 = u.pn * 256 + wc * 32 + 8 * fq;
        const float* bb = bout + (size_t)u.e * 1024 + col0;
        f32x4 bv[2][2];
#pragma unroll
        for (int bj = 0; bj < 2; ++bj)
#pragma unroll
            for (int n = 0; n < 2; ++n) bv[bj][n] = *(const f32x4*)(bb + bj * 128 + 4 * n);
#pragma unroll
        for (int ai = 0; ai < 2; ++ai)
#pragma unroll
            for (int m = 0; m < 4; ++m) { const int row = row0 + ai * 128 + m * 16; const float gt = gslot[row]; bf16* rowp = Y + (size_t)row * 1024 + col0;
#pragma unroll
                for (int bj = 0; bj < 2; ++bj) { const f32x4 v0 = (acc[ai][bj][m][0] + bv[bj][0]) * gt, v1 = (acc[ai][bj][m][1] + bv[bj][1]) * gt;
                    v4u w; w.x = cvt_pk_bf16(v0[0], v0[1]); w.y = cvt_pk_bf16(v0[2], v0[3]); w.z = cvt_pk_bf16(v1[0], v1[1]); w.w = cvt_pk_bf16(v1[2], v1[3]);
                    *(v4u*)(rowp + bj * 128) = w; } }
    }
};

__device__ __forceinline__ float wave_sum(float v) {
#pragma unroll
    for (int o = 1; o < 64; o <<= 1) v += __shfl_xor(v, o);
    return v;
}
__device__ __forceinline__ void p0_transpose_item(const float* W, int Nsrc, bf16* WT, int Kp, int k0, int ns0, int nd0, LAS float* scr, int lane) {
#pragma unroll 8
    for (int i = 0; i < 32; ++i) { const int kk = 2 * i + (lane >> 5); scr[kk * 33 + (lane & 31)] = W[(size_t)(k0 + kk) * Nsrc + ns0 + (lane & 31)]; }
    LDS_WAIT(); asm volatile("" ::: "memory");
    const int c = lane & 7;
#pragma unroll
    for (int j = 0; j < 4; ++j) { const int n = (lane >> 3) + 8 * j; const LAS float* s = scr + (8 * c) * 33 + n;
        v4u o; o.x = pk2(s[0 * 33], s[1 * 33]); o.y = pk2(s[2 * 33], s[3 * 33]); o.z = pk2(s[4 * 33], s[5 * 33]); o.w = pk2(s[6 * 33], s[7 * 33]);
        *(v4u*)(WT + (size_t)(nd0 + n) * Kp + k0 + 8 * c) = o; }
    LDS_WAIT(); asm volatile("" ::: "memory");
}

struct Args { const float* in[17]; float* out; unsigned char* ws; int ph_lo, ph_hi, li, pad; };
constexpr int NPHASE = 11;

__global__ void __launch_bounds__(NTHR, 2) fwd(Args args) {
    extern __shared__ __attribute__((aligned(16))) unsigned char lds_raw[];
    LAS unsigned char* lds = (LAS unsigned char*)lds_raw;
    LAS float* ldsf = (LAS float*)lds_raw;
    volatile LAS unsigned* MISC = (volatile LAS unsigned*)(lds + MISC_OFF);
    const int tid = threadIdx.x, lane = tid & 63, wave = __builtin_amdgcn_readfirstlane(tid >> 6);
    const int G = gridDim.x, bx = blockIdx.x;
    unsigned char* ws = args.ws;
    unsigned* ctl = (unsigned*)(ws + WS_CTL);
    const float* x = args.in[0]; const float* g1 = args.in[1]; const float* w_in = args.in[2]; const float* gate_up = args.in[3]; const float* gate_bias = args.in[4];
    const float* gla_ng = args.in[5]; const float* qng = args.in[6]; const float* kng = args.in[7]; const float* rel_bias = args.in[8]; const float* w_out = args.in[9];
    const float* g2 = args.in[10]; const float* router_w = args.in[11]; const float* router_b = args.in[12]; const float* moe_w_in = args.in[13]; const float* moe_b_in = args.in[14];
    const float* moe_w_out = args.in[15]; const float* moe_b_out = args.in[16];
    float* out = args.out;
    float* RWP = (float*)(ws + WS_RWP); int* TOPE = (int*)(ws + WS_TOPE); float* TOPG = (float*)(ws + WS_TOPG); int* RANK = (int*)(ws + WS_RANK); int* SLOTOF = (int*)(ws + WS_SLOTOF);
    int* HIST = (int*)(ws + WS_HIST); int* TILEE = (int*)(ws + WS_TILEE); int* BUFTOK = (int*)(ws + WS_BUFTOK); float* GATESLOT = (float*)(ws + WS_GATESLOT); float* DEC = (float*)(ws + WS_DEC);
    bf16* WIN = (bf16*)(ws + WS_WIN); bf16* WOUT = (bf16*)(ws + WS_WOUT); bf16* WMIN = (bf16*)(ws + WS_WMIN); bf16* WMOUT = (bf16*)(ws + WS_WMOUT);
    bf16* H2 = (bf16*)(ws + WS_H2); bf16* YB = (bf16*)(ws + WS_Y); bf16* H1 = (bf16*)(ws + WS_H1); bf16* PROJ = (bf16*)(ws + WS_PROJ); float* GATE = (float*)(ws + WS_GATE);
    float* US = (float*)(ws + WS_US); bf16* MIX = (bf16*)(ws + WS_MIX); bf16* ACT = (bf16*)(ws + WS_ACT);

    for (int u = tid; u < (LDS_BYTES - LDSCTL_OFF) / 4; u += NTHR) ((LAS unsigned*)(lds + LDSCTL_OFF))[u] = 0u;
    __syncthreads();
    XcdBarrier bar; bar.bar = ctl + CW_BAR; bar.x = 0; bar.st = nullptr;
#if MK_ONE_LAUNCH
    bar = xcd_barrier_post(ctl + CW_BAR, MISC + 8);
#define GRID_BAR() xcd_barrier(bar)
#else
#define GRID_BAR() do { } while (0)
#endif
    const int lo = args.ph_lo, hi = args.ph_hi;
#define IN(k) (lo <= (k) && (k) < hi)
#define BOTH(k) (IN(k) && IN((k) + 1))
    const int gw = bx * NWAVES + wave, NGW = G * NWAVES;
    const int gthr = bx * NTHR + tid, NGT = G * NTHR;

    if (IN(0)) {
        LAS float* scr = (LAS float*)(lds + wave * 16384);
        constexpr int I_IN = 16 * 96, I_OUT = 16 * 32, I_MIN = 32 * 16 * 64, I_MOUT = 32 * 16 * 32, NITEMS = I_IN + I_OUT + I_MIN + I_MOUT;
        for (int it = gw; it < NITEMS; it += NGW) {
            int r = it;
            if (r < I_MIN) { const int e = r / 1024, q = r % 1024, kb = q / 64, nb = q % 64, ns0 = 32 * nb, f = ns0 & 1023, nd0 = 256 * (f >> 7) + ((ns0 >= 1024) ? 128 : 0) + (f & 127);
                p0_transpose_item(moe_w_in + (size_t)e * 1024 * 2048, 2048, WMIN + (size_t)e * 2048 * 1024, 1024, 64 * kb, ns0, nd0, scr, lane); continue; } r -= I_MIN;
            if (r < I_MOUT) { const int e = r / 512, q = r % 512, kb = q / 32, nb = q % 32;
                p0_transpose_item(moe_w_out + (size_t)e * 1024 * 1024, 1024, WMOUT + (size_t)e * 1024 * 1024, 1024, 64 * kb, 32 * nb, 32 * nb, scr, lane); continue; } r -= I_MOUT;
            if (r < I_IN) { const int kb = r / 96, nb = r % 96, nd0 = 32 * nb, ns0 = nd0 < 1024 ? nd0 : nd0 + 16;
                p0_transpose_item(w_in, W_IN_COLS, WIN, 1024, 64 * kb, ns0, nd0, scr, lane); continue; } r -= I_IN;
            { const int kb = r / 32, nb = r % 32; p0_transpose_item(w_out, 1024, WOUT, 1024, 64 * kb, 32 * nb, 32 * nb, scr, lane); }
        }
        for (int idx = gthr; idx < 256 * 1024; idx += NGT) { const int j = idx >> 10, d = idx & 1023; const float* wr_ = w_in + (size_t)d * W_IN_COLS + 1024; float s = 0.f;
#pragma unroll
            for (int r = 0; r < 16; ++r) s += wr_[r] * gate_up[r * 256 + j];
            WIN[(size_t)(3072 + j) * 1024 + d] = (bf16)f2bf(s); }
        for (int idx = gthr; idx < 1024 * 32; idx += NGT) RWP[idx] = router_w[idx] * g2[idx >> 5];
        for (int m = gw; m < NTOK; m += NGW) {
            const f32x4* xr = (const f32x4*)(x + (size_t)m * DM) + lane; const f32x4* gr = (const f32x4*)g1 + lane;
            f32x4 v[4]; float s = 0.f;
#pragma unroll
            for (int j = 0; j < 4; ++j) { v[j] = xr[64 * j]; s += (v[j].x * v[j].x + v[j].y * v[j].y) + (v[j].z * v[j].z + v[j].w * v[j].w); }
            const float r = 1.f / sqrtf(wave_sum(s) * (1.f / DM) + EPS);
            unsigned long long* o8 = (unsigned long long*)(H1 + (size_t)m * DM) + lane;
#pragma unroll
            for (int j = 0; j < 4; ++j) { const f32x4 gg = gr[64 * j]; o8[64 * j] = (unsigned long long)pk2(v[j].x * r * gg.x, v[j].y * r * gg.y) | ((unsigned long long)pk2(v[j].z * r * gg.z, v[j].w * r * gg.w) << 32); }
        }
        if (BOTH(0)) GRID_BAR();
    }

    if (IN(1)) {
        pg8::Gemm g{H1, WIN, 1024, nullptr}; pg8::StaticOrder S; S.init(NTOK / 256, NIN / 256, G, bx);
        EpiProj E{PROJ, GATE, gate_bias};
        pg8::gemm_phase<EpiProj, pg8::StaticOrder, true, false>(lds, g, S, E);
        if (BOTH(1)) GRID_BAR();
    }

    if (IN(2)) {
        LAS float* cum = ldsf;
        LAS float* kd = ldsf + 4096;
        LAS float* vs = ldsf + 8192;
        LAS float* segs = ldsf + 16384;
        LAS float* tot = ldsf + 16384 + 512;
        for (int un = bx; un < NCHT * 4; un += G) {
            const int chunk = un >> 2, h = un & 3; const size_t tok0 = (size_t)chunk * 64;
#pragma unroll
            for (int j = 0; j < 8; ++j) { const int idx = tid + 512 * j, c = idx >> 6, k = idx & 63; cum[idx] = GATE[(tok0 + c) * 256 + h * 64 + k]; }
            __syncthreads();
            { const int seg = tid >> 6, k = tid & 63; float run = 0.f;
#pragma unroll
              for (int i = 0; i < 8; ++i) { run += cum[(seg * 8 + i) * 64 + k]; cum[(seg * 8 + i) * 64 + k] = run; }
              segs[seg * 64 + k] = run; }
            __syncthreads();
            { const int seg = tid >> 6, k = tid & 63; float off = 0.f;
              for (int s = 0; s < seg; ++s) off += segs[s * 64 + k];
#pragma unroll
              for (int i = 0; i < 8; ++i) cum[(seg * 8 + i) * 64 + k] += off;
              if (seg == 7) tot[k] = off + segs[7 * 64 + k]; }
            __syncthreads();
#pragma unroll
            for (int j = 0; j < 2; ++j) { const int idx4 = tid + 512 * j, c = idx4 >> 4, k4 = (idx4 & 15) * 4;
                const v2u kw = *(const v2u*)(PROJ + (tok0 + c) * PW + C_GK + h * 64 + k4);
                const float kv[4] = {bflo(kw.x), bfhi(kw.x), bflo(kw.y), bfhi(kw.y)};
#pragma unroll
                for (int i = 0; i < 4; ++i) kd[c * 64 + k4 + i] = kv[i] * __expf(tot[k4 + i] - cum[c * 64 + k4 + i]); }
#pragma unroll
            for (int j = 0; j < 4; ++j) { const int idx4 = tid + 512 * j, c = idx4 >> 5, v4 = (idx4 & 31) * 4;
                const v2u vw = *(const v2u*)(PROJ + (tok0 + c) * PW + C_GV + h * 128 + v4);
                *(LAS f32x4*)(vs + c * 128 + v4) = (f32x4){bflo(vw.x), bfhi(vw.x), bflo(vw.y), bfhi(vw.y)}; }
            if (tid < 64) DEC[(size_t)chunk * 256 + h * 64 + tid] = __expf(tot[tid]);
            __syncthreads();
            { const int v0 = (tid >> 4) * 4, k0 = (tid & 15) * 4; f32x4 a0 = {0, 0, 0, 0}, a1 = a0, a2 = a0, a3 = a0;
#pragma unroll 8
              for (int c = 0; c < 64; ++c) { const f32x4 vv = *(const LAS f32x4*)(vs + c * 128 + v0), kk = *(const LAS f32x4*)(kd + c * 64 + k0);
                  a0 += kk * vv.x; a1 += kk * vv.y; a2 += kk * vv.z; a3 += kk * vv.w; }
              float* up = US + ((size_t)un * 128 + v0) * 64 + k0;
              *(f32x4*)(up) = a0; *(f32x4*)(up + 64) = a1; *(f32x4*)(up + 128) = a2; *(f32x4*)(up + 192) = a3; }
            __syncthreads();
        }
        for (int m = gw; m < NTOK; m += NGW) {
            bf16* p = PROJ + (size_t)m * PW + C_AQ + 16 * lane;
            const v4u w0 = *(const v4u*)p, w1 = *(const v4u*)(p + 8);
            float v[16] = {bflo(w0.x), bfhi(w0.x), bflo(w0.y), bfhi(w0.y), bflo(w0.z), bfhi(w0.z), bflo(w0.w), bfhi(w0.w), bflo(w1.x), bfhi(w1.x), bflo(w1.y), bfhi(w1.y), bflo(w1.z), bfhi(w1.z), bflo(w1.w), bfhi(w1.w)};
            float s = 0.f;
#pragma unroll
            for (int i = 0; i < 16; ++i) s += v[i] * v[i];
            s += __shfl_xor(s, 1); s += __shfl_xor(s, 2);
            const float r = 1.f / sqrtf(s * (1.f / 64.f) + EPS);
            const int d0 = (16 * lane) & 63;
#pragma unroll
            for (int i = 0; i < 16; ++i) { const float sc = (lane < 32) ? r * qng[d0 + i] * kng[d0 + i] * C2 : r; v[i] *= sc; }
            v4u o0, o1; o0.x = pk2(v[0], v[1]); o0.y = pk2(v[2], v[3]); o0.z = pk2(v[4], v[5]); o0.w = pk2(v[6], v[7]); o1.x = pk2(v[8], v[9]); o1.y = pk2(v[10], v[11]); o1.z = pk2(v[12], v[13]); o1.w = pk2(v[14], v[15]);
            *(v4u*)p = o0; *(v4u*)(p + 8) = o1;
        }
        if (BOTH(2)) GRID_BAR();
    }

    if (IN(3)) {
        for (int e = gthr; e < 65536; e += NGT) {
            const int b = e >> 15, idx = e & 32767, hk = ((idx >> 13) << 6) + (idx & 63);
            float* up = US + (size_t)b * 256 * 32768 + idx; const float* dp = DEC + (size_t)b * 256 * 256 + hk;
            float s = 0.f;
            for (int n = 0; n < 256; n += 8) { float uu[8], dd[8];
#pragma unroll
                for (int i = 0; i < 8; ++i) { uu[i] = up[(size_t)(n + i) * 32768]; dd[i] = dp[(size_t)(n + i) * 256]; }
#pragma unroll
                for (int i = 0; i < 8; ++i) { s = dd[i] * s + uu[i]; up[(size_t)(n + i) * 32768] = s; } }
        }
        {
            const attn_body::AttnTensors AT{(const attn_body::bf16*)(PROJ + C_AQ), (const attn_body::bf16*)(PROJ + C_AK), (const attn_body::bf16*)(PROJ + C_AV), (attn_body::bf16*)(MIX + 512), rel_bias};
            const attn_body::StaticOrder S(G, bx);
            attn_body::attn_phase<attn_body::StaticOrder>((char*)lds_raw, AT, S);
        }
        if (BOTH(3)) GRID_BAR();
    }

    if (IN(4)) {
        LAS float* qT = ldsf;
        LAS float* ST = ldsf + 64 * 68;
        for (int un = bx; un < NCHT * 4; un += G) {
            const int chunk = un >> 2, h = un & 3; const size_t tok0 = (size_t)chunk * 64;
#pragma unroll
            for (int j = 0; j < 2; ++j) { const int idx4 = tid + 512 * j, c = idx4 >> 4, k4 = (idx4 & 15) * 4;
                const v2u qw = *(const v2u*)(PROJ + (tok0 + c) * PW + C_GQ + h * 64 + k4);
                qT[(k4 + 0) * 68 + c] = bflo(qw.x) * 0.125f; qT[(k4 + 1) * 68 + c] = bfhi(qw.x) * 0.125f; qT[(k4 + 2) * 68 + c] = bflo(qw.y) * 0.125f; qT[(k4 + 3) * 68 + c] = bfhi(qw.y) * 0.125f; }
#pragma unroll
            for (int j = 0; j < 4; ++j) { const int idx4 = tid + 512 * j, v = idx4 >> 4, k4 = (idx4 & 15) * 4;
                const f32x4 sv = *(const f32x4*)(US + ((size_t)un * 128 + v) * 64 + k4);
                ST[(k4 + 0) * 132 + v] = sv.x; ST[(k4 + 1) * 132 + v] = sv.y; ST[(k4 + 2) * 132 + v] = sv.z; ST[(k4 + 3) * 132 + v] = sv.w; }
            __syncthreads();
            const int c0 = (tid >> 5) * 4, v0 = (tid & 31) * 4; f32x4 a[4]; a[0] = (f32x4){0, 0, 0, 0}; a[1] = a[0]; a[2] = a[0]; a[3] = a[0];
#pragma unroll 8
            for (int k = 0; k < 64; ++k) { const f32x4 qq = *(const LAS f32x4*)(qT + k * 68 + c0), ss = *(const LAS f32x4*)(ST + k * 132 + v0);
                a[0] += ss * qq.x; a[1] += ss * qq.y; a[2] += ss * qq.z; a[3] += ss * qq.w; }
            const f32x4 gn = *(const f32x4*)(gla_ng + v0);
#pragma unroll
            for (int i = 0; i < 4; ++i) { float ssq = (a[i].x * a[i].x + a[i].y * a[i].y) + (a[i].z * a[i].z + a[i].w * a[i].w);
                ssq += __shfl_xor(ssq, 1); ssq += __shfl_xor(ssq, 2); ssq += __shfl_xor(ssq, 4); ssq += __shfl_xor(ssq, 8); ssq += __shfl_xor(ssq, 16);
                const float r = 1.f / sqrtf(ssq * (1.f / 128.f) + EPS);
                const v2u gw_ = *(const v2u*)(PROJ + (tok0 + c0 + i) * PW + C_OG + h * 128 + v0);
                const float og[4] = {bflo(gw_.x), bfhi(gw_.x), bflo(gw_.y), bfhi(gw_.y)}; float ov[4];
#pragma unroll
                for (int j = 0; j < 4; ++j) { const float sg = og[j] / (1.f + __expf(-og[j])); ov[j] = a[i][j] * r * gn[j] * sg; }
                v2u w; w.x = pk2(ov[0], ov[1]); w.y = pk2(ov[2], ov[3]);
                *(v2u*)(MIX + (tok0 + c0 + i) * DM + h * 128 + v0) = w; }
            __syncthreads();
        }
        if (BOTH(4)) GRID_BAR();
    }

    if (IN(5)) {
        pg8::Gemm g{MIX, WOUT, 1024, nullptr}; pg8::StaticOrder S; S.init(NTOK / 256, 4, G, bx);
        EpiResid E{x, out};
        pg8::gemm_phase<EpiResid, pg8::StaticOrder, true, false>(lds, g, S, E);
        if (BOTH(5)) GRID_BAR();
    }

    if (IN(6)) {
        LAS float* rstd = ldsf;
        LAS int* lh = (LAS int*)(ldsf + 128);
        for (int blk = bx; blk < 256; blk += G) {
            const int t0 = blk * 128;
            if (tid < 32) lh[tid] = 0;
            f32x16 acc;
#pragma unroll
            for (int i = 0; i < 16; ++i) acc[i] = 0.f;
            if (wave >= 4) {
                const f32x4* gr = (const f32x4*)g2 + lane;
                for (int j = 0; j < 32; ++j) { const int tl = (wave - 4) * 32 + j; const size_t m = (size_t)t0 + tl;
                    const f32x4* xr = (const f32x4*)(out + m * DM) + lane; f32x4 v[4]; float s = 0.f;
#pragma unroll
                    for (int jj = 0; jj < 4; ++jj) { v[jj] = xr[64 * jj]; s += (v[jj].x * v[jj].x + v[jj].y * v[jj].y) + (v[jj].z * v[jj].z + v[jj].w * v[jj].w); }
                    const float r = 1.f / sqrtf(wave_sum(s) * (1.f / DM) + EPS);
                    unsigned long long* o8 = (unsigned long long*)(H2 + m * DM) + lane;
#pragma unroll
                    for (int jj = 0; jj < 4; ++jj) { const f32x4 gg = gr[64 * jj]; o8[64 * jj] = (unsigned long long)pk2(v[jj].x * r * gg.x, v[jj].y * r * gg.y) | ((unsigned long long)pk2(v[jj].z * r * gg.z, v[jj].w * r * gg.w) << 32); }
                    if (lane == 0) rstd[tl] = r; }
            } else {
                const int half = lane >> 5, l31 = lane & 31; const size_t m = (size_t)t0 + wave * 32 + l31;
                const float* xp = out + m * DM + 4 * half; const float* wp = RWP + (4 * half) * 32 + l31;
                for (int mm = 0; mm < 128; ++mm) { const f32x4 xv = *(const f32x4*)(xp + 8 * mm);
#pragma unroll
                    for (int i = 0; i < 4; ++i) { const float a = wp[(8 * mm + i) * 32]; acc = __builtin_amdgcn_mfma_f32_32x32x2f32(a, xv[i], acc, 0, 0, 0); } }
            }
            __syncthreads();
            if (wave < 4) {
                const int half = lane >> 5, l31 = lane & 31, tl = wave * 32 + l31; const float r = rstd[tl];
                float bv[4] = {-3e38f, -3e38f, -3e38f, -3e38f}; int bi[4] = {0, 0, 0, 0};
#pragma unroll
                for (int reg = 0; reg < 16; ++reg) { const int e = (reg & 3) + 8 * (reg >> 2) + 4 * half; float v = acc[reg] * r + router_b[e]; int id = e;
#pragma unroll
                    for (int s = 0; s < 4; ++s) { const bool gt = v > bv[s]; const float tv = gt ? bv[s] : v; const int ti = gt ? bi[s] : id; bv[s] = gt ? v : bv[s]; bi[s] = gt ? id : bi[s]; v = tv; id = ti; } }
                float ov[4]; int oi[4];
#pragma unroll
                for (int s = 0; s < 4; ++s) { ov[s] = __shfl_xor(bv[s], 32); oi[s] = __shfl_xor(bi[s], 32); }
#pragma unroll
                for (int c = 0; c < 4; ++c) { float v = ov[c]; int id = oi[c];
#pragma unroll
                    for (int s = 0; s < 4; ++s) { const bool gt = (v > bv[s]) || (v == bv[s] && id < bi[s]); const float tv = gt ? bv[s] : v; const int ti = gt ? bi[s] : id; bv[s] = gt ? v : bv[s]; bi[s] = gt ? id : bi[s]; v = tv; id = ti; } }
                if (half == 0) {
                    const float e1 = __expf(bv[1] - bv[0]), e2 = __expf(bv[2] - bv[0]), e3 = __expf(bv[3] - bv[0]); const float inv = 1.f / (1.f + e1 + e2 + e3);
                    const size_t m = (size_t)t0 + tl;
                    *(f32x4*)(TOPG + m * 4) = (f32x4){inv, e1 * inv, e2 * inv, e3 * inv};
                    int rk[4];
#pragma unroll
                    for (int s = 0; s < 4; ++s) rk[s] = atomicAdd((int*)&lh[bi[s]], 1);
                    *(v4u*)(TOPE + m * 4) = (v4u){(unsigned)bi[0], (unsigned)bi[1], (unsigned)bi[2], (unsigned)bi[3]};
                    *(v4u*)(RANK + m * 4) = (v4u){(unsigned)rk[0], (unsigned)rk[1], (unsigned)rk[2], (unsigned)rk[3]};
                }
            }
            __syncthreads();
            if (tid < 32) HIST[blk * 32 + tid] = lh[tid];
            __syncthreads();
        }
        if (BOTH(6)) GRID_BAR();
    }

    if (IN(7)) {
        LAS int* ptot = (LAS int*)ldsf;
        LAS int* pbase = ptot + 512;
        LAS int* tot = pbase + 512;
        LAS int* pstart = tot + 32;
        LAS int* sbase = pstart + 32;
        for (int blk = bx; blk < 256; blk += G) {
            { const int e = tid & 31, part = tid >> 5; int a = 0, b = 0;
              for (int i = 0; i < 16; ++i) { const int bb = part * 16 + i; const int hv = HIST[bb * 32 + e]; a += hv; b += (bb < blk) ? hv : 0; }
              ptot[part * 32 + e] = a; pbase[part * 32 + e] = b; }
            __syncthreads();
            if (tid < 32) { int a = 0, b = 0; for (int p = 0; p < 16; ++p) { a += ptot[p * 32 + tid]; b += pbase[p * 32 + tid]; } tot[tid] = a; sbase[tid] = b; }
            __syncthreads();
            if (tid < 32) { int ps = 0; for (int e = 0; e < tid; ++e) ps += (tot[e] + 255) & ~255; pstart[tid] = ps; sbase[tid] += ps; }
            __syncthreads();
            { const int tl = tid >> 2, k = tid & 3; const size_t m = (size_t)blk * 128 + tl; const int e = TOPE[m * 4 + k]; const int slot = sbase[e] + RANK[m * 4 + k];
              BUFTOK[slot] = (int)m; GATESLOT[slot] = TOPG[m * 4 + k]; SLOTOF[m * 4 + k] = slot; }
            if (blk < 32) { const int e = blk, ps = pstart[e], te = tot[e], pe = (te + 255) & ~255;
                if (tid < 256 && te + tid < pe) { BUFTOK[ps + te + tid] = 0; GATESLOT[ps + te + tid] = 0.f; }
                for (int t = tid; t < pe / 256; t += NTHR) TILEE[ps / 256 + t] = e;
                if (e == 31 && tid == 0) TILEE[1023] = (ps + pe) / 256; }
            __syncthreads();
        }
        if (BOTH(7)) GRID_BAR();
    }

    if (IN(8)) {
        const int nT = TILEE[1023];
        pg8::Gemm g{H2, WMIN, 1024, BUFTOK}; pg8::MoeOrder S; S.init(nT, 8, G, bx, TILEE);
        EpiSwiglu E{ACT, moe_b_in};
        pg8::gemm_phase<EpiSwiglu, pg8::MoeOrder, true, true>(lds, g, S, E);
        if (BOTH(8)) GRID_BAR();
    }

    if (IN(9)) {
        const int nT = TILEE[1023];
        pg8::Gemm g{ACT, WMOUT, 1024, nullptr}; pg8::MoeOrder S; S.init(nT, 4, G, bx, TILEE);
        EpiY E{YB, moe_b_out, GATESLOT};
        pg8::gemm_phase<EpiY, pg8::MoeOrder, true, false>(lds, g, S, E);
        if (BOTH(9)) GRID_BAR();
    }

    if (IN(10)) {
        for (int m = gw; m < NTOK; m += NGW) {
            const v4u sl = *(const v4u*)(SLOTOF + (size_t)m * 4);
            float* op = out + (size_t)m * DM;
#pragma unroll
            for (int j = 0; j < 2; ++j) { const int col = 8 * lane + 512 * j;
                f32x4 a0 = *(const f32x4*)(op + col), a1 = *(const f32x4*)(op + col + 4);
#pragma unroll
                for (int k = 0; k < 4; ++k) { const v4u w = *(const v4u*)(YB + (size_t)sl[k] * 1024 + col);
                    a0.x += bflo(w.x); a0.y += bfhi(w.x); a0.z += bflo(w.y); a0.w += bfhi(w.y); a1.x += bflo(w.z); a1.y += bfhi(w.z); a1.z += bflo(w.w); a1.w += bfhi(w.w); }
                *(f32x4*)(op + col) = a0; *(f32x4*)(op + col + 4) = a1; }
        }
    }
#undef IN
#undef BOTH
}

extern "C" void kernel_launch(void* const* d_in, const int* in_sizes, int n_in, void* d_out, int out_size, void* d_ws, size_t ws_size, hipStream_t stream) {
    static int grid = 0;
    if (grid == 0) {
        if (n_in != 17 || in_sizes[0] != NTOK * DM || out_size != NTOK * DM || ws_size < WS_END) { fprintf(stderr, "kernel_launch: unexpected shapes (n_in %d, in0 %d, out %d, ws %zu)\n", n_in, n_in > 0 ? in_sizes[0] : -1, out_size, ws_size); grid = -1; return; }
        int dev = 0, cus = 0, per_cu = 0;
        if (hipGetDevice(&dev) != hipSuccess || hipDeviceGetAttribute(&cus, hipDeviceAttributeMultiprocessorCount, dev) != hipSuccess) { grid = -1; return; }
        if (hipFuncSetAttribute((const void*)fwd, hipFuncAttributeMaxDynamicSharedMemorySize, LDS_BYTES) != hipSuccess) { fprintf(stderr, "kernel_launch: hipFuncSetAttribute failed\n"); grid = -1; return; }
        if (hipOccupancyMaxActiveBlocksPerMultiprocessor(&per_cu, (const void*)fwd, NTHR, LDS_BYTES) != hipSuccess || per_cu < 1) fprintf(stderr, "kernel_launch: occupancy query reports %d\n", per_cu);
        (void)hipGetLastError();
        grid = cus;
    }
    if (grid < 0) return;
    (void)hipMemsetAsync((char*)d_ws + WS_CTL, 0, CTL_ZERO_BYTES, stream);
    Args a{};
    for (int i = 0; i < 17; ++i) a.in[i] = (const float*)d_in[i];
    a.out = (float*)d_out; a.ws = (unsigned char*)d_ws; a.li = 0; a.pad = 0;
#if MK_ONE_LAUNCH
    a.ph_lo = 0; a.ph_hi = NPHASE;
    hipLaunchKernelGGL(fwd, dim3(grid), dim3(NTHR), LDS_BYTES, stream, a);
#else
    for (int p = 0; p < NPHASE; ++p) { a.ph_lo = p; a.ph_hi = p + 1; hipLaunchKernelGGL(fwd, dim3(grid), dim3(NTHR), LDS_BYTES, stream, a); }
#endif
}
```

```cpp
#include <hip/hip_runtime.h>
#include <cstdio>
#include <cstdint>

#ifndef MK_ONE_LAUNCH
#define MK_ONE_LAUNCH 1
#endif
#ifndef PROBE_DUP
#define PROBE_MULTI 0
#define PROBE_DUP -1
#define PROBE_FLAGS 0
#endif

namespace pg8 {
#define PG8_LAS __attribute__((address_space(3)))
typedef unsigned short bf16_t;
typedef short bf16x8 __attribute__((ext_vector_type(8)));
typedef float f32x4 __attribute__((ext_vector_type(4)));
typedef unsigned u32x4 __attribute__((ext_vector_type(4)));
constexpr int BM = 256, BK = 64, HALF = 128, HTB = HALF * BK * 2, STAGE_BYTES = 8 * HTB, NXCD = 8, WGM = 8;

__host__ __device__ __forceinline__ int lds_byte(int r, int c) { const int st = (r >> 4) * 2 + (c >> 5), rr = r & 15, cc = c & 31, ob = rr * 64 + cc * 2; return st * 1024 + (ob ^ (((ob >> 9) & 1) << 5)); }
__host__ __device__ __forceinline__ void stage_rc(int b, int& R, int& C) { const int st = b / 1024, sb = b % 1024, swz = sb ^ (((sb >> 9) & 1) << 5); R = (st >> 1) * 16 + swz / 64; C = (st & 1) * 32 + (swz % 64) / 2; }
__host__ __device__ __forceinline__ int perm32(int rho) { const int n = rho >> 4, i = rho & 15; return 8 * (i >> 2) + 4 * n + (i & 3); }

struct Unit { int pm, pn, pb, e; };
struct Gemm { const void* A; const void* Bt; int kbytes; const int* rowtok; };
typedef int v4i_t __attribute__((ext_vector_type(4)));
typedef int v8i_t __attribute__((ext_vector_type(8)));

__device__ __forceinline__ bool tile_of(long L, int nM, int nN, int& pm, int& pn) {
    const int nwg = nM * nN; if (L >= nwg) return false;
    int wgid = (int)L; { const int q = nwg / NXCD, r = nwg % NXCD, xcd = wgid % NXCD, off = wgid / NXCD; wgid = (xcd < r ? xcd * (q + 1) : r * (q + 1) + (xcd - r) * q) + off; }
    const int nig = WGM * nN, gid = wgid / nig, fm = gid * WGM, gsz = (nM - fm) < WGM ? (nM - fm) : WGM;
    pm = fm + ((wgid % nig) % gsz); pn = (wgid % nig) / gsz; return true;
}
__device__ __forceinline__ bool short_block(int nwg, int G, int c) { const int rounds = (nwg + G - 1) / G; return (nwg % G) != 0 && (long)(rounds - 1) * G + c >= nwg; }
struct StaticOrder {
    int nM, nN, G, c;
    __device__ void init(int nM_, int nN_, int G_, int c_) { nM = nM_; nN = nN_; G = G_; c = c_; }
    __device__ __forceinline__ bool next(int i, Unit& u) const { if (!tile_of((long)i * G + c, nM, nN, u.pm, u.pn)) return false; u.pb = u.pn; u.e = 0; return true; }
    __device__ __forceinline__ bool next_lane(int i, Unit& u) const { return next(i, u); }
};
struct MoeOrder {
    int nM, nN, G, c; const int* tile_e;
    __device__ void init(int nM_, int nN_, int G_, int c_, const int* te) { nM = nM_; nN = nN_; G = G_; c = c_; tile_e = te; }
    __device__ __forceinline__ bool next(int i, Unit& u) const { if (!tile_of((long)i * G + c, nM, nN, u.pm, u.pn)) return false; u.e = __builtin_amdgcn_readfirstlane(__hip_atomic_load(tile_e + u.pm, __ATOMIC_RELAXED, __HIP_MEMORY_SCOPE_AGENT)); u.pb = u.e * nN + u.pn; return true; }
    __device__ __forceinline__ bool next_lane(int i, Unit& u) const { if (!tile_of((long)i * G + c, nM, nN, u.pm, u.pn)) return false; u.e = __hip_atomic_load(tile_e + u.pm, __ATOMIC_RELAXED, __HIP_MEMORY_SCOPE_AGENT); u.pb = u.e * nN + u.pn; return true; }
};

template <class Inner> struct TableOrder {
    const Inner* S; PG8_LAS int* tab;
    __device__ __forceinline__ void build(const Inner* S_, PG8_LAS int* tab_) { S = S_; tab = tab_;
        if (threadIdx.x < 64) { Unit u; const bool ok = S->next_lane((int)threadIdx.x, u); PG8_LAS int* t = tab + 4 * threadIdx.x; t[0] = ok ? u.pm : -1; t[1] = u.pn; t[2] = u.pb; t[3] = u.e; }
        __syncthreads(); }
    __device__ __forceinline__ bool next(int i, Unit& u) const { if (i >= 64) return S->next(i, u);
        const v4i_t t = *(const PG8_LAS v4i_t*)(tab + 4 * i); u.pm = __builtin_amdgcn_readfirstlane(t[0]); u.pn = __builtin_amdgcn_readfirstlane(t[1]); u.pb = __builtin_amdgcn_readfirstlane(t[2]); u.e = __builtin_amdgcn_readfirstlane(t[3]); return u.pm >= 0; }
};
__device__ __forceinline__ unsigned cvt_pk_bf16(float lo, float hi) { unsigned r; asm volatile("v_cvt_pk_bf16_f32 %0, %1, %2" : "=v"(r) : "v"(lo), "v"(hi)); return r; }

template <bool FP8> struct FragT;
template <> struct FragT<false> { struct type { bf16x8 f[2]; }; };
template <> struct FragT<true> { struct type { v8i_t v; }; };
template <class Epi, class Sched, bool ALIGN_EPI, bool GATHER, bool FP8>
__device__ __forceinline__ void gemm_phase(PG8_LAS unsigned char* lds, const Gemm g, const Sched& S, const Epi& E, PG8_LAS unsigned char* side) {
    const int delay_ticks = 0;
    const int tid = threadIdx.x, wid = __builtin_amdgcn_readfirstlane(tid >> 6), lane = tid & 63, wr = wid >> 2, wc = wid & 3, fr = lane & 15, fq = lane >> 4;
    const int KB = g.kbytes, nt = KB / 128;
    const size_t kstep = (size_t)128;
    const size_t hstep = (size_t)HALF * KB;
    const size_t tstep = 2 * hstep;
    const size_t bhstep = Epi::HEADPERM ? (size_t)32 * KB : hstep;
    int RA[2]; unsigned CA2[2], voffB[2];
#pragma unroll
    for (int i = 0; i < 2; ++i) { int R, C; stage_rc(tid * 16 + i * 8192, R, C); const int Rb = Epi::HEADPERM ? (64 * (R >> 5) + perm32(R & 31)) : (Epi::PERM ? ((R & ~31) + perm32(R & 31)) : R);
        RA[i] = R; CA2[i] = (unsigned)C * 2u; voffB[i] = (unsigned)(Rb * KB) + (unsigned)C * 2u; }
    const unsigned ldsw = (unsigned)wid * 1024u;
    const int aoff = lds_byte(wr * 64 + fr, fq * 8), boff = lds_byte(wc * 32 + fr, fq * 8);
#define PG8_SA(b, h) (((b) * 2 + (h)) * HTB)
#define PG8_SB(b, h) ((4 + (b) * 2 + (h)) * HTB)
#define PG8_STAGE(bufoff, gbase, voff) do { _Pragma("unroll") for (int _i = 0; _i < 2; ++_i) \
        __builtin_amdgcn_global_load_lds((const unsigned*)((const char*)(gbase) + (voff)[_i]), (PG8_LAS unsigned*)(lds + (bufoff) + ldsw + _i * 8192), 16, 0, 0); } while (0)
#define PG8_LDF(dst, addr) do { if constexpr (FP8) { const v4i_t lo_ = *(const PG8_LAS v4i_t*)(addr), hi_ = *(const PG8_LAS v4i_t*)((addr) + 1024); dst.v = __builtin_shufflevector(lo_, hi_, 0, 1, 2, 3, 4, 5, 6, 7); } \
        else { dst.f[0] = *(const PG8_LAS bf16x8*)(addr); dst.f[1] = *(const PG8_LAS bf16x8*)((addr) + 1024); } } while (0)
#define PG8_LDA(dst, b, h) do { _Pragma("unroll") for (int m = 0; m < 4; ++m) PG8_LDF(dst[m], lds + PG8_SA(b, h) + aoff + m * 2048); } while (0)
#define PG8_LDB(dst, b, h) do { _Pragma("unroll") for (int n = 0; n < 2; ++n) PG8_LDF(dst[n], lds + PG8_SB(b, h) + boff + n * 2048); } while (0)
#define PG8_MMA(ai, bj, At, Bt) do { __builtin_amdgcn_s_setprio(1); _Pragma("unroll") for (int m = 0; m < 4; ++m) _Pragma("unroll") for (int n = 0; n < 2; ++n) { \
        if constexpr (FP8) asm volatile("s_nop 1\n\tv_mfma_f32_16x16x128_f8f6f4 %0, %1, %2, %0" : "+v"(acc[ai][bj][m][n]) : "v"(Bt[n].v), "v"(At[m].v)); \
        else { _Pragma("unroll") for (int k = 0; k < 2; ++k) acc[ai][bj][m][n] = __builtin_amdgcn_mfma_f32_16x16x32_bf16(Bt[n].f[k], At[m].f[k], acc[ai][bj][m][n], 0, 0, 0); } } __builtin_amdgcn_s_setprio(0); } while (0)
#define PG8_WAIT_V(n) asm volatile("s_waitcnt vmcnt(" #n ")" ::: "memory")
#define PG8_WAIT_L(n) asm volatile("s_waitcnt lgkmcnt(" #n ")" ::: "memory")
#define PG8_BAR __builtin_amdgcn_s_barrier()
#define PG8_SCHED __builtin_amdgcn_sched_barrier(0)
#define PG8_AOFF(dst, u) do { _Pragma("unroll") for (int h_ = 0; h_ < 2; ++h_) _Pragma("unroll") for (int i_ = 0; i_ < 2; ++i_) { \
        if constexpr (GATHER) { const int tok_ = g.rowtok[(u).pm * BM + h_ * HALF + RA[i_]]; dst[h_][i_] = (unsigned)tok_ * (unsigned)KB + CA2[i_]; } \
        else { dst[h_][i_] = (unsigned)(RA[i_] * KB) + CA2[i_] + (unsigned)(h_ * (int)hstep); } } } while (0)
#define PG8_ABASE(u) ((const char*)g.A + (GATHER ? (size_t)0 : (size_t)(u).pm * tstep))
    Unit cur, nxt; int ui = 0;
    if (!S.next(0, cur)) return;
    if (delay_ticks > 0) { const unsigned long long t0_ = __builtin_amdgcn_s_memrealtime(); while ((long long)(__builtin_amdgcn_s_memrealtime() - t0_) < (long long)delay_ticks) __builtin_amdgcn_s_sleep(16); }
    f32x4 acc[2][2][4][2];
#pragma unroll
    for (int a = 0; a < 2; ++a)
#pragma unroll
        for (int b = 0; b < 2; ++b)
#pragma unroll
            for (int m = 0; m < 4; ++m)
#pragma unroll
                for (int n = 0; n < 2; ++n) acc[a][b][m][n] = (f32x4){0.f, 0.f, 0.f, 0.f};
    typedef typename FragT<FP8>::type frag_t;
    frag_t At[4], B0[2], B1[2];
    unsigned vA[2][2], nvA[2][2];
    PG8_AOFF(vA, cur);
#pragma unroll
    for (int h_ = 0; h_ < 2; ++h_) { nvA[h_][0] = vA[h_][0]; nvA[h_][1] = vA[h_][1]; }
    const char* cA = PG8_ABASE(cur); const char* cB = (const char*)g.Bt + (size_t)cur.pb * tstep;
    PG8_STAGE(PG8_SB(0, 0), cB, voffB); PG8_STAGE(PG8_SB(0, 1), cB + bhstep, voffB); PG8_STAGE(PG8_SA(0, 0), cA, vA[0]); PG8_STAGE(PG8_SA(0, 1), cA, vA[1]);
    if (wr == 1) PG8_BAR;
    PG8_WAIT_V(2); PG8_BAR;
    PG8_STAGE(PG8_SB(1, 0), cB + kstep, voffB); PG8_STAGE(PG8_SA(1, 0), cA + kstep, vA[0]); PG8_STAGE(PG8_SB(1, 1), cB + bhstep + kstep, voffB);
    PG8_WAIT_V(6); PG8_BAR;
    PG8_STAGE(PG8_SA(1, 1), cA + kstep, vA[1]);
    for (;;) {
        const bool has_next = S.next(ui + 1, nxt);
        const char* nA = has_next ? PG8_ABASE(nxt) : cA; const char* nB = has_next ? (const char*)g.Bt + (size_t)nxt.pb * tstep : cB;
#pragma clang loop unroll(disable)
        for (int t = 0; t < nt; t += 2) {
            const bool last = (t == nt - 2);
            const char* a1 = cA + (size_t)(t + 1) * kstep;
            const char* a2 = last ? nA : cA + (size_t)(t + 2) * kstep; const char* b2 = last ? nB : cB + (size_t)(t + 2) * kstep;
            const char* a3 = a2 + kstep; const char* b3 = b2 + kstep;
            if constexpr (GATHER) { if (last && has_next) {
#pragma unroll
                for (int h_ = 0; h_ < 2; ++h_)
#pragma unroll
                    for (int i_ = 0; i_ < 2; ++i_) nvA[h_][i_] = (unsigned)(*(const PG8_LAS int*)(side + 2048 + (h_ * HALF + RA[i_]) * 4)) * (unsigned)KB + CA2[i_]; } }
            unsigned sA[2][2];
#pragma unroll
            for (int h_ = 0; h_ < 2; ++h_)
#pragma unroll
                for (int i_ = 0; i_ < 2; ++i_) sA[h_][i_] = (GATHER && last && has_next) ? nvA[h_][i_] : vA[h_][i_];
            const bool post_epi = (t == 0) && (ui > 0);
#define PG8_WAIT_VS() do { if (post_epi) asm volatile("s_waitcnt vmcnt(%0)" :: "i"(Epi::NSTORE + 8) : "memory"); else PG8_WAIT_V(8); } while (0)
            PG8_LDB(B0, 0, 0); PG8_LDB(B1, 0, 1); PG8_SCHED; PG8_LDA(At, 0, 0); if (t != 0) PG8_STAGE(PG8_SA(1, 1), a1, vA[1]);
            PG8_WAIT_VS(); PG8_WAIT_L(0); PG8_BAR; PG8_MMA(0, 0, At, B0); PG8_MMA(0, 1, At, B1); PG8_BAR; PG8_SCHED;
            PG8_LDA(At, 0, 1); PG8_STAGE(PG8_SB(0, 0), b2, voffB); PG8_STAGE(PG8_SB(0, 1), b2 + bhstep, voffB); PG8_STAGE(PG8_SA(0, 0), a2, sA[0]);
            if constexpr (Epi::SIDE) { if (t == 0) {
                __builtin_amdgcn_global_load_lds((const unsigned*)E.side_src(cur, nxt, has_next, wid & 3, lane), (PG8_LAS unsigned*)(side + (wid & 3) * 1024), 16, 0, 0); } }
            PG8_WAIT_VS(); PG8_WAIT_L(0); PG8_BAR; PG8_MMA(1, 0, At, B0); PG8_MMA(1, 1, At, B1); PG8_BAR; PG8_SCHED;
            PG8_LDB(B0, 1, 0); PG8_LDB(B1, 1, 1); PG8_SCHED; PG8_LDA(At, 1, 0); PG8_STAGE(PG8_SA(0, 1), a2, sA[1]);
            PG8_WAIT_VS(); PG8_WAIT_L(0); PG8_BAR; PG8_MMA(0, 0, At, B0); PG8_MMA(0, 1, At, B1); PG8_BAR; PG8_SCHED;
            PG8_LDA(At, 1, 1); PG8_STAGE(PG8_SB(1, 0), b3, voffB); PG8_STAGE(PG8_SB(1, 1), b3 + bhstep, voffB); PG8_STAGE(PG8_SA(1, 0), a3, sA[0]);
            PG8_WAIT_V(8); PG8_WAIT_L(0); PG8_BAR; PG8_MMA(1, 0, At, B0); PG8_MMA(1, 1, At, B1); PG8_BAR; PG8_SCHED;
            if (last) PG8_STAGE(PG8_SA(1, 1), a3, sA[1]);
#undef PG8_WAIT_VS
        }
        if constexpr (ALIGN_EPI) { if (wr == 0) PG8_BAR; }
        if constexpr (FP8) {
#define PG8_PIN8(a, b, s) asm volatile(s : "+v"(acc[a][b][0][0]), "+v"(acc[a][b][0][1]), "+v"(acc[a][b][1][0]), "+v"(acc[a][b][1][1]), "+v"(acc[a][b][2][0]), "+v"(acc[a][b][2][1]), "+v"(acc[a][b][3][0]), "+v"(acc[a][b][3][1]))
            PG8_PIN8(0, 0, "s_nop 15\n\ts_nop 7"); PG8_PIN8(0, 1, ""); PG8_PIN8(1, 0, ""); PG8_PIN8(1, 1, "");
#undef PG8_PIN8
        }
        E(acc, cur, wr, wc, fr, fq, side);
        if (!has_next) break;
#pragma unroll
        for (int a = 0; a < 2; ++a)
#pragma unroll
            for (int b = 0; b < 2; ++b)
#pragma unroll
                for (int m = 0; m < 4; ++m)
#pragma unroll
                    for (int n = 0; n < 2; ++n) acc[a][b][m][n] = (f32x4){0.f, 0.f, 0.f, 0.f};
        cur = nxt; cA = nA; cB = nB; ++ui;
        if constexpr (GATHER) {
#pragma unroll
            for (int h_ = 0; h_ < 2; ++h_) { vA[h_][0] = nvA[h_][0]; vA[h_][1] = nvA[h_][1]; } }
        if constexpr (ALIGN_EPI) { if (wr == 1) PG8_BAR; }
    }
    PG8_WAIT_V(0);
    if constexpr (!ALIGN_EPI) { if (wr == 0) PG8_BAR; }
    PG8_BAR;
#undef PG8_SA
#undef PG8_SB
#undef PG8_STAGE
#undef PG8_LDA
#undef PG8_LDB
#undef PG8_MMA
#undef PG8_LDF
#undef PG8_WAIT_V
#undef PG8_WAIT_L
#undef PG8_BAR
#undef PG8_SCHED
#undef PG8_AOFF
#undef PG8_ABASE
}
}

#include <hip/hip_bf16.h>
#include <cmath>
namespace attn_body {
using bf16=__hip_bfloat16;
using bf16x8=__attribute__((ext_vector_type(8)))short;
using s16x4=__attribute__((ext_vector_type(4)))short;
using f32x16=__attribute__((ext_vector_type(16)))float;
using u32x4=__attribute__((ext_vector_type(4)))unsigned;
constexpr int BATCH=2,NHEAD=8,SEQ=16384,D=64,DM=3072,OP=1024;
constexpr int NW=8,QBLK=32,QB=QBLK*NW,KVBLK=64,NQB=SEQ/QB;
constexpr int ATTN_PITCH=DM, ATTN_UNIT_ROWS=QB;
__device__ __forceinline__ int crow(int r,int hi){return (r&3)+8*(r>>2)+4*hi;}
#define SBAR() __builtin_amdgcn_sched_barrier(0)
__device__ __forceinline__ void cmask(f32x16&p0,f32x16&p1,int jb,int qrel,int hi){
  const float NEG=-INFINITY; int kb=64*jb+4*hi;
  #pragma unroll
  for(int r=0;r<16;++r){int kv=kb+(r&3)+8*(r>>2); if(kv>qrel)p0[r]=NEG; if(kv+32>qrel)p1[r]=NEG;}
}

constexpr int NSLOT=3, SLOTB=8192;
constexpr int LDS_K=0, LDS_V=NSLOT*SLOTB, LDS_WS=2*NSLOT*SLOTB, LDS_OST=LDS_WS+NW*64*4, LDS_BIAS=LDS_OST+NW*4096, BIAS_CP=1552, LDS_BYTES=LDS_BIAS+4*BIAS_CP;
constexpr float C2=0.125f*1.4426950408889634f;
__device__ __forceinline__ void glds16(const void*gsrc,unsigned lds_dst){unsigned keep;
  asm volatile("s_mov_b32 %0, m0\n\ts_mov_b32 m0, %2\n\ts_nop 0\n\tglobal_load_lds_dwordx4 %1, off\n\ts_mov_b32 m0, %0":"=&s"(keep):"v"(gsrc),"s"(lds_dst):"memory");}
__device__ __forceinline__ float max3f(float a,float b,float c){float r;asm("v_max3_f32 %0, %1, %2, %3":"=v"(r):"v"(a),"v"(b),"v"(c));return r;}
__device__ __forceinline__ float max2f(float a,float b){float r;asm("v_max_f32_e32 %0, %1, %2":"=v"(r):"v"(a),"v"(b));return r;}
__device__ __forceinline__ float fadd_s(float a,float b){float r;asm("v_add_f32_e32 %0, %1, %2":"=v"(r):"v"(a),"v"(b));return r;}
__device__ __forceinline__ float fsub_s(float a,float b){float r;asm("v_sub_f32_e32 %0, %1, %2":"=v"(r):"v"(a),"v"(b));return r;}
typedef float f32x2_t __attribute__((ext_vector_type(2))); typedef __bf16 bf16x2_t __attribute__((ext_vector_type(2)));
__device__ __forceinline__ unsigned cvtpk_s(float lo,float hi){f32x2_t v={lo,hi};bf16x2_t b=__builtin_convertvector(v,bf16x2_t);return __builtin_bit_cast(unsigned,b);}
#define WAIT_BAR(N) asm volatile("s_waitcnt vmcnt(" #N ") lgkmcnt(0)\n\ts_barrier":::"memory")

__device__ __forceinline__ void qkt(f32x16&p0,f32x16&p1,const char*Kslot,const bf16x8*qr,int r32,int hi){
  const char*kb=Kslot+hi*1024+r32*16;
  #pragma unroll
  for(int d0=0;d0<4;++d0){
    const bf16x8 b0=*reinterpret_cast<const bf16x8*>(kb+d0*2048);
    const bf16x8 b1=*reinterpret_cast<const bf16x8*>(kb+d0*2048+512);
    if(d0==0){p0=__builtin_amdgcn_mfma_f32_32x32x16_bf16(b0,qr[0],f32x16{},0,0,0);p1=__builtin_amdgcn_mfma_f32_32x32x16_bf16(b1,qr[0],f32x16{},0,0,0);}
    else{p0=__builtin_amdgcn_mfma_f32_32x32x16_bf16(b0,qr[d0],p0,0,0,0);p1=__builtin_amdgcn_mfma_f32_32x32x16_bf16(b1,qr[d0],p1,0,0,0);}}
}
typedef __attribute__((address_space(3))) const char* lds_cptr;
typedef short v4i16_t __attribute__((ext_vector_type(4)));
typedef float f32x4_t __attribute__((ext_vector_type(4)));
__device__ __forceinline__ void kload8(bf16x8*kf,lds_cptr kp){
  kf[0]=*(const __attribute__((address_space(3))) bf16x8*)(kp);      kf[1]=*(const __attribute__((address_space(3))) bf16x8*)(kp+512);
  kf[2]=*(const __attribute__((address_space(3))) bf16x8*)(kp+2048); kf[3]=*(const __attribute__((address_space(3))) bf16x8*)(kp+2560);
  kf[4]=*(const __attribute__((address_space(3))) bf16x8*)(kp+4096); kf[5]=*(const __attribute__((address_space(3))) bf16x8*)(kp+4608);
  kf[6]=*(const __attribute__((address_space(3))) bf16x8*)(kp+6144); kf[7]=*(const __attribute__((address_space(3))) bf16x8*)(kp+6656);
}
__device__ __forceinline__ void kload2(bf16x8*kf,lds_cptr kp,int j){ kf[2*j]=*(const __attribute__((address_space(3))) bf16x8*)(kp+j*2048); kf[2*j+1]=*(const __attribute__((address_space(3))) bf16x8*)(kp+j*2048+512); }
__device__ __forceinline__ s16x4 vtr(lds_cptr p){ return __builtin_bit_cast(s16x4,__builtin_amdgcn_ds_read_tr16_b64_v4i16((__attribute__((address_space(3))) v4i16_t*)p)); }
__device__ __forceinline__ float rowmax(const f32x16&p0,const f32x16&p1){
  float a=max3f(p0[0],p0[1],p1[0]),b=max3f(p0[2],p0[3],p1[1]);a=max3f(a,p1[2],p1[3]);
  #pragma unroll
  for(int r=4;r<16;r+=4){a=max3f(a,p0[r],p0[r+1]);b=max3f(b,p0[r+2],p0[r+3]);a=max3f(a,p1[r],p1[r+1]);b=max3f(b,p1[r+2],p1[r+3]);}
  const float m=max2f(a,b);
  auto rr=__builtin_amdgcn_permlane32_swap(__float_as_uint(m),__float_as_uint(m),false,false);
  return max2f(__uint_as_float(rr[0]),__uint_as_float(rr[1]));
}
__device__ __forceinline__ void pv(f32x16*o,int vb,bf16x8 pa0,bf16x8 pa1,bf16x8 pa2,bf16x8 pa3){
  #pragma unroll
  for(int d0=0;d0<2;++d0){s16x4 lo[4],hi[4];
    #pragma unroll
    for(int ks=0;ks<4;++ks){
      asm volatile("ds_read_b64_tr_b16 %0,%1 offset:%c2":"=&v"(lo[ks]):"v"(vb),"i"(d0*4096+ks*1024):"memory");
      asm volatile("ds_read_b64_tr_b16 %0,%1 offset:%c2":"=&v"(hi[ks]):"v"(vb),"i"(d0*4096+ks*1024+512):"memory");}
    asm volatile("s_waitcnt lgkmcnt(0)":::"memory");SBAR();
    #define PK(k) (bf16x8){lo[k][0],lo[k][1],lo[k][2],lo[k][3],hi[k][0],hi[k][1],hi[k][2],hi[k][3]}
    o[d0]=__builtin_amdgcn_mfma_f32_32x32x16_bf16(pa0,PK(0),o[d0],0,0,0);
    o[d0]=__builtin_amdgcn_mfma_f32_32x32x16_bf16(pa1,PK(1),o[d0],0,0,0);
    o[d0]=__builtin_amdgcn_mfma_f32_32x32x16_bf16(pa2,PK(2),o[d0],0,0,0);
    o[d0]=__builtin_amdgcn_mfma_f32_32x32x16_bf16(pa3,PK(3),o[d0],0,0,0);
    #undef PK
  }
}

__device__ __forceinline__ void maskbias(f32x16&p0,f32x16&p1,int dl,lds_cptr bl,float cfar,float mh){
  if(dl<0||dl>8){
    #pragma unroll
    for(int r=0;r<16;++r){p0[r]=-INFINITY;p1[r]=-INFINITY;}
  } else if(dl>=5){
    {const float cc=cfar-mh; _Pragma("unroll") for(int r=0;r<16;++r){p0[r]+=cc;p1[r]+=cc;}}
  } else { const lds_cptr b=bl-256*dl;
    #pragma unroll
    for(int g=0;g<4;++g){ const f32x4_t x0=*(const __attribute__((address_space(3))) f32x4_t*)(b+32*g), x1=*(const __attribute__((address_space(3))) f32x4_t*)(b+32*g+128);
      #pragma unroll
      for(int e=0;e<4;++e){p0[4*g+e]+=x0[e]-mh;p1[4*g+e]+=x1[e]-mh;} } }
}
#ifndef ATTN_STORE16
#define ATTN_STORE16(p,v) (*(u32x4*)(p)=(v))
#endif
template<int THRL> __device__ __forceinline__ void attn_unit(int b,int h,int qb,const bf16*Q,const bf16*__restrict__ K,const bf16*__restrict__ V,bf16*O,const float*relb,char*shm,bool fill){
  const int tid=threadIdx.x,lane=tid&63,r32=lane&31,hi=lane>>5; const int wid=__builtin_amdgcn_readfirstlane(tid>>6);
  const long rowbase=(long)b*SEQ; const int q0=qb*QB;
  const bf16*Qw=Q+(rowbase+q0+wid*QBLK)*DM+h*D;
  const bf16*Kh=K+rowbase*DM+h*D,*Vh=V+rowbase*DM+h*D;
  const unsigned lds0=(unsigned)(uintptr_t)shm;
  const lds_cptr shm3b=(lds_cptr)shm;
  float*wsf=(float*)(shm+LDS_WS)+wid*64;
  const bf16*ksrc=Kh+(long)lane*DM+wid*8;
  const bf16*vsrc=Vh+(long)(16*(wid&3)+(lane>>2))*DM+(wid>>2)*32+(lane&3)*8;
  const unsigned kdst=lds0+LDS_K+wid*1024, vdst=lds0+LDS_V+wid*1024;
  #define TOFF(t) ((t)==0?0:((t)<=nb?-(t):(t)-nb))
  #define DMA_K(t,slot) glds16(ksrc+(long)(q0+KVBLK*TOFF(t))*DM,(unsigned)__builtin_amdgcn_readfirstlane(kdst+(slot)))
  #define DMA_V(t,slot) glds16(vsrc+(long)(q0+KVBLK*TOFF(t))*DM,(unsigned)__builtin_amdgcn_readfirstlane(vdst+(slot)))
  const int vb0=(int)(lds0+LDS_V)+((lane>>4)&1)*32+(lane&3)*8+(4*hi+((lane&15)>>2))*64;
  const char*Kbase=shm+LDS_K; bf16x8 kf[8];
  const lds_cptr shm3=(lds_cptr)shm; const lds_cptr kp0=shm3+LDS_K+hi*1024+r32*16; const lds_cptr vp0=shm3+LDS_V+((lane>>4)&1)*32+(lane&3)*8+(4*hi+((lane&15)>>2))*64;
  const int nb=(4*qb<8)?4*qb:8; const int NT=4+nb;
  const int pw_=wid>>1, qi_=32*(wid&1)+r32, al_=(3-qi_)&3;
  if(fill){ __attribute__((address_space(3))) float* bc=(__attribute__((address_space(3))) float*)(shm3b+LDS_BIAS);
    for(int j=tid;j<4*388;j+=512){const int a=j/388,jj=j-a*388,rel=319-jj-a; bc[j]=(rel>=-63)?relb[(rel>256?256:rel)+256]*1.4426950408889634f:0.f;} }
  const float cfar=relb[512]*1.4426950408889634f;
  const lds_cptr bl_=shm3b+LDS_BIAS+al_*BIAS_CP+(319-qi_+4*hi-al_)*4;
  DMA_K(0,0);DMA_V(0,0);DMA_K(1,SLOTB);
  bf16x8 qr[4];
  #pragma unroll
  for(int d0=0;d0<4;++d0)qr[d0]=*reinterpret_cast<const bf16x8*>(&Qw[(long)r32*DM+d0*16+hi*8]);
  float mhat=0.f,l_reg=0.f;f32x16 o[2];o[0]=f32x16{};o[1]=f32x16{};
  const int qrel=wid*QBLK+r32;
  #define CMASK(P0,P1,t) maskbias(P0,P1,pw_-TOFF(t),bl_,cfar,mhat)
  bool resc=false;
  #define START(P0,P1) do{ const float rm=rowmax(P0,P1); resc=false; \
    { const float dl=rm; mhat=fadd_s(mhat,dl); \
      _Pragma("unroll") for(int r=0;r<16;++r){P0[r]=fsub_s(P0[r],dl);P1[r]=fsub_s(P1[r],dl);} } \
    _Pragma("unroll") for(int r=0;r<16;++r)P0[r]=__builtin_amdgcn_exp2f(P0[r]); }while(0)
  #define RESC() do{ if(resc){ asm volatile("s_waitcnt lgkmcnt(0)":::"memory"); \
      _Pragma("unroll") for(int d_=0;d_<2;++d_) _Pragma("unroll") for(int r=0;r<16;++r)o[d_][r]*=wsf[crow(r,hi)]; } }while(0)
  f32x16 pA0,pA1,pB0,pB1;
  int sl_prev=0,sl_cur=0,sl_next=SLOTB;
  #define ROT() do{sl_prev=sl_cur;sl_cur=sl_next;sl_next=(sl_next==(NSLOT-1)*SLOTB)?0:sl_next+SLOTB;}while(0)
  DMA_K(2,2*SLOTB);
  WAIT_BAR(3);
  qkt(pA0,pA1,Kbase,qr,r32,hi);asm volatile("s_nop 15\n\ts_nop 7":"+v"(pA0),"+v"(pA1));CMASK(pA0,pA1,0);
  START(pA0,pA1);
  _Pragma("unroll") for(int r=0;r<16;++r)pA1[r]=__builtin_amdgcn_exp2f(pA1[r]);
  WAIT_BAR(0);
  DMA_K(3,0);DMA_V(1,SLOTB);
  ROT();
  kload8(kf,kp0+sl_cur);
  WAIT_BAR(2);
  s16x4 vlo[8],vhi[8]; u32x4 pw0,pw1,pw2,pw3;
  #define PKW(P,B) cvtpk_s(P[B],P[B+1])
  #define PAF(k) __builtin_bit_cast(bf16x8,pw##k)
  #define VFR(i) (bf16x8){vlo[i][0],vlo[i][1],vlo[i][2],vlo[i][3],vhi[i][0],vhi[i][1],vhi[i][2],vhi[i][3]}
  #define PIN(x) asm volatile("":"+v"(x))
  #define MX3(a,b,c) __builtin_fmaxf(__builtin_fmaxf((a),(b)),(c))
  #define GAPA(MF,A0,A1,A2,A3,W0,W1,PW) do{ MF; sacc+=A0; sacc+=A1; sacc+=A2; sacc+=A3; PIN(sacc); W0; W1; PIN(PW); SBAR(); }while(0)
  #define EX(v) __builtin_amdgcn_exp2f(v)
  #define GAPB(MF,X,B) do{ MF; X[B]=EX(X[B]); X[B+1]=EX(X[B+1]); X[B+2]=EX(X[B+2]); X[B+3]=EX(X[B+3]); PIN(X); SBAR(); }while(0)
  #define VRD(i) do{ vlo[i]=vtr(vp_+(((i)>>2)*4096+((i)&3)*1024)); vhi[i]=vtr(vp_+(((i)>>2)*4096+((i)&3)*1024+512)); }while(0)
  #define KRD(G,j) do{ if(G){ kload2(kf,kp0+sl_next,j); SBAR(); } }while(0)
  #define STEP(C0,C1,P0,P1,t,GK,GV,GL) do{ SBAR(); \
    const lds_cptr vp_=vp0+sl_prev; \
    VRD(0); SBAR(); float sacc=(P0[0]+P0[1]); \
    GAPA(C0=__builtin_amdgcn_mfma_f32_32x32x16_bf16(kf[0],qr[0],f32x16{},0,0,0), P0[2],P0[3],P0[4],P0[5],     pw0[0]=PKW(P0,0), pw0[1]=PKW(P0,2), pw0); \
    VRD(4); SBAR(); GAPA(C1=__builtin_amdgcn_mfma_f32_32x32x16_bf16(kf[1],qr[0],f32x16{},0,0,0), P0[6],P0[7],P0[8],P0[9],     pw0[2]=PKW(P0,4), pw0[3]=PKW(P0,6), pw0); \
    VRD(1); SBAR(); GAPA(C0=__builtin_amdgcn_mfma_f32_32x32x16_bf16(kf[2],qr[1],C0,0,0,0),   P0[10],P0[11],P0[12],P0[13], pw1[0]=PKW(P0,8), pw1[1]=PKW(P0,10), pw1); \
    VRD(5); SBAR(); GAPA(C1=__builtin_amdgcn_mfma_f32_32x32x16_bf16(kf[3],qr[1],C1,0,0,0),   P0[14],P0[15],P1[0],P1[1],   pw1[2]=PKW(P0,12),pw1[3]=PKW(P0,14), pw1); \
    VRD(2); SBAR(); GAPA(C0=__builtin_amdgcn_mfma_f32_32x32x16_bf16(kf[4],qr[2],C0,0,0,0),   P1[2],P1[3],P1[4],P1[5],     pw2[0]=PKW(P1,0), pw2[1]=PKW(P1,2), pw2); \
    VRD(6); SBAR(); GAPA(C1=__builtin_amdgcn_mfma_f32_32x32x16_bf16(kf[5],qr[2],C1,0,0,0),   P1[6],P1[7],P1[8],P1[9],     pw2[2]=PKW(P1,4), pw2[3]=PKW(P1,6), pw2); \
    VRD(3); SBAR(); GAPA(C0=__builtin_amdgcn_mfma_f32_32x32x16_bf16(kf[6],qr[3],C0,0,0,0),   P1[10],P1[11],P1[12],P1[13], pw3[0]=PKW(P1,8), pw3[1]=PKW(P1,10), pw3); \
    VRD(7); SBAR(); GAPA(C1=__builtin_amdgcn_mfma_f32_32x32x16_bf16(kf[7],qr[3],C1,0,0,0),   P1[14],P1[15],0.f,0.f,       pw3[2]=PKW(P1,12),pw3[3]=PKW(P1,14), pw3); \
    l_reg+=sacc; \
    if(GK){DMA_K((t)+3,sl_cur);} if(GV){DMA_V((t)+1,sl_next);} \
    CMASK(C0,C1,t); \
    { float a=MX3(C0[0],C0[1],C1[0]),b=MX3(C0[2],C0[3],C1[1]); a=MX3(a,C1[2],C1[3]); \
      _Pragma("unroll") for(int r=4;r<16;r+=4){a=MX3(a,C0[r],C0[r+1]);b=MX3(b,C0[r+2],C0[r+3]);a=MX3(a,C1[r],C1[r+1]);b=MX3(b,C1[r+2],C1[r+3]);} \
      float rm=__builtin_fmaxf(a,b); { auto rr=__builtin_amdgcn_permlane32_swap(__float_as_uint(rm),__float_as_uint(rm),false,false); rm=__builtin_fmaxf(__uint_as_float(rr[0]),__uint_as_float(rr[1])); } \
      resc=false; \
      if(__builtin_expect(__any(rm>(float)THRL),0)){ const float dl=__builtin_fmaxf(rm,0.f); mhat+=dl; \
        _Pragma("unroll") for(int r=0;r<16;++r){C0[r]-=dl;C1[r]-=dl;} \
        const float f=__builtin_amdgcn_exp2f(-dl); l_reg*=f; if(hi==0)wsf[r32]=f; resc=true; } } \
    SBAR(); \
    GAPB(o[0]=__builtin_amdgcn_mfma_f32_32x32x16_bf16(PAF(0),VFR(0),o[0],0,0,0), C0,0); \
    GAPB(o[1]=__builtin_amdgcn_mfma_f32_32x32x16_bf16(PAF(0),VFR(4),o[1],0,0,0), C0,4); \
    KRD(GL,0); GAPB(o[0]=__builtin_amdgcn_mfma_f32_32x32x16_bf16(PAF(1),VFR(1),o[0],0,0,0), C0,8); \
    KRD(GL,1); GAPB(o[1]=__builtin_amdgcn_mfma_f32_32x32x16_bf16(PAF(1),VFR(5),o[1],0,0,0), C0,12); \
    KRD(GL,2); GAPB(o[0]=__builtin_amdgcn_mfma_f32_32x32x16_bf16(PAF(2),VFR(2),o[0],0,0,0), C1,0); \
    KRD(GL,3); GAPB(o[1]=__builtin_amdgcn_mfma_f32_32x32x16_bf16(PAF(2),VFR(6),o[1],0,0,0), C1,4); \
    GAPB(o[0]=__builtin_amdgcn_mfma_f32_32x32x16_bf16(PAF(3),VFR(3),o[0],0,0,0), C1,8); \
    GAPB(o[1]=__builtin_amdgcn_mfma_f32_32x32x16_bf16(PAF(3),VFR(7),o[1],0,0,0), C1,12); \
    }while(0)
  int t=1;
  for(;t+5<NT;t+=2){
    STEP(pB0,pB1,pA0,pA1,t,true,true,true);     WAIT_BAR(2); RESC(); ROT();
    STEP(pA0,pA1,pB0,pB1,t+1,true,true,true);   WAIT_BAR(2); RESC(); ROT();
  }
  #define ENDW(tt) do{ if((tt)+3<NT){WAIT_BAR(2);} else if((tt)+2<NT){WAIT_BAR(1);} else {WAIT_BAR(0);} }while(0)
  for(;t+1<NT;t+=2){
    STEP(pB0,pB1,pA0,pA1,t,(t+3<NT),(t+1<NT),(t+1<NT));       ENDW(t);   RESC(); ROT();
    STEP(pA0,pA1,pB0,pB1,t+1,(t+4<NT),(t+2<NT),(t+2<NT));     ENDW(t+1); RESC(); ROT();
  }
  STEP(pB0,pB1,pA0,pA1,NT-1,false,false,false); RESC();
  { float sacc=pB0[0]+pB0[1]; _Pragma("unroll") for(int r=2;r<16;++r)sacc+=pB0[r]; _Pragma("unroll") for(int r=0;r<16;++r)sacc+=pB1[r]; l_reg+=sacc;
    pw0=(u32x4){PKW(pB0,0),PKW(pB0,2),PKW(pB0,4),PKW(pB0,6)};pw1=(u32x4){PKW(pB0,8),PKW(pB0,10),PKW(pB0,12),PKW(pB0,14)};pw2=(u32x4){PKW(pB1,0),PKW(pB1,2),PKW(pB1,4),PKW(pB1,6)};pw3=(u32x4){PKW(pB1,8),PKW(pB1,10),PKW(pB1,12),PKW(pB1,14)};
    SBAR(); pv(o,vb0+sl_cur,PAF(0),PAF(1),PAF(2),PAF(3)); }
  #undef PKW
  #undef PAF
  #undef VFR
  #undef PIN
  #undef MX3
  #undef GAPA
  #undef GAPB
  #undef EX
  #undef VRD
  #undef KRD
  #undef STEP
  #undef ENDW
  {auto rr=__builtin_amdgcn_permlane32_swap(__float_as_uint(l_reg),__float_as_uint(l_reg),false,false);l_reg=__uint_as_float(rr[0])+__uint_as_float(rr[1]);}
  if(hi==0)wsf[32+r32]=l_reg;asm volatile("s_waitcnt lgkmcnt(0)":::"memory");
  float rli[16];
  #pragma unroll
  for(int r=0;r<16;++r)rli[r]=__builtin_amdgcn_rcpf(wsf[32+crow(r,hi)]);
  bf16*Ow=O+(rowbase+q0+wid*QBLK)*OP+h*D;
  { bf16*stg=(bf16*)(shm+LDS_OST)+wid*2048;
    #pragma unroll
    for(int r=0;r<16;++r){const int orow=crow(r,hi);
      #pragma unroll
      for(int d0=0;d0<2;++d0)stg[orow*64+d0*32+r32]=__float2bfloat16(o[d0][r]*rli[r]);}
    asm volatile("s_waitcnt lgkmcnt(0)":::"memory");
    #pragma unroll
    for(int i=0;i<4;++i){const int row=i*8+(lane>>3),ch=lane&7; const u32x4 v=*(const u32x4*)(stg+row*64+ch*8); ATTN_STORE16(Ow+(long)row*OP+ch*8,v);} }
  asm volatile("s_waitcnt lgkmcnt(0)\n\ts_barrier":::"memory");
  #undef DMA_K
  #undef TOFF
  #undef DMA_V
  #undef CMASK
  #undef START
  #undef RESC
  #undef ROT
}
constexpr int ATTN_LDS_BYTES=LDS_BYTES;
struct AttnTensors { const bf16* Q; const bf16* K; const bf16* V; bf16* O; const float* relb; };
struct AttnUnit { int bh; int qb; };
struct StaticOrder {
  int vcu,upb;
  __device__ __forceinline__ explicit StaticOrder(int grid,int block):vcu((grid%8==0)?(block%8)*(grid/8)+block/8:block),upb((BATCH*NHEAD*NQB+grid-1)/grid){}
  __device__ __forceinline__ bool next(int i,AttnUnit&u)const{ const int un=vcu*upb+i; if(i>=upb||un>=BATCH*NHEAD*NQB)return false; u.bh=un/NQB; u.qb=un%NQB; return true; }
  __device__ __forceinline__ void a_ready(const AttnUnit&)const{}
  __device__ __forceinline__ void done(const AttnUnit&)const{}
};
template<class Sched,int THRL=8> __device__ __forceinline__ void attn_phase(char*lds,const AttnTensors&T,const Sched&S){
  AttnUnit u;
  int ph=-1;
  for(int i=0;S.next(i,u);++i){ const int h=u.bh%NHEAD; S.a_ready(u); attn_unit<THRL>(u.bh/NHEAD,h,u.qb,T.Q,T.K,T.V,T.O,T.relb+h*513,lds,h!=ph); ph=h; S.done(u); }
}
#undef SBAR
#undef WAIT_BAR
}
constexpr int NWAVES = 8, NTHR = 512;
constexpr int NTOK = 32768, DM = 1024, SEQ = 16384, CH = 64, NCH = SEQ / CH, NCHT = 2 * NCH;
constexpr int PW = 3072;
constexpr int C_GQ = 0, C_GK = 256, C_GV = 512, C_OG = 1024, C_AQ = 1536, C_AK = 2048, C_AV = 2560;
constexpr int NIN = 3072;
constexpr int W_IN_COLS = 3088;
constexpr int NEXP = 32, TOPK = 4, DFF = 1024;
constexpr int PSLOTS = 139264;
constexpr float EPS = 1e-6f;
constexpr float LOG2E = 1.4426950408889634f;
constexpr float C2 = 0.125f * LOG2E;

constexpr size_t MiB = 1u << 20;
constexpr size_t WS_CTL = 0, CTL_ZERO_BYTES = 1 * MiB;
constexpr size_t WS_RWP = 1 * MiB;
constexpr size_t WS_WLR = 1 * MiB + 262144;
constexpr size_t WS_TOPE = 2 * MiB, WS_TOPG = 3 * MiB, WS_RANK = 4 * MiB, WS_SLOTOF = 5 * MiB;
constexpr size_t WS_HIST = 6 * MiB;
constexpr size_t WS_TILEE = 6 * MiB + 65536;
constexpr size_t WS_RSLOT = 6 * MiB + 131072;
constexpr size_t WS_RSTD = 9 * MiB + 524288;
constexpr size_t WS_BUFTOK = 7 * MiB, WS_GATESLOT = 8 * MiB;
constexpr size_t WS_DEC = 9 * MiB;
constexpr size_t WS_WIN = 10 * MiB;
constexpr size_t WS_WOUT = 17 * MiB;
constexpr size_t WS_WMIN = 20 * MiB;
constexpr size_t WS_WMOUT = 148 * MiB;
constexpr size_t WS_H2 = 212 * MiB;
constexpr size_t WS_Y = 276 * MiB;
constexpr size_t WS_H1 = 548 * MiB;
constexpr size_t WS_ST16 = WS_H1;
constexpr size_t WS_PROJ = 612 * MiB;
constexpr size_t WS_GATE = 804 * MiB;
constexpr size_t WS_US = 836 * MiB;
constexpr size_t WS_MIX = 900 * MiB;
constexpr size_t WS_M16 = WS_US;
constexpr size_t WS_ACT = 548 * MiB;
constexpr size_t WS_END = 964 * MiB;
static_assert(WS_Y + (size_t)PSLOTS * 1024 * 2 <= WS_H1 && WS_ACT + (size_t)PSLOTS * 1024 * 2 <= WS_US && WS_MIX + (size_t)NTOK * 1024 * 2 <= WS_END, "ws map");
static_assert(WS_WIN + (size_t)NIN * 1024 * 2 <= WS_WOUT && WS_WMIN + (size_t)32 * 2048 * 1024 * 2 <= WS_WMOUT && WS_WMOUT + (size_t)32 * 1024 * 1024 * 2 <= WS_H2, "ws map 2");

constexpr int CW_BAR = 4096;
constexpr int RING_BYTES = 131072, LDSCTL_OFF = RING_BYTES, MISC_OFF = LDSCTL_OFF + 320, LDS_BYTES = 147456;

#define GAS __attribute__((address_space(1)))
#define LAS __attribute__((address_space(3)))
typedef unsigned short bf16;
typedef unsigned v4u __attribute__((ext_vector_type(4)));
typedef unsigned v2u __attribute__((ext_vector_type(2)));
typedef float f32x4 __attribute__((ext_vector_type(4)));
typedef float f32x16 __attribute__((ext_vector_type(16)));
#define LDS_WAIT() asm volatile("s_waitcnt lgkmcnt(0)" ::: "memory")
typedef short s16x4 __attribute__((ext_vector_type(4)));
typedef short s16x8 __attribute__((ext_vector_type(8)));
__device__ __forceinline__ s16x4 tr16(const LAS unsigned char* p) { return __builtin_bit_cast(s16x4, __builtin_amdgcn_ds_read_tr16_b64_v4i16((LAS s16x4*)p)); }
__device__ __forceinline__ unsigned f2bf(float f) { unsigned u = __builtin_bit_cast(unsigned, f); return (u + 0x7fffu + ((u >> 16) & 1u)) >> 16; }
__device__ __forceinline__ unsigned pk2(float lo, float hi) { return f2bf(lo) | (f2bf(hi) << 16); }
constexpr float ACT8S = 4.f, Y8S = 16.f;
constexpr float W8S = 32.f, W8I = 1.f / 32.f;
__device__ __forceinline__ unsigned pk4_fp8(float a, float b, float c, float d) { int w = __builtin_amdgcn_cvt_pk_fp8_f32(a, b, 0, false); w = __builtin_amdgcn_cvt_pk_fp8_f32(c, d, w, true); return (unsigned)w; }
template <int B> __device__ __forceinline__ float fp8f(unsigned w) { return __builtin_amdgcn_cvt_f32_fp8((int)w, B); }
__device__ __forceinline__ float bflo(unsigned w) { return __builtin_bit_cast(float, w << 16); }
__device__ __forceinline__ float bfhi(unsigned w) { return __builtin_bit_cast(float, w & 0xffff0000u); }

#define XB_TMO      128
#define XB_XCNT(j)  (256  + 64 * (j))
#define XB_XSUB(j)  (1280 + 64 * (j))
#define XB_XGEN(j)  (2304 + 64 * (j))
#define XB_TOP      3328
#define XB_TOPGEN   3392
#define XCD_BAR_WORDS 3456
#define XB_SPIN_CAP (1u << 18)
__device__ __forceinline__ unsigned xb_ld(unsigned* p)              { return __hip_atomic_load(p, __ATOMIC_RELAXED, __HIP_MEMORY_SCOPE_AGENT); }
__device__ __forceinline__ unsigned xb_add(unsigned* p, unsigned v) { return __hip_atomic_fetch_add(p, v, __ATOMIC_RELAXED, __HIP_MEMORY_SCOPE_AGENT); }
__device__ __forceinline__ unsigned xb_xcc_id() { return (unsigned)__builtin_amdgcn_s_getreg((3 << 11) | 20) & 0xFu; }
#define XB_SPIN(cond, bar) do { unsigned _sp = 0; while (cond) { __builtin_amdgcn_s_sleep(1); \
    if ((++_sp & 255u) == 0u) { if (xb_ld(&(bar)[XB_TMO])) break; if (_sp > XB_SPIN_CAP) { atomicAdd(&(bar)[XB_TMO], 1u); break; } } } } while (0)
struct XcdBarrier { unsigned* bar; unsigned x; volatile LAS unsigned* st; };
__device__ __forceinline__ XcdBarrier xcd_barrier_post(unsigned* bar, volatile LAS unsigned* st) {
    XcdBarrier b; b.bar = bar; b.x = xb_xcc_id(); b.st = st;
    if (threadIdx.x == 0) (void)xb_add(&bar[XB_XCNT(b.x)], 1u);
    return b;
}
__device__ __forceinline__ void xcd_barrier_complete(unsigned* bar, unsigned x, unsigned& nloc, unsigned& nx) {
    const unsigned G = gridDim.x * gridDim.y * gridDim.z;
    unsigned sum, cnt, mine, sp = 0u;
    for (;;) {
        sum = 0u; cnt = 0u; mine = 0u;
#pragma unroll
        for (unsigned j = 0; j < 16; ++j) { const unsigned c = xb_ld(&bar[XB_XCNT(j)]); sum += c; cnt += (c > 0u) ? 1u : 0u; mine = (j == x) ? c : mine; }
        if (sum == G) break;
        __builtin_amdgcn_s_sleep(1);
        if ((++sp & 255u) == 0u) { if (xb_ld(&bar[XB_TMO])) break; if (sp > XB_SPIN_CAP) { atomicAdd(&bar[XB_TMO], 1u); break; } }
    }
    nloc = mine > 0u ? mine : 1u; nx = cnt > 0u ? cnt : 1u;
}
__device__ __forceinline__ void xcd_barrier(const XcdBarrier& b) {
    asm volatile("s_waitcnt vmcnt(0)" ::: "memory");
    __syncthreads();
    if (threadIdx.x == 0) {
        unsigned* bar = b.bar;
        __builtin_amdgcn_s_waitcnt(0);
        unsigned nloc = b.st[0], nx = b.st[1];
        if (nloc == 0u) { xcd_barrier_complete(bar, b.x, nloc, nx); b.st[0] = nloc; b.st[1] = nx; }
        const unsigned old = xb_add(&bar[XB_XSUB(b.x)], 1u);
        const unsigned gen = old / nloc;
        if (old + 1u == (gen + 1u) * nloc) {
            __builtin_amdgcn_fence(__ATOMIC_RELEASE, "agent");
            asm volatile("s_waitcnt vmcnt(0)" ::: "memory");
            const unsigned og = xb_add(&bar[XB_TOP], 1u);
            const unsigned tg = og / nx;
            if (og + 1u == (tg + 1u) * nx) xb_add(&bar[XB_TOPGEN], 1u);
            else XB_SPIN(xb_ld(&bar[XB_TOPGEN]) == tg, bar);
            __builtin_amdgcn_fence(__ATOMIC_ACQUIRE, "agent");
            xb_add(&bar[XB_XGEN(b.x)], 1u);
            asm volatile("s_waitcnt vmcnt(0)" ::: "memory");
        } else {
            XB_SPIN(xb_ld(&bar[XB_XGEN(b.x)]) == gen, bar);
            __builtin_amdgcn_fence(__ATOMIC_ACQUIRE, "agent");
            asm volatile("s_waitcnt vmcnt(0)" ::: "memory");
        }
    }
    __syncthreads();
}

using pg8::Unit; using pg8::cvt_pk_bf16;
struct EpiProj {
    static constexpr bool PERM = true, HEADPERM = true; static constexpr int NSTORE = 16;
    bf16* P; float* G; const float* gbias; const float* qg; const float* kg; int pf;
    static constexpr bool SIDE = false; __device__ __forceinline__ const void* side_src(const Unit&, const Unit&, bool, int, int) const { return nullptr; }
    __device__ __forceinline__ void operator()(const f32x4 (&acc)[2][2][4][2], const Unit& u, int wr, int wc, int fr, int fq, LAS unsigned char* side) const {
        const int row0 = u.pm * 256 + wr * 64 + fr;
        if (u.pn < 12) {
            const int col0 = u.pn * 256 + wc * 64 + 8 * fq;
            const bool isq = (u.pn == 6 || u.pn == 7), isk = (u.pn == 8 || u.pn == 9);
            f32x4 sq[2][2];
#pragma unroll
            for (int bj = 0; bj < 2; ++bj)
#pragma unroll
                for (int n = 0; n < 2; ++n) { const int d = 32 * bj + 8 * fq + 4 * n; sq[bj][n] = isq ? *(const LAS f32x4*)(side + d * 4) : (f32x4){1.f, 1.f, 1.f, 1.f}; }
#pragma unroll
            for (int ai = 0; ai < 2; ++ai)
#pragma unroll
                for (int m = 0; m < 4; ++m) { bf16* rowp = P + (size_t)(row0 + ai * 128 + m * 16) * PW + col0;
                    float r = 1.f;
                    if (isq || isk) { float ss = 0.f;
#pragma unroll
                        for (int bj = 0; bj < 2; ++bj)
#pragma unroll
                            for (int n = 0; n < 2; ++n) { const f32x4 v = acc[ai][bj][m][n]; ss += (v[0] * v[0] + v[1] * v[1]) + (v[2] * v[2] + v[3] * v[3]); }
                        ss += __shfl_xor(ss, 16); ss += __shfl_xor(ss, 32);
                        r = 1.f / sqrtf(ss * (1.f / 64.f) + EPS); }
#pragma unroll
                    for (int bj = 0; bj < 2; ++bj) { const f32x4 v0 = acc[ai][bj][m][0] * sq[bj][0] * r, v1 = acc[ai][bj][m][1] * sq[bj][1] * r;
                        v4u w; w.x = cvt_pk_bf16(v0[0], v0[1]); w.y = cvt_pk_bf16(v0[2], v0[3]); w.z = cvt_pk_bf16(v1[0], v1[1]); w.w = cvt_pk_bf16(v1[2], v1[3]);
                        *(v4u*)(rowp + bj * 32) = w; } }
        } else {
            const int col0 = wc * 64 + 8 * fq;
            f32x4 bv[2][2];
#pragma unroll
            for (int bj = 0; bj < 2; ++bj)
#pragma unroll
                for (int n = 0; n < 2; ++n) bv[bj][n] = *(const f32x4*)(gbias + col0 + bj * 32 + 4 * n);
#pragma unroll
            for (int ai = 0; ai < 2; ++ai)
#pragma unroll
                for (int m = 0; m < 4; ++m) { float* rowp = G + (size_t)(row0 + ai * 128 + m * 16) * 256 + col0;
#pragma unroll
                    for (int bj = 0; bj < 2; ++bj)
#pragma unroll
                        for (int n = 0; n < 2; ++n) { const f32x4 z = acc[ai][bj][m][n] + bv[bj][n]; f32x4 o;
#pragma unroll
                            for (int i = 0; i < 4; ++i) { const float zz = z[i]; const float t = __logf(1.f + __expf(-fabsf(zz))); o[i] = (fminf(zz, 0.f) - t) * (1.f / 16.f); }
                            *(f32x4*)(rowp + bj * 32 + 4 * n) = o; } }
        }
    }
};
struct EpiMix16 {
    static constexpr bool PERM = true, HEADPERM = false; static constexpr int NSTORE = 16;
    bf16* O;
    static constexpr bool SIDE = false; __device__ __forceinline__ const void* side_src(const Unit&, const Unit&, bool, int, int) const { return nullptr; }
    __device__ __forceinline__ void operator()(const f32x4 (&acc)[2][2][4][2], const Unit& u, int wr, int wc, int fr, int fq, LAS unsigned char*) const {
        const int row0 = u.pm * 256 + wr * 64 + fr, col0 = u.pn * 256 + wc * 32 + 8 * fq;
#pragma unroll
        for (int ai = 0; ai < 2; ++ai)
#pragma unroll
            for (int m = 0; m < 4; ++m) { bf16* rowp = O + (size_t)(row0 + ai * 128 + m * 16) * DM + col0;
#pragma unroll
                for (int bj = 0; bj < 2; ++bj) { const f32x4 v0 = acc[ai][bj][m][0], v1 = acc[ai][bj][m][1];
                    v4u w; w.x = cvt_pk_bf16(v0[0], v0[1]); w.y = cvt_pk_bf16(v0[2], v0[3]); w.z = cvt_pk_bf16(v1[0], v1[1]); w.w = cvt_pk_bf16(v1[2], v1[3]);
                    *(v4u*)(rowp + bj * 128) = w; } }
    }
};
struct EpiSwiglu {
    static constexpr bool PERM = true, HEADPERM = false; static constexpr int NSTORE = 8;
    unsigned char* ACT; const float* bin; const float* rslot; const int* rowtok;
    static constexpr bool SIDE = true;
    __device__ __forceinline__ const void* side_src(const Unit& u, const Unit& nx, bool has_next, int piece, int lane) const {
        const float* b0 = bin + (size_t)u.e * 2048 + u.pn * 128 + ((lane < 32) ? 4 * lane : 1024 + 4 * (lane - 32));
        if (piece == 1) return rslot + u.pm * 256 + 4 * lane;
        if (piece == 2 && has_next) return rowtok + nx.pm * 256 + 4 * lane;
        return b0;
    }
    __device__ __forceinline__ void operator()(const f32x4 (&acc)[2][2][4][2], const Unit& u, int wr, int wc, int fr, int fq, LAS unsigned char* side) const {
        const int row0 = u.pm * 256 + wr * 64 + fr, f0 = u.pn * 128 + wc * 32 + 8 * fq;
        f32x4 bgv[2], blv[2];
#pragma unroll
        for (int n = 0; n < 2; ++n) { bgv[n] = *(const LAS f32x4*)(side + (wc * 32 + 8 * fq + 4 * n) * 4); blv[n] = *(const LAS f32x4*)(side + 512 + (wc * 32 + 8 * fq + 4 * n) * 4); }
        const LAS float* rsp = (const LAS float*)(side + 1024) + wr * 64 + fr;
#pragma unroll
        for (int ai = 0; ai < 2; ++ai)
#pragma unroll
            for (int m = 0; m < 4; ++m) { float a[8]; const float rs = rsp[ai * 128 + m * 16] * W8I;
#pragma unroll
                for (int n = 0; n < 2; ++n) { const f32x4 gl = acc[ai][0][m][n] * rs + bgv[n], li = acc[ai][1][m][n] * rs + blv[n];
#pragma unroll
                    for (int i = 0; i < 4; ++i) { const float gg = fminf(gl[i], 7.f), ll = fminf(fmaxf(li[i], -7.f), 7.f);
                        const float sg = __builtin_amdgcn_rcpf(1.f + __builtin_amdgcn_exp2f(-1.702f * LOG2E * gg)); a[4 * n + i] = gg * sg * (ll + 1.f) * ACT8S; } }
                v2u w; w.x = pk4_fp8(a[0], a[1], a[2], a[3]); w.y = pk4_fp8(a[4], a[5], a[6], a[7]);
                *(v2u*)(ACT + (size_t)(row0 + ai * 128 + m * 16) * 1024 + f0) = w; }
    }
};
struct EpiY {
    static constexpr bool PERM = true, HEADPERM = false; static constexpr int NSTORE = 16;
    unsigned char* Y; const float* bout; const float* gslot; const int* dstrow;
    static constexpr bool SIDE = true;
    __device__ __forceinline__ const void* side_src(const Unit& u, const Unit&, bool, int piece, int lane) const {
        if (piece == 1) return gslot + u.pm * 256 + 4 * lane;
        if (piece == 2) return dstrow + u.pm * 256 + 4 * lane;
        return bout + (size_t)u.e * 1024 + u.pn * 256 + 4 * lane;
    }
    __device__ __forceinline__ void operator()(const f32x4 (&acc)[2][2][4][2], const Unit& u, int wr, int wc, int fr, int fq, LAS unsigned char* side) const {
        const int row0 = u.pm * 256 + wr * 64 + fr, col0 = u.pn * 256 + wc * 32 + 8 * fq;
        f32x4 bv[2][2];
#pragma unroll
        for (int bj = 0; bj < 2; ++bj)
#pragma unroll
            for (int n = 0; n < 2; ++n) bv[bj][n] = *(const LAS f32x4*)(side + (bj * 128 + wc * 32 + 8 * fq + 4 * n) * 4);
        const LAS float* gtp = (const LAS float*)(side + 1024) + wr * 64 + fr; const LAS int* drp = (const LAS int*)(side + 2048) + wr * 64 + fr;
#pragma unroll
        for (int ai = 0; ai < 2; ++ai)
#pragma unroll
            for (int m = 0; m < 4; ++m) { const float gt = gtp[ai * 128 + m * 16]; unsigned char* rowp = Y + (size_t)drp[ai * 128 + m * 16] * 1024 + col0;
#pragma unroll
                for (int bj = 0; bj < 2; ++bj) { const f32x4 v0 = (acc[ai][bj][m][0] * (W8I / ACT8S) + bv[bj][0]) * (gt * Y8S), v1 = (acc[ai][bj][m][1] * (W8I / ACT8S) + bv[bj][1]) * (gt * Y8S);
                    v2u w; w.x = pk4_fp8(v0[0], v0[1], v0[2], v0[3]); w.y = pk4_fp8(v1[0], v1[1], v1[2], v1[3]);
                    *(v2u*)(rowp + bj * 128) = w; } }
    }
};

__device__ __forceinline__ void p0_transpose_item_fp8(const float* W, int Nsrc, unsigned char* WT, int Kp, int k0, int ns0, int nd0, LAS float* scr, int lane, float scale, const float* kscale) {
#pragma unroll 8
    for (int i = 0; i < 32; ++i) { const int kk = 2 * i + (lane >> 5); scr[kk * 33 + (lane & 31)] = W[(size_t)(k0 + kk) * Nsrc + ns0 + (lane & 31)]; }
    LDS_WAIT(); asm volatile("" ::: "memory");
    const int c = lane & 3;
    float ks[16];
#pragma unroll
    for (int q = 0; q < 16; ++q) ks[q] = scale;
    if (kscale) {
#pragma unroll
        for (int q = 0; q < 4; ++q) { const f32x4 g = *(const f32x4*)(kscale + k0 + 16 * c + 4 * q); ks[4 * q] *= g.x; ks[4 * q + 1] *= g.y; ks[4 * q + 2] *= g.z; ks[4 * q + 3] *= g.w; } }
#pragma unroll
    for (int j = 0; j < 2; ++j) { const int n = (lane >> 2) + 16 * j; const LAS float* s = scr + (16 * c) * 33 + n;
        v4u o; o.x = pk4_fp8(s[0 * 33] * ks[0], s[1 * 33] * ks[1], s[2 * 33] * ks[2], s[3 * 33] * ks[3]); o.y = pk4_fp8(s[4 * 33] * ks[4], s[5 * 33] * ks[5], s[6 * 33] * ks[6], s[7 * 33] * ks[7]); o.z = pk4_fp8(s[8 * 33] * ks[8], s[9 * 33] * ks[9], s[10 * 33] * ks[10], s[11 * 33] * ks[11]); o.w = pk4_fp8(s[12 * 33] * ks[12], s[13 * 33] * ks[13], s[14 * 33] * ks[14], s[15 * 33] * ks[15]);
        *(v4u*)(WT + (size_t)(nd0 + n) * Kp + k0 + 16 * c) = o; }
    LDS_WAIT(); asm volatile("" ::: "memory");
}
__device__ __forceinline__ float wave_sum(float v) {
#pragma unroll
    for (int o = 1; o < 64; o <<= 1) v += __shfl_xor(v, o);
    return v;
}
__device__ __forceinline__ void p0_transpose_item(const float* W, int Nsrc, bf16* WT, int Kp, int k0, int ns0, int nd0, LAS float* scr, int lane) {
#pragma unroll 8
    for (int i = 0; i < 32; ++i) { const int kk = 2 * i + (lane >> 5); scr[kk * 33 + (lane & 31)] = W[(size_t)(k0 + kk) * Nsrc + ns0 + (lane & 31)]; }
    LDS_WAIT(); asm volatile("" ::: "memory");
    const int c = lane & 7;
#pragma unroll
    for (int j = 0; j < 4; ++j) { const int n = (lane >> 3) + 8 * j; const LAS float* s = scr + (8 * c) * 33 + n;
        v4u o; o.x = pk2(s[0 * 33], s[1 * 33]); o.y = pk2(s[2 * 33], s[3 * 33]); o.z = pk2(s[4 * 33], s[5 * 33]); o.w = pk2(s[6 * 33], s[7 * 33]);
        *(v4u*)(WT + (size_t)(nd0 + n) * Kp + k0 + 8 * c) = o; }
    LDS_WAIT(); asm volatile("" ::: "memory");
}

struct Args { const float* in[17]; float* out; unsigned char* ws; int ph_lo, ph_hi, li, flags; };
constexpr int NPHASE = 11;
#ifndef STAG_P1
#define STAG_P1 0
#define STAG_P8 0
#define STAG_P9 0
#endif

__global__ void __launch_bounds__(NTHR, 2) fwd(Args args) {
    extern __shared__ __attribute__((aligned(16))) unsigned char lds_raw[];
    LAS unsigned char* lds = (LAS unsigned char*)lds_raw;
    LAS float* ldsf = (LAS float*)lds_raw;
    volatile LAS unsigned* MISC = (volatile LAS unsigned*)(lds + MISC_OFF);
    LAS int* UTAB = (LAS int*)(lds + RING_BYTES + 2048);
    const int tid = threadIdx.x, lane = tid & 63, wave = __builtin_amdgcn_readfirstlane(tid >> 6);
    const int G = gridDim.x, bx = blockIdx.x;
    unsigned char* ws = args.ws;
    unsigned* ctl = (unsigned*)(ws + WS_CTL);
    const float* x = args.in[0]; const float* g1 = args.in[1]; const float* w_in = args.in[2]; const float* gate_up = args.in[3]; const float* gate_bias = args.in[4];
    const float* gla_ng = args.in[5]; const float* qng = args.in[6]; const float* kng = args.in[7]; const float* rel_bias = args.in[8]; const float* w_out = args.in[9];
    const float* g2 = args.in[10]; const float* router_w = args.in[11]; const float* router_b = args.in[12]; const float* moe_w_in = args.in[13]; const float* moe_b_in = args.in[14];
    const float* moe_w_out = args.in[15]; const float* moe_b_out = args.in[16];
    float* out = args.out;
    float* RWP = (float*)(ws + WS_RWP); int* TOPE = (int*)(ws + WS_TOPE); float* TOPG = (float*)(ws + WS_TOPG); int* RANK = (int*)(ws + WS_RANK); int* DSTROW = (int*)(ws + WS_SLOTOF);
    int* HIST = (int*)(ws + WS_HIST); int* TILEE = (int*)(ws + WS_TILEE); int* BUFTOK = (int*)(ws + WS_BUFTOK); float* GATESLOT = (float*)(ws + WS_GATESLOT); float* DEC = (float*)(ws + WS_DEC); float* RSLOT = (float*)(ws + WS_RSLOT); float* RSTD = (float*)(ws + WS_RSTD);
    bf16* WLR = (bf16*)(ws + WS_WLR); bf16* WIN = (bf16*)(ws + WS_WIN); bf16* WOUT = (bf16*)(ws + WS_WOUT); unsigned char* WMIN = ws + WS_WMIN; unsigned char* WMOUT = ws + WS_WMOUT;
    unsigned char* H2 = ws + WS_H2; unsigned char* YB = ws + WS_Y; bf16* H1 = (bf16*)(ws + WS_H1); bf16* PROJ = (bf16*)(ws + WS_PROJ); float* GATE = (float*)(ws + WS_GATE);
    bf16* US = (bf16*)(ws + WS_US);    bf16* ST16 = (bf16*)(ws + WS_ST16); bf16* MIX = (bf16*)(ws + WS_MIX); bf16* M16 = (bf16*)(ws + WS_M16); unsigned char* ACT = ws + WS_ACT;

    for (int u = tid; u < (LDS_BYTES - LDSCTL_OFF) / 4; u += NTHR) ((LAS unsigned*)(lds + LDSCTL_OFF))[u] = 0u;
    __syncthreads();
    XcdBarrier bar; bar.bar = ctl + CW_BAR; bar.x = 0; bar.st = nullptr;
#if MK_ONE_LAUNCH
    bar = xcd_barrier_post(ctl + CW_BAR, MISC + 8);
#define GRID_BAR() xcd_barrier(bar)
#else
#define GRID_BAR() do { } while (0)
#endif
    const int lo = args.ph_lo, hi = args.ph_hi;
#define IN(k) (lo <= (k) && (k) < hi)
#define BOTH(k) (IN(k) && IN((k) + 1))
    const int gw = bx * NWAVES + wave, NGW = G * NWAVES;
    const int gthr = bx * NTHR + tid, NGT = G * NTHR;

    if (IN(0)) {
        LAS float* scr = (LAS float*)(lds + wave * 16384);
        constexpr int I_IN = 16 * 96, I_OUT = 16 * 32, I_MIN = 32 * 16 * 64, I_MOUT = 32 * 16 * 32, NITEMS = I_IN + I_OUT + I_MIN + I_MOUT;
        {
            struct TI { const float* src; int nsrc; unsigned char* dst; int nd0, k0, mode; };
            auto decode = [&](int it, TI& t) {
                int r = it;
                if (r < I_MIN) { const int e = r / 1024, q = r % 1024, kb = q / 64, nb = q % 64, ns0 = 32 * nb, f = ns0 & 1023;
                    t.src = moe_w_in + (size_t)e * 1024 * 2048 + (size_t)(64 * kb) * 2048 + ns0; t.nsrc = 2048; t.dst = WMIN + (size_t)e * 2048 * 1024; t.nd0 = 256 * (f >> 7) + ((ns0 >= 1024) ? 128 : 0) + (f & 127); t.k0 = 64 * kb; t.mode = 2; return; }
                r -= I_MIN;
                if (r < I_MOUT) { const int e = r / 512, q = r % 512, kb = q / 32, nb = q % 32;
                    t.src = moe_w_out + (size_t)e * 1024 * 1024 + (size_t)(64 * kb) * 1024 + 32 * nb; t.nsrc = 1024; t.dst = WMOUT + (size_t)e * 1024 * 1024; t.nd0 = 32 * nb; t.k0 = 64 * kb; t.mode = 1; return; }
                r -= I_MOUT;
                if (r < I_IN) { const int kb = r / 96, nb = r % 96, nd0 = 32 * nb, ns0 = nd0 < 1024 ? nd0 : nd0 + 16;
                    t.src = w_in + (size_t)(64 * kb) * W_IN_COLS + ns0; t.nsrc = W_IN_COLS; t.dst = (unsigned char*)WIN; t.nd0 = nd0; t.k0 = 64 * kb; t.mode = 0; return; }
                r -= I_IN;
                { const int kb = r / 32, nb = r % 32; t.src = w_out + (size_t)(64 * kb) * 1024 + 32 * nb; t.nsrc = 1024; t.dst = (unsigned char*)WOUT; t.nd0 = 32 * nb; t.k0 = 64 * kb; t.mode = 0; }
            };
            TI cur, nxt; float wv[32], wn[32];
            int it = gw;
            if (it < NITEMS) { decode(it, cur);
#pragma unroll
                for (int i = 0; i < 32; ++i) wv[i] = cur.src[(size_t)(2 * i + (lane >> 5)) * cur.nsrc + (lane & 31)]; }
            for (; it < NITEMS; it += NGW) {
                const bool hn = it + NGW < NITEMS;
                if (hn) { decode(it + NGW, nxt);
#pragma unroll
                    for (int i = 0; i < 32; ++i) wn[i] = nxt.src[(size_t)(2 * i + (lane >> 5)) * nxt.nsrc + (lane & 31)]; }
#pragma unroll
                for (int i = 0; i < 32; ++i) scr[(2 * i + (lane >> 5)) * 33 + (lane & 31)] = wv[i];
                LDS_WAIT(); asm volatile("" ::: "memory");
                if (cur.mode == 0) { const int c = lane & 7;
#pragma unroll
                    for (int j = 0; j < 4; ++j) { const int n = (lane >> 3) + 8 * j; const LAS float* s = scr + (8 * c) * 33 + n;
                        v4u o; o.x = pk2(s[0 * 33], s[1 * 33]); o.y = pk2(s[2 * 33], s[3 * 33]); o.z = pk2(s[4 * 33], s[5 * 33]); o.w = pk2(s[6 * 33], s[7 * 33]);
                        *(v4u*)(cur.dst + ((size_t)(cur.nd0 + n) * 1024 + cur.k0 + 8 * c) * 2) = o; }
                } else { const int c = lane & 3; float ks[16];
#pragma unroll
                    for (int q = 0; q < 16; ++q) ks[q] = W8S;
                    if (cur.mode == 2) {
#pragma unroll
                        for (int q = 0; q < 4; ++q) { const f32x4 gg = *(const f32x4*)(g2 + cur.k0 + 16 * c + 4 * q); ks[4 * q] *= gg.x; ks[4 * q + 1] *= gg.y; ks[4 * q + 2] *= gg.z; ks[4 * q + 3] *= gg.w; } }
#pragma unroll
                    for (int j = 0; j < 2; ++j) { const int n = (lane >> 2) + 16 * j; const LAS float* s = scr + (16 * c) * 33 + n;
                        v4u o; o.x = pk4_fp8(s[0 * 33] * ks[0], s[1 * 33] * ks[1], s[2 * 33] * ks[2], s[3 * 33] * ks[3]); o.y = pk4_fp8(s[4 * 33] * ks[4], s[5 * 33] * ks[5], s[6 * 33] * ks[6], s[7 * 33] * ks[7]);
                        o.z = pk4_fp8(s[8 * 33] * ks[8], s[9 * 33] * ks[9], s[10 * 33] * ks[10], s[11 * 33] * ks[11]); o.w = pk4_fp8(s[12 * 33] * ks[12], s[13 * 33] * ks[13], s[14 * 33] * ks[14], s[15 * 33] * ks[15]);
                        *(v4u*)(cur.dst + (size_t)(cur.nd0 + n) * 1024 + cur.k0 + 16 * c) = o; } }
                LDS_WAIT(); asm volatile("" ::: "memory");
                if (hn) { cur = nxt;
#pragma unroll
                    for (int i = 0; i < 32; ++i) wv[i] = wn[i]; }
            }
        }
        for (int idx = gthr; idx < 16 * 1024; idx += NGT) { const int r = idx >> 10, d = idx & 1023; WLR[idx] = (bf16)f2bf(w_in[(size_t)d * W_IN_COLS + 1024 + r]); }
        for (int idx = gthr; idx < 1024 * 32; idx += NGT) RWP[idx] = router_w[idx] * g2[idx >> 5];
        for (int m0 = gw * 8; m0 < NTOK; m0 += NGW * 8) {
            const f32x4* gr = (const f32x4*)g1 + lane;
            f32x4 v[8][4]; float s[8];
#pragma unroll
            for (int j = 0; j < 8; ++j) { const f32x4* xr = (const f32x4*)(x + (size_t)(m0 + j) * DM) + lane;
#pragma unroll
                for (int jj = 0; jj < 4; ++jj) v[j][jj] = xr[64 * jj]; }
#pragma unroll
            for (int j = 0; j < 8; ++j) { float a = 0.f;
#pragma unroll
                for (int jj = 0; jj < 4; ++jj) a += (v[j][jj].x * v[j][jj].x + v[j][jj].y * v[j][jj].y) + (v[j][jj].z * v[j][jj].z + v[j][jj].w * v[j][jj].w);
                s[j] = a; }
#pragma unroll
            for (int o = 1; o < 64; o <<= 1) {
#pragma unroll
                for (int j = 0; j < 8; ++j) s[j] += __shfl_xor(s[j], o); }
#pragma unroll
            for (int j = 0; j < 8; ++j) { const float r = 1.f / sqrtf(s[j] * (1.f / DM) + EPS);
                unsigned long long* o8 = (unsigned long long*)(H1 + (size_t)(m0 + j) * DM) + lane;
#pragma unroll
                for (int jj = 0; jj < 4; ++jj) { const f32x4 gg = gr[64 * jj]; o8[64 * jj] = (unsigned long long)pk2(v[j][jj].x * r * gg.x, v[j][jj].y * r * gg.y) | ((unsigned long long)pk2(v[j][jj].z * r * gg.z, v[j][jj].w * r * gg.w) << 32); } }
        }
        if (BOTH(0)) GRID_BAR();
    }

    if (IN(1)) {
        pg8::Gemm g{H1, WIN, 2048, nullptr}; pg8::StaticOrder S; S.init(NTOK / 256, NIN / 256, G, bx);
        EpiProj E{PROJ, GATE, gate_bias, qng, kng, 0};
        if (tid < 64) ((LAS float*)(lds + RING_BYTES + 4096))[tid] = qng[tid] * kng[tid] * C2;
        pg8::TableOrder<pg8::StaticOrder> T; T.build(&S, UTAB);
        pg8::gemm_phase<EpiProj, pg8::TableOrder<pg8::StaticOrder>, true, false, false>(lds, g, T, E, lds + RING_BYTES + 4096);
        if (BOTH(1)) GRID_BAR();
    }

    if (IN(2)) {
        LAS float* cumL = ldsf;
        LAS float* lrp = ldsf + 16384;
        LAS float* gup = ldsf + 18432;
        LAS float* gbs = ldsf + 22528;
        LAS float* segs = ldsf + 22784;
        LAS float* totL = ldsf + 24832;
        LAS unsigned char* kdb = lds + 100352;
        LAS unsigned char* vsb = lds + 109568;
        if (bx < NCHT) { for (int i = tid; i < 1024; i += NTHR) ((LAS f32x4*)gup)[i] = ((const f32x4*)gate_up)[i]; if (tid < 64) ((LAS f32x4*)gbs)[tid] = ((const f32x4*)gate_bias)[tid]; }
        for (int chunk = bx; chunk < NCHT; chunk += G) {
            const size_t tok0 = (size_t)chunk * 64;
            {
                const int mt = wave & 3, kh = wave >> 2;
                const bf16* ap = H1 + (tok0 + 16 * mt + (lane & 15)) * 1024 + 512 * kh + 8 * (lane >> 4); const bf16* bp = WLR + (size_t)(lane & 15) * 1024 + 512 * kh + 8 * (lane >> 4);
                f32x4 a4 = {0.f, 0.f, 0.f, 0.f};
#pragma unroll
                for (int s = 0; s < 16; ++s) { const s16x8 a = *(const s16x8*)(ap + 32 * s), b = *(const s16x8*)(bp + 32 * s); a4 = __builtin_amdgcn_mfma_f32_16x16x32_bf16(a, b, a4, 0, 0, 0); }
#pragma unroll
                for (int rg = 0; rg < 4; ++rg) lrp[(kh * 64 + 16 * mt + 4 * (lane >> 4) + rg) * 16 + (lane & 15)] = a4[rg];
            }
            __syncthreads();
            {
                const int c = tid >> 3, jg = tid & 7; float lr[16];
#pragma unroll
                for (int q = 0; q < 4; ++q) { const f32x4 p0 = *(const LAS f32x4*)(lrp + c * 16 + 4 * q), p1 = *(const LAS f32x4*)(lrp + 1024 + c * 16 + 4 * q); lr[4 * q] = p0.x + p1.x; lr[4 * q + 1] = p0.y + p1.y; lr[4 * q + 2] = p0.z + p1.z; lr[4 * q + 3] = p0.w + p1.w; }
#pragma unroll
                for (int jj = 0; jj < 32; jj += 4) { const int j = jj * 8 + jg * 4; f32x4 z = *(const LAS f32x4*)(gbs + j);
#pragma unroll
                    for (int r = 0; r < 16; ++r) z += (*(const LAS f32x4*)(gup + r * 256 + j)) * lr[r];
                    f32x4 o;
#pragma unroll
                    for (int i = 0; i < 4; ++i) { const float zz = z[i]; const float t = __logf(1.f + __expf(-fabsf(zz))); o[i] = (fminf(zz, 0.f) - t) * (1.f / 16.f); }
                    *(LAS f32x4*)(cumL + c * 256 + j) = o; }
            }
            __syncthreads();
            {
                const int seg = tid >> 6, c4 = (tid & 63) * 4; f32x4 run = {0.f, 0.f, 0.f, 0.f};
#pragma unroll
                for (int i = 0; i < 8; ++i) { run += *(const LAS f32x4*)(cumL + (seg * 8 + i) * 256 + c4); *(LAS f32x4*)(cumL + (seg * 8 + i) * 256 + c4) = run; }
                *(LAS f32x4*)(segs + seg * 256 + c4) = run; }
            __syncthreads();
            { const int seg = tid >> 6, c4 = (tid & 63) * 4; f32x4 off = {0.f, 0.f, 0.f, 0.f};
              for (int s = 0; s < seg; ++s) off += *(const LAS f32x4*)(segs + s * 256 + c4);
#pragma unroll
              for (int i = 0; i < 8; ++i) { LAS f32x4* p = (LAS f32x4*)(cumL + (seg * 8 + i) * 256 + c4); *p = *p + off; }
              if (seg == 7) *(LAS f32x4*)(totL + c4) = off + *(const LAS f32x4*)(segs + 7 * 256 + c4); }
            __syncthreads();
            for (int h = 0; h < 4; ++h) {
                const int un = chunk * 4 + h;
#pragma unroll
                for (int j = 0; j < 2; ++j) { const int idx4 = tid + 512 * j, c = idx4 >> 4, k4 = (idx4 & 15) * 4;
                    const v2u kw = *(const v2u*)(PROJ + (tok0 + c) * PW + C_GK + h * 64 + k4);
                    const float kv[4] = {bflo(kw.x), bfhi(kw.x), bflo(kw.y), bfhi(kw.y)}; float kx[4];
                    const f32x4 tt = *(const LAS f32x4*)(totL + h * 64 + k4), cc = *(const LAS f32x4*)(cumL + c * 256 + h * 64 + k4);
#pragma unroll
                    for (int i = 0; i < 4; ++i) kx[i] = kv[i] * __expf(tt[i] - cc[i]);
                    v2u w; w.x = pk2(kx[0], kx[1]); w.y = pk2(kx[2], kx[3]); *(LAS v2u*)(kdb + c * 144 + k4 * 2) = w; }
#pragma unroll
                for (int j = 0; j < 4; ++j) { const int idx4 = tid + 512 * j, c = idx4 >> 5, v4 = (idx4 & 31) * 4;
                    *(LAS v2u*)(vsb + c * 272 + v4 * 2) = *(const v2u*)(PROJ + (tok0 + c) * PW + C_GV + h * 128 + v4); }
                if (tid < 64) DEC[(size_t)chunk * 256 + h * 64 + tid] = __expf(totL[h * 64 + tid]);
                __syncthreads();
                {
                    const int vblk = wave >> 1, kblk = wave & 1, hi = lane >> 5, q_ = (lane & 15) >> 2, p_ = lane & 3, g16 = (lane >> 4) & 1;
                    const LAS unsigned char* va = vsb + (4 * hi + q_) * 272 + (32 * vblk + 16 * g16 + 4 * p_) * 2;
                    const LAS unsigned char* ka = kdb + (4 * hi + q_) * 144 + (32 * kblk + 16 * g16 + 4 * p_) * 2;
                    f32x16 acc;
#pragma unroll
                    for (int i = 0; i < 16; ++i) acc[i] = 0.f;
#pragma unroll
                    for (int s = 0; s < 4; ++s) {
                        const s16x4 a0 = tr16(va + (16 * s) * 272), a1 = tr16(va + (16 * s + 8) * 272), b0 = tr16(ka + (16 * s) * 144), b1 = tr16(ka + (16 * s + 8) * 144);
                        const s16x8 A = {a0[0], a0[1], a0[2], a0[3], a1[0], a1[1], a1[2], a1[3]}, B = {b0[0], b0[1], b0[2], b0[3], b1[0], b1[1], b1[2], b1[3]};
                        acc = __builtin_amdgcn_mfma_f32_32x32x16_bf16(A, B, acc, 0, 0, 0); }
                    bf16* up = US + ((size_t)un * 128 + 32 * vblk + 4 * hi) * 64 + 32 * kblk + (lane & 31);
#pragma unroll
                    for (int r = 0; r < 16; ++r) up[((r & 3) + 8 * (r >> 2)) * 64] = (bf16)f2bf(acc[r]);
                }
                __syncthreads();
            }
        }
        if (BOTH(2)) GRID_BAR();
    }

    if (IN(3)) {
        if (!(args.flags & 4))
        for (int e = gthr; e < 65536; e += NGT) {
            const int b = e >> 15, idx = e & 32767, hk = ((idx >> 13) << 6) + (idx & 63);
            const bf16* up = US + (size_t)b * 256 * 32768 + idx; const float* dp = DEC + (size_t)b * 256 * 256 + hk; bf16* sp = ST16 + (size_t)b * 256 * 32768 + idx;
            float s = 0.f;
            for (int n = 0; n < 256; n += 32) { float uu[32], dd[32];
#pragma unroll
                for (int i = 0; i < 32; ++i) { uu[i] = bflo((unsigned)up[(size_t)(n + i) * 32768]); dd[i] = dp[(size_t)(n + i) * 256]; }
#pragma unroll
                for (int i = 0; i < 32; ++i) { s = dd[i] * s + uu[i]; sp[(size_t)(n + i) * 32768] = (bf16)f2bf(s); } }
        }
        if (!(args.flags & 8)) {
            const attn_body::AttnTensors AT{(const attn_body::bf16*)(PROJ + C_AQ), (const attn_body::bf16*)(PROJ + C_AK), (const attn_body::bf16*)(PROJ + C_AV), (attn_body::bf16*)(MIX + 512), rel_bias};
            const attn_body::StaticOrder S(G, bx);
            attn_body::attn_phase<attn_body::StaticOrder>((char*)lds_raw, AT, S);
        }
        if (BOTH(3)) GRID_BAR();
    }

    if (IN(4)) {
        for (int wu = gw; wu < NCHT * 8; wu += NGW) {
            const int chunk = wu >> 3, h = (wu >> 1) & 3, cb = wu & 1, un = chunk * 4 + h, l31 = lane & 31, hi = lane >> 5;
            const size_t tokq = (size_t)chunk * 64 + 32 * cb + l31, tok0 = (size_t)chunk * 64 + 32 * cb + 4 * hi;
            s16x8 qf[4];
#pragma unroll
            for (int s = 0; s < 4; ++s) qf[s] = *(const s16x8*)(PROJ + tokq * PW + C_GQ + h * 64 + 16 * s + 8 * hi);
            f32x16 acc[4];
#pragma unroll
            for (int vb = 0; vb < 4; ++vb) {
#pragma unroll
                for (int i = 0; i < 16; ++i) acc[vb][i] = 0.f;
#pragma unroll
                for (int s = 0; s < 4; ++s) { const s16x8 sf = *(const s16x8*)(ST16 + ((size_t)un * 128 + 32 * vb + l31) * 64 + 16 * s + 8 * hi);
                    acc[vb] = __builtin_amdgcn_mfma_f32_32x32x16_bf16(qf[s], sf, acc[vb], 0, 0, 0); } }
            float sc[16];
#pragma unroll
            for (int r = 0; r < 16; ++r) { float ssq = (acc[0][r] * acc[0][r] + acc[1][r] * acc[1][r]) + (acc[2][r] * acc[2][r] + acc[3][r] * acc[3][r]);
                ssq += __shfl_xor(ssq, 1); ssq += __shfl_xor(ssq, 2); ssq += __shfl_xor(ssq, 4); ssq += __shfl_xor(ssq, 8); ssq += __shfl_xor(ssq, 16);
                sc[r] = 0.125f / sqrtf(ssq * (1.f / (64.f * 128.f)) + EPS); }
#pragma unroll
            for (int vb = 0; vb < 4; ++vb) { const int v = 32 * vb + l31; const float gn = gla_ng[v]; bf16 ogw[16];
#pragma unroll
                for (int r = 0; r < 16; ++r) ogw[r] = PROJ[(tok0 + (r & 3) + 8 * (r >> 2)) * PW + C_OG + h * 128 + v];
#pragma unroll
                for (int r = 0; r < 16; ++r) { const float og = bflo((unsigned)ogw[r]); const float sg = og / (1.f + __expf(-og));
                    MIX[(tok0 + (r & 3) + 8 * (r >> 2)) * DM + h * 128 + v] = (bf16)f2bf(acc[vb][r] * sc[r] * gn * sg); } }
        }
        if (BOTH(4)) GRID_BAR();
    }

    if (IN(5)) {
        pg8::Gemm g{MIX, WOUT, 2048, nullptr}; pg8::StaticOrder S; S.init(NTOK / 256, 4, G, bx);
        EpiMix16 E{M16};
        pg8::TableOrder<pg8::StaticOrder> T; T.build(&S, UTAB);
        pg8::gemm_phase<EpiMix16, pg8::TableOrder<pg8::StaticOrder>, true, false, false>(lds, g, T, E, lds + RING_BYTES + 4096);
        if (BOTH(5)) GRID_BAR();
    }

    if (IN(6)) {
        LAS float* rwl = ldsf;
        LAS int* lh = (LAS int*)(lds + RING_BYTES + 1024);
        if (bx < 256) { for (int i = tid; i < 8192; i += NTHR) { const int d = i >> 3, c4 = (i & 7) * 4; *(LAS f32x4*)(rwl + d * 32 + (c4 ^ (16 * ((d >> 2) & 1)))) = *(const f32x4*)(RWP + d * 32 + c4); } }
        for (int blk = bx; blk < 256; blk += G) {
            const int t0 = blk * 128;
            if (tid < 32) lh[tid] = 0;
            __syncthreads();
            const int tk = lane & 15, kq = lane >> 4; const size_t m = (size_t)t0 + wave * 16 + tk;
            const float* xp = x + m * DM + 4 * kq; const bf16* mp = M16 + m * DM + 4 * kq; unsigned char* x8 = H2 + m * DM + 4 * kq;
            const LAS float* wp0 = rwl + (4 * kq) * 32 + (tk ^ (16 * (kq & 1))); const LAS float* wp1 = rwl + (4 * kq) * 32 + ((16 + tk) ^ (16 * (kq & 1)));
            f32x4 acc0 = {0.f, 0.f, 0.f, 0.f}, acc1 = acc0; float ss = 0.f;
            f32x4 xv[8]; v2u mv[8];
#pragma unroll
            for (int j = 0; j < 8; ++j) { xv[j] = *(const f32x4*)(xp + 16 * j); mv[j] = *(const v2u*)(mp + 16 * j); }
            for (int mm = 0; mm < 64; mm += 8) { f32x4 xn[8]; v2u mn[8];
#pragma unroll
                for (int j = 0; j < 8; ++j) { xn[j] = *(const f32x4*)(xp + 16 * ((mm + 8 + j) & 63)); mn[j] = *(const v2u*)(mp + 16 * ((mm + 8 + j) & 63)); }
#pragma unroll
                for (int j = 0; j < 8; ++j) { const f32x4 v = xv[j] + (f32x4){bflo(mv[j].x), bfhi(mv[j].x), bflo(mv[j].y), bfhi(mv[j].y)};
                    ss += (v.x * v.x + v.y * v.y) + (v.z * v.z + v.w * v.w);
                    if (!(args.flags & 64)) *(unsigned*)(x8 + 16 * (mm + j)) = pk4_fp8(v.x, v.y, v.z, v.w);
                    if (!(args.flags & 128))
#pragma unroll
                    for (int i = 0; i < 4; ++i) { const float a0 = wp0[(16 * (mm + j) + i) * 32], a1 = wp1[(16 * (mm + j) + i) * 32];
                        acc0 = __builtin_amdgcn_mfma_f32_16x16x4f32(a0, v[i], acc0, 0, 0, 0); acc1 = __builtin_amdgcn_mfma_f32_16x16x4f32(a1, v[i], acc1, 0, 0, 0); } }
#pragma unroll
                for (int j = 0; j < 8; ++j) { xv[j] = xn[j]; mv[j] = mn[j]; } }
            ss += __shfl_xor(ss, 16); ss += __shfl_xor(ss, 32);
            const float r = 1.f / sqrtf(ss * (1.f / DM) + EPS);
            float bv[4] = {-3e38f, -3e38f, -3e38f, -3e38f}; int bi[4] = {0, 0, 0, 0};
#pragma unroll
            for (int c = 0; c < 8; ++c) { const int e = (c < 4) ? (4 * kq + c) : (16 + 4 * kq + (c - 4)); float v = ((c < 4) ? acc0[c & 3] : acc1[c & 3]) * r + router_b[e]; int id = e;
#pragma unroll
                for (int s = 0; s < 4; ++s) { const bool gt = v > bv[s]; const float tv = gt ? bv[s] : v; const int ti = gt ? bi[s] : id; bv[s] = gt ? v : bv[s]; bi[s] = gt ? id : bi[s]; v = tv; id = ti; } }
#pragma unroll
            for (int xo = 16; xo <= 32; xo <<= 1) { float ov[4]; int oi[4];
#pragma unroll
                for (int s = 0; s < 4; ++s) { ov[s] = __shfl_xor(bv[s], xo); oi[s] = __shfl_xor(bi[s], xo); }
#pragma unroll
                for (int c = 0; c < 4; ++c) { float v = ov[c]; int id = oi[c];
#pragma unroll
                    for (int s = 0; s < 4; ++s) { const bool gt = (v > bv[s]) || (v == bv[s] && id < bi[s]); const float tv = gt ? bv[s] : v; const int ti = gt ? bi[s] : id; bv[s] = gt ? v : bv[s]; bi[s] = gt ? id : bi[s]; v = tv; id = ti; } } }
            if (kq == 0) {
                const float e1 = __expf(bv[1] - bv[0]), e2 = __expf(bv[2] - bv[0]), e3 = __expf(bv[3] - bv[0]); const float inv = 1.f / (1.f + e1 + e2 + e3);
                *(f32x4*)(TOPG + m * 4) = (f32x4){inv, e1 * inv, e2 * inv, e3 * inv};
                int rk[4];
#pragma unroll
                for (int s = 0; s < 4; ++s) rk[s] = atomicAdd((int*)&lh[bi[s]], 1);
                *(v4u*)(TOPE + m * 4) = (v4u){(unsigned)bi[0], (unsigned)bi[1], (unsigned)bi[2], (unsigned)bi[3]};
                *(v4u*)(RANK + m * 4) = (v4u){(unsigned)rk[0], (unsigned)rk[1], (unsigned)rk[2], (unsigned)rk[3]};
                RSTD[m] = r;
            }
            __syncthreads();
            if (tid < 32) HIST[blk * 32 + tid] = lh[tid];
            __syncthreads();
        }
        if (BOTH(6)) GRID_BAR();
    }

    if (IN(7)) {
        LAS int* ptot = (LAS int*)ldsf;
        LAS int* pbase = ptot + 512;
        LAS int* tot = pbase + 512;
        LAS int* pstart = tot + 32;
        LAS int* sbase = pstart + 32;
        for (int blk = bx; blk < 256; blk += G) {
            { const int e = tid & 31, part = tid >> 5; int a = 0, b = 0;
              for (int i = 0; i < 16; ++i) { const int bb = part * 16 + i; const int hv = HIST[bb * 32 + e]; a += hv; b += (bb < blk) ? hv : 0; }
              ptot[part * 32 + e] = a; pbase[part * 32 + e] = b; }
            __syncthreads();
            if (tid < 32) { int a = 0, b = 0; for (int p = 0; p < 16; ++p) { a += ptot[p * 32 + tid]; b += pbase[p * 32 + tid]; } tot[tid] = a; sbase[tid] = b; }
            __syncthreads();
            if (tid < 32) { int ps = 0; for (int e = 0; e < tid; ++e) ps += (tot[e] + 255) & ~255; pstart[tid] = ps; sbase[tid] += ps; }
            __syncthreads();
            { const int tl = tid >> 2, k = tid & 3; const size_t m = (size_t)blk * 128 + tl; const int e = TOPE[m * 4 + k]; const int slot = sbase[e] + RANK[m * 4 + k];
              BUFTOK[slot] = (int)m; GATESLOT[slot] = TOPG[m * 4 + k]; RSLOT[slot] = RSTD[m]; DSTROW[slot] = (int)m * 4 + k; }
            if (blk < 32) { const int e = blk, ps = pstart[e], te = tot[e], pe = (te + 255) & ~255;
                if (tid < 256 && te + tid < pe) { BUFTOK[ps + te + tid] = 0; GATESLOT[ps + te + tid] = 0.f; RSLOT[ps + te + tid] = 0.f; DSTROW[ps + te + tid] = NTOK * 4; }
                for (int t = tid; t < pe / 256; t += NTHR) TILEE[ps / 256 + t] = e;
                if (e == 31 && tid == 0) TILEE[1023] = (ps + pe) / 256; }
            __syncthreads();
        }
        if (BOTH(7)) GRID_BAR();
    }

    if (IN(8)) {
        const int nT = __builtin_amdgcn_readfirstlane(__hip_atomic_load(TILEE + 1023, __ATOMIC_RELAXED, __HIP_MEMORY_SCOPE_AGENT));
        pg8::Gemm g{H2, WMIN, 1024, BUFTOK}; pg8::MoeOrder S; S.init(nT, 8, G, bx, TILEE);
        EpiSwiglu E{ACT, moe_b_in, RSLOT, BUFTOK};
        pg8::TableOrder<pg8::MoeOrder> T; T.build(&S, UTAB);
        pg8::gemm_phase<EpiSwiglu, pg8::TableOrder<pg8::MoeOrder>, true, true, true>(lds, g, T, E, lds + RING_BYTES + 4096);
        if (BOTH(8)) GRID_BAR();
    }

    if (IN(9)) {
        const int nT = __builtin_amdgcn_readfirstlane(__hip_atomic_load(TILEE + 1023, __ATOMIC_RELAXED, __HIP_MEMORY_SCOPE_AGENT));
        pg8::Gemm g{ACT, WMOUT, 1024, nullptr}; pg8::MoeOrder S; S.init(nT, 4, G, bx, TILEE);
        EpiY E{YB, moe_b_out, GATESLOT, DSTROW};
        pg8::TableOrder<pg8::MoeOrder> T; T.build(&S, UTAB);
        pg8::gemm_phase<EpiY, pg8::TableOrder<pg8::MoeOrder>, true, false, true>(lds, g, T, E, lds + RING_BYTES + 4096);
        if (BOTH(9)) GRID_BAR();
    }

    if (IN(10)) {
        for (int m0 = gw * 4; m0 < NTOK; m0 += NGW * 4) {
            f32x4 a0[2][4], a1[2][4]; v4u mw[2][4]; v2u w[2][4][4];
#pragma unroll
            for (int j = 0; j < 2; ++j)
#pragma unroll
                for (int t = 0; t < 4; ++t) { const int col = 8 * lane + 512 * j; const float* op = x + (size_t)(m0 + t) * DM + col; a0[j][t] = *(const f32x4*)op; a1[j][t] = *(const f32x4*)(op + 4);
                    mw[j][t] = *(const v4u*)(M16 + (size_t)(m0 + t) * DM + col);
#pragma unroll
                    for (int kk = 0; kk < 4; ++kk) w[j][t][kk] = *(const v2u*)(YB + ((size_t)(m0 + t) * 4 + kk) * 1024 + col); }
#pragma unroll
            for (int j = 0; j < 2; ++j)
#pragma unroll
                for (int t = 0; t < 4; ++t) { const int col = 8 * lane + 512 * j; f32x4 b0 = a0[j][t], b1 = a1[j][t]; const v4u mm_ = mw[j][t];
                    b0 += (f32x4){bflo(mm_.x), bfhi(mm_.x), bflo(mm_.y), bfhi(mm_.y)}; b1 += (f32x4){bflo(mm_.z), bfhi(mm_.z), bflo(mm_.w), bfhi(mm_.w)};
                    f32x4 y0 = {0.f, 0.f, 0.f, 0.f}, y1 = y0;
#pragma unroll
                    for (int kk = 0; kk < 4; ++kk) { const v2u ww = w[j][t][kk];
                        y0.x += fp8f<0>(ww.x); y0.y += fp8f<1>(ww.x); y0.z += fp8f<2>(ww.x); y0.w += fp8f<3>(ww.x); y1.x += fp8f<0>(ww.y); y1.y += fp8f<1>(ww.y); y1.z += fp8f<2>(ww.y); y1.w += fp8f<3>(ww.y); }
                    b0 += y0 * (1.f / Y8S); b1 += y1 * (1.f / Y8S);
                    float* op = out + (size_t)(m0 + t) * DM + col; *(f32x4*)op = b0; *(f32x4*)(op + 4) = b1; }
        }
    }
#undef IN
#undef BOTH
}

extern "C" void kernel_launch(void* const* d_in, const int* in_sizes, int n_in, void* d_out, int out_size, void* d_ws, size_t ws_size, hipStream_t stream) {
    static int grid = 0;
    if (grid == 0) {
        if (n_in != 17 || in_sizes[0] != NTOK * DM || out_size != NTOK * DM || ws_size < WS_END) { fprintf(stderr, "kernel_launch: unexpected shapes (n_in %d, in0 %d, out %d, ws %zu)\n", n_in, n_in > 0 ? in_sizes[0] : -1, out_size, ws_size); grid = -1; return; }
        int dev = 0, cus = 0, per_cu = 0;
        if (hipGetDevice(&dev) != hipSuccess || hipDeviceGetAttribute(&cus, hipDeviceAttributeMultiprocessorCount, dev) != hipSuccess) { grid = -1; return; }
        if (hipFuncSetAttribute((const void*)fwd, hipFuncAttributeMaxDynamicSharedMemorySize, LDS_BYTES) != hipSuccess) { fprintf(stderr, "kernel_launch: hipFuncSetAttribute failed\n"); grid = -1; return; }
        if (hipOccupancyMaxActiveBlocksPerMultiprocessor(&per_cu, (const void*)fwd, NTHR, LDS_BYTES) != hipSuccess || per_cu < 1) fprintf(stderr, "kernel_launch: occupancy query reports %d\n", per_cu);
        (void)hipGetLastError();
        grid = cus;
    }
    if (grid < 0) return;
    (void)hipMemsetAsync((char*)d_ws + WS_CTL, 0, CTL_ZERO_BYTES, stream);
    Args a{};
    for (int i = 0; i < 17; ++i) a.in[i] = (const float*)d_in[i];
    a.out = (float*)d_out; a.ws = (unsigned char*)d_ws; a.li = 0; a.flags = 0;
#if MK_ONE_LAUNCH && !PROBE_MULTI
    a.ph_lo = 0; a.ph_hi = NPHASE;
    hipLaunchKernelGGL(fwd, dim3(grid), dim3(NTHR), LDS_BYTES, stream, a);
#else
    for (int p = 0; p < NPHASE; ++p) { a.ph_lo = p; a.ph_hi = p + 1; a.flags = 0; hipLaunchKernelGGL(fwd, dim3(grid), dim3(NTHR), LDS_BYTES, stream, a);
        if (p == PROBE_DUP) { a.flags = PROBE_FLAGS; hipLaunchKernelGGL(fwd, dim3(grid), dim3(NTHR), LDS_BYTES, stream, a); } }
#endif
}
```

```cpp
#include <hip/hip_runtime.h>
#include <cstdio>
#include <cstdint>

#ifndef MK_ONE_LAUNCH
#define MK_ONE_LAUNCH 1
#endif
#ifndef PROBE_DUP
#define PROBE_MULTI 0
#define PROBE_DUP -1
#define PROBE_FLAGS 0
#endif

namespace pg8 {
#define PG8_LAS __attribute__((address_space(3)))
typedef unsigned short bf16_t;
typedef short bf16x8 __attribute__((ext_vector_type(8)));
typedef float f32x4 __attribute__((ext_vector_type(4)));
typedef unsigned u32x4 __attribute__((ext_vector_type(4)));
constexpr int BM = 256, BK = 64, HALF = 128, HTB = HALF * BK * 2, STAGE_BYTES = 8 * HTB, NXCD = 8, WGM = 8;

__host__ __device__ __forceinline__ int lds_byte(int r, int c) { const int st = (r >> 4) * 2 + (c >> 5), rr = r & 15, cc = c & 31, ob = rr * 64 + cc * 2; return st * 1024 + (ob ^ (((ob >> 9) & 1) << 5)); }
__host__ __device__ __forceinline__ void stage_rc(int b, int& R, int& C) { const int st = b / 1024, sb = b % 1024, swz = sb ^ (((sb >> 9) & 1) << 5); R = (st >> 1) * 16 + swz / 64; C = (st & 1) * 32 + (swz % 64) / 2; }
__host__ __device__ __forceinline__ int perm32(int rho) { const int n = rho >> 4, i = rho & 15; return 8 * (i >> 2) + 4 * n + (i & 3); }

struct Unit { int pm, pn, pb, e; };
struct Gemm { const void* A; const void* Bt; int kbytes; const int* rowtok; };
typedef int v4i_t __attribute__((ext_vector_type(4)));
typedef int v8i_t __attribute__((ext_vector_type(8)));

__device__ __forceinline__ bool tile_of(long L, int nM, int nN, int& pm, int& pn) {
    const int nwg = nM * nN; if (L >= nwg) return false;
    int wgid = (int)L; { const int q = nwg / NXCD, r = nwg % NXCD, xcd = wgid % NXCD, off = wgid / NXCD; wgid = (xcd < r ? xcd * (q + 1) : r * (q + 1) + (xcd - r) * q) + off; }
    const int nig = WGM * nN, gid = wgid / nig, fm = gid * WGM, gsz = (nM - fm) < WGM ? (nM - fm) : WGM;
    pm = fm + ((wgid % nig) % gsz); pn = (wgid % nig) / gsz; return true;
}
__device__ __forceinline__ bool short_block(int nwg, int G, int c) { const int rounds = (nwg + G - 1) / G; return (nwg % G) != 0 && (long)(rounds - 1) * G + c >= nwg; }
struct StaticOrder {
    int nM, nN, G, c;
    __device__ void init(int nM_, int nN_, int G_, int c_) { nM = nM_; nN = nN_; G = G_; c = c_; }
    __device__ __forceinline__ bool next(int i, Unit& u) const { if (!tile_of((long)i * G + c, nM, nN, u.pm, u.pn)) return false; u.pb = u.pn; u.e = 0; return true; }
    __device__ __forceinline__ bool next_lane(int i, Unit& u) const { return next(i, u); }
};
struct MoeOrder {
    int nM, nN, G, c; const int* tile_e;
    __device__ void init(int nM_, int nN_, int G_, int c_, const int* te) { nM = nM_; nN = nN_; G = G_; c = c_; tile_e = te; }
    __device__ __forceinline__ bool next(int i, Unit& u) const { if (!tile_of((long)i * G + c, nM, nN, u.pm, u.pn)) return false; u.e = __builtin_amdgcn_readfirstlane(__hip_atomic_load(tile_e + u.pm, __ATOMIC_RELAXED, __HIP_MEMORY_SCOPE_AGENT)); u.pb = u.e * nN + u.pn; return true; }
    __device__ __forceinline__ bool next_lane(int i, Unit& u) const { if (!tile_of((long)i * G + c, nM, nN, u.pm, u.pn)) return false; u.e = __hip_atomic_load(tile_e + u.pm, __ATOMIC_RELAXED, __HIP_MEMORY_SCOPE_AGENT); u.pb = u.e * nN + u.pn; return true; }
};

struct OwnOrder {
    int nN, nb, jj, lo, nown, S, U, ns; bool has_own, own_first, split; int pm_own; const int* tile_e;
    __device__ __forceinline__ void init(int nT, int nN_, int G, int c, const int* te, bool own_first_, bool rev) {
        nN = nN_; tile_e = te; own_first = own_first_;
        const int NX = (G % NXCD == 0) ? NXCD : 1; nb = G / NX; const int x = c % NX, j = c / NX;
        const int q = nT / NX, r = nT % NX, cnt = q + (x < r ? 1 : 0); lo = x * q + (x < r ? x : r);
        nown = cnt < nb ? cnt : nb; has_own = j < nown; pm_own = lo + j; S = cnt - nown; U = S * nN; jj = rev ? nb - 1 - j : j; ns = (U > jj) ? (U - jj + nb - 1) / nb : 0;
        split = own_first && nN == 4 && nown == nb && (nb % 2) == 0;
    }
    __device__ __forceinline__ bool decode(int i, int& pm, int& pn) const {
        const int no = has_own ? nN : 0; int k;
        if (own_first) {
            if (split) { if (i < 2) { pm = pm_own; pn = i; return true; } if (i < 4) { const int h = nb / 2; pm = lo + (jj % h) + h * (i - 2); pn = 2 + jj / h; return true; } k = ns - 1 - (i - 4); }
            else { if (i < no) { pm = pm_own; pn = i; return true; } k = ns - 1 - (i - no); } }
        else { const int sg = (no && ns >= 3) ? (jj & 3) : 0, h0 = ns - sg;
            if (i < h0) k = i; else if (i < h0 + no) { pm = pm_own; pn = i - h0; return true; } else if (i < ns + no) k = i - no; else return false; }
        const int w = k * nb + jj; if (k < 0 || w >= U) return false;
        const int nig = WGM * nN, gid = w / nig, fm = gid * WGM, gsz = (S - fm) < WGM ? (S - fm) : WGM;
        pm = lo + nown + fm + ((w % nig) % gsz); pn = (w % nig) / gsz; return true;
    }
    __device__ __forceinline__ bool next(int i, Unit& u) const { int pm, pn; if (!decode(i, pm, pn)) return false; u.pm = __builtin_amdgcn_readfirstlane(pm); u.pn = __builtin_amdgcn_readfirstlane(pn);
        u.e = __builtin_amdgcn_readfirstlane(__hip_atomic_load(tile_e + u.pm, __ATOMIC_RELAXED, __HIP_MEMORY_SCOPE_AGENT)); u.pb = u.e * nN + u.pn; return true; }
    __device__ __forceinline__ bool next_lane(int i, Unit& u) const { int pm, pn; if (!decode(i, pm, pn)) return false; u.pm = pm; u.pn = pn; u.e = __hip_atomic_load(tile_e + pm, __ATOMIC_RELAXED, __HIP_MEMORY_SCOPE_AGENT); u.pb = u.e * nN + pn; return true; }
};
template <class Inner> struct SubOrder {
    Inner S; int off, n;
    __device__ __forceinline__ bool next(int i, Unit& u) const { return i < n && S.next(i + off, u); }
    __device__ __forceinline__ bool next_lane(int i, Unit& u) const { return i < n && S.next_lane(i + off, u); }
};

template <class Inner> struct TableOrder {
    PG8_LAS int* tab;
    __device__ __forceinline__ void build(const Inner* S_, PG8_LAS int* tab_) { tab = tab_;
        if (threadIdx.x < 64) { Unit u; const bool ok = S_->next_lane((int)threadIdx.x, u); PG8_LAS int* t = tab + 4 * threadIdx.x; t[0] = ok ? u.pm : -1; t[1] = u.pn; t[2] = u.pb; t[3] = u.e; }
        __syncthreads(); }
    __device__ __forceinline__ bool next(int i, Unit& u) const { if (i >= 64) return false;
        const v4i_t t = *(const PG8_LAS v4i_t*)(tab + 4 * i); u.pm = __builtin_amdgcn_readfirstlane(t[0]); u.pn = __builtin_amdgcn_readfirstlane(t[1]); u.pb = __builtin_amdgcn_readfirstlane(t[2]); u.e = __builtin_amdgcn_readfirstlane(t[3]); return u.pm >= 0; }
};
__device__ __forceinline__ unsigned cvt_pk_bf16(float lo, float hi) { unsigned r; asm volatile("v_cvt_pk_bf16_f32 %0, %1, %2" : "=v"(r) : "v"(lo), "v"(hi)); return r; }

template <bool FP8> struct FragT;
template <> struct FragT<false> { struct type { bf16x8 f[2]; }; };
template <> struct FragT<true> { struct type { v8i_t v; }; };
template <class Epi, class Sched, bool ALIGN_EPI, bool GATHER, bool FP8>
__device__ __forceinline__ void gemm_phase(PG8_LAS unsigned char* lds, const Gemm g, const Sched& S, const Epi& E, PG8_LAS unsigned char* side) {
    const int delay_ticks = 0;
    const int tid = threadIdx.x, wid = __builtin_amdgcn_readfirstlane(tid >> 6), lane = tid & 63, wr = wid >> 2, wc = wid & 3, fr = lane & 15, fq = lane >> 4;
    const int KB = g.kbytes, nt = KB / 128;
    const size_t kstep = (size_t)128;
    const size_t hstep = (size_t)HALF * KB;
    const size_t tstep = 2 * hstep;
    const size_t bhstep = Epi::LINE16 ? (size_t)8 * KB : Epi::HEADPERM ? (size_t)32 * KB : hstep;
    int RA[2]; unsigned CA2[2], voffB[2];
#pragma unroll
    for (int i = 0; i < 2; ++i) { int R, C; stage_rc(tid * 16 + i * 8192, R, C); const int Rb = Epi::LINE16 ? (64 * (R >> 5) + 16 * ((R >> 2) & 3) + 4 * ((R >> 4) & 1) + (R & 3)) : Epi::HEADPERM ? (64 * (R >> 5) + perm32(R & 31)) : (Epi::PERM ? ((R & ~31) + perm32(R & 31)) : R);
        RA[i] = R; CA2[i] = (unsigned)C * 2u; voffB[i] = (unsigned)(Rb * KB) + (unsigned)C * 2u; }
    const unsigned ldsw = (unsigned)wid * 1024u;
    const int aoff = lds_byte(wr * 64 + fr, fq * 8), boff = lds_byte(wc * 32 + fr, fq * 8);
#define PG8_SA(b, h) (((b) * 2 + (h)) * HTB)
#define PG8_SB(b, h) ((4 + (b) * 2 + (h)) * HTB)
#define PG8_STAGE(bufoff, gbase, voff) do { _Pragma("unroll") for (int _i = 0; _i < 2; ++_i) \
        __builtin_amdgcn_global_load_lds((const unsigned*)((const char*)(gbase) + (voff)[_i]), (PG8_LAS unsigned*)(lds + (bufoff) + ldsw + _i * 8192), 16, 0, 0); } while (0)
#define PG8_LDF(dst, addr) do { if constexpr (FP8) { const v4i_t lo_ = *(const PG8_LAS v4i_t*)(addr), hi_ = *(const PG8_LAS v4i_t*)((addr) + 1024); dst.v = __builtin_shufflevector(lo_, hi_, 0, 1, 2, 3, 4, 5, 6, 7); } \
        else { dst.f[0] = *(const PG8_LAS bf16x8*)(addr); dst.f[1] = *(const PG8_LAS bf16x8*)((addr) + 1024); } } while (0)
#define PG8_LDA(dst, b, h) do { _Pragma("unroll") for (int m = 0; m < 4; ++m) PG8_LDF(dst[m], lds + PG8_SA(b, h) + aoff + m * 2048); } while (0)
#define PG8_LDB(dst, b, h) do { _Pragma("unroll") for (int n = 0; n < 2; ++n) PG8_LDF(dst[n], lds + PG8_SB(b, h) + boff + n * 2048); } while (0)
#define PG8_MMA(ai, bj, At, Bt) do { __builtin_amdgcn_s_setprio(1); _Pragma("unroll") for (int m = 0; m < 4; ++m) _Pragma("unroll") for (int n = 0; n < 2; ++n) { \
        if constexpr (FP8) asm volatile("s_nop 1\n\tv_mfma_f32_16x16x128_f8f6f4 %0, %1, %2, %0" : "+v"(acc[ai][bj][m][n]) : "v"(Bt[n].v), "v"(At[m].v)); \
        else { _Pragma("unroll") for (int k = 0; k < 2; ++k) acc[ai][bj][m][n] = __builtin_amdgcn_mfma_f32_16x16x32_bf16(Bt[n].f[k], At[m].f[k], acc[ai][bj][m][n], 0, 0, 0); } } __builtin_amdgcn_s_setprio(0); } while (0)
#define PG8_WAIT_V(n) asm volatile("s_waitcnt vmcnt(" #n ")" ::: "memory")
#define PG8_WAIT_L(n) asm volatile("s_waitcnt lgkmcnt(" #n ")" ::: "memory")
#define PG8_BAR __builtin_amdgcn_s_barrier()
#define PG8_SCHED __builtin_amdgcn_sched_barrier(0)
#define PG8_AOFF(dst, u) do { _Pragma("unroll") for (int h_ = 0; h_ < 2; ++h_) _Pragma("unroll") for (int i_ = 0; i_ < 2; ++i_) { \
        if constexpr (GATHER) { const int tok_ = g.rowtok[(u).pm * BM + h_ * HALF + RA[i_]]; dst[h_][i_] = (unsigned)tok_ * (unsigned)KB + CA2[i_]; } \
        else { dst[h_][i_] = (unsigned)(RA[i_] * KB) + CA2[i_] + (unsigned)(h_ * (int)hstep); } } } while (0)
#define PG8_ABASE(u) ((const char*)g.A + (GATHER ? (size_t)0 : (size_t)(u).pm * tstep))
    Unit cur, nxt; int ui = 0;
    if (!S.next(0, cur)) return;
    if (delay_ticks > 0) { const unsigned long long t0_ = __builtin_amdgcn_s_memrealtime(); while ((long long)(__builtin_amdgcn_s_memrealtime() - t0_) < (long long)delay_ticks) __builtin_amdgcn_s_sleep(16); }
    f32x4 acc[2][2][4][2];
#pragma unroll
    for (int a = 0; a < 2; ++a)
#pragma unroll
        for (int b = 0; b < 2; ++b)
#pragma unroll
            for (int m = 0; m < 4; ++m)
#pragma unroll
                for (int n = 0; n < 2; ++n) acc[a][b][m][n] = (f32x4){0.f, 0.f, 0.f, 0.f};
    typedef typename FragT<FP8>::type frag_t;
    frag_t At[4], B0[2], B1[2];
    unsigned vA[2][2], nvA[2][2];
    PG8_AOFF(vA, cur);
#pragma unroll
    for (int h_ = 0; h_ < 2; ++h_) { nvA[h_][0] = vA[h_][0]; nvA[h_][1] = vA[h_][1]; }
    const char* cA = PG8_ABASE(cur); const char* cB = (const char*)g.Bt + (size_t)cur.pb * tstep;
    PG8_STAGE(PG8_SB(0, 0), cB, voffB); PG8_STAGE(PG8_SB(0, 1), cB + bhstep, voffB); PG8_STAGE(PG8_SA(0, 0), cA, vA[0]); PG8_STAGE(PG8_SA(0, 1), cA, vA[1]);
    if (wr == 1) PG8_BAR;
    PG8_WAIT_V(2); PG8_BAR;
    PG8_STAGE(PG8_SB(1, 0), cB + kstep, voffB); PG8_STAGE(PG8_SA(1, 0), cA + kstep, vA[0]); PG8_STAGE(PG8_SB(1, 1), cB + bhstep + kstep, voffB);
    PG8_WAIT_V(6); PG8_BAR;
    for (;;) {
        const bool has_next = S.next(ui + 1, nxt);
        const char* nA = has_next ? PG8_ABASE(nxt) : cA; const char* nB = has_next ? (const char*)g.Bt + (size_t)nxt.pb * tstep : cB;
#pragma clang loop unroll(disable)
        for (int t = 0; t < nt; t += 2) {
            const bool last = (t == nt - 2);
            const char* a1 = cA + (size_t)(t + 1) * kstep;
            const char* a2 = last ? nA : cA + (size_t)(t + 2) * kstep; const char* b2 = last ? nB : cB + (size_t)(t + 2) * kstep;
            const char* a3 = a2 + kstep; const char* b3 = b2 + kstep;
            if constexpr (GATHER) { if (last && has_next) {
#pragma unroll
                for (int h_ = 0; h_ < 2; ++h_)
#pragma unroll
                    for (int i_ = 0; i_ < 2; ++i_) nvA[h_][i_] = (unsigned)(*(const PG8_LAS int*)(side + 2048 + (h_ * HALF + RA[i_]) * 4)) * (unsigned)KB + CA2[i_]; } }
            unsigned sA[2][2];
#pragma unroll
            for (int h_ = 0; h_ < 2; ++h_)
#pragma unroll
                for (int i_ = 0; i_ < 2; ++i_) sA[h_][i_] = (GATHER && last && has_next) ? nvA[h_][i_] : vA[h_][i_];
            PG8_LDB(B0, 0, 0); PG8_LDB(B1, 0, 1); PG8_SCHED; PG8_LDA(At, 0, 0); PG8_STAGE(PG8_SA(1, 1), a1, vA[1]);
            PG8_WAIT_V(8); PG8_WAIT_L(0); PG8_BAR; PG8_MMA(0, 0, At, B0); PG8_MMA(0, 1, At, B1); PG8_BAR; PG8_SCHED;
            PG8_LDA(At, 0, 1); PG8_STAGE(PG8_SB(0, 0), b2, voffB); PG8_STAGE(PG8_SB(0, 1), b2 + bhstep, voffB); PG8_STAGE(PG8_SA(0, 0), a2, sA[0]);
            if constexpr (Epi::SIDE) { if (t == 0) {
                __builtin_amdgcn_global_load_lds((const unsigned*)E.side_src(cur, nxt, has_next, wid & 3, lane), (PG8_LAS unsigned*)(side + (wid & 3) * 1024), 16, 0, 0); } }
            PG8_WAIT_V(8); PG8_WAIT_L(0); PG8_BAR; PG8_MMA(1, 0, At, B0); PG8_MMA(1, 1, At, B1); PG8_BAR; PG8_SCHED;
            PG8_LDB(B0, 1, 0); PG8_LDB(B1, 1, 1); PG8_SCHED; PG8_LDA(At, 1, 0); PG8_STAGE(PG8_SA(0, 1), a2, sA[1]);
            PG8_WAIT_V(8); PG8_WAIT_L(0); PG8_BAR; PG8_MMA(0, 0, At, B0); PG8_MMA(0, 1, At, B1); PG8_BAR; PG8_SCHED;
            PG8_LDA(At, 1, 1); PG8_STAGE(PG8_SB(1, 0), b3, voffB); PG8_STAGE(PG8_SB(1, 1), b3 + bhstep, voffB); PG8_STAGE(PG8_SA(1, 0), a3, sA[0]);
            PG8_WAIT_V(8); PG8_WAIT_L(0); PG8_BAR; PG8_MMA(1, 0, At, B0); PG8_MMA(1, 1, At, B1); PG8_BAR; PG8_SCHED;
        }
        if constexpr (ALIGN_EPI) { if (wr == 0) PG8_BAR; }
        if constexpr (FP8) {
#define PG8_PIN8(a, b, s) asm volatile(s : "+v"(acc[a][b][0][0]), "+v"(acc[a][b][0][1]), "+v"(acc[a][b][1][0]), "+v"(acc[a][b][1][1]), "+v"(acc[a][b][2][0]), "+v"(acc[a][b][2][1]), "+v"(acc[a][b][3][0]), "+v"(acc[a][b][3][1]))
            PG8_PIN8(0, 0, "s_nop 15\n\ts_nop 7"); PG8_PIN8(0, 1, ""); PG8_PIN8(1, 0, ""); PG8_PIN8(1, 1, "");
#undef PG8_PIN8
        }
        E(acc, cur, wr, wc, fr, fq, side);
        if (!has_next) break;
#pragma unroll
        for (int a = 0; a < 2; ++a)
#pragma unroll
            for (int b = 0; b < 2; ++b)
#pragma unroll
                for (int m = 0; m < 4; ++m)
#pragma unroll
                    for (int n = 0; n < 2; ++n) acc[a][b][m][n] = (f32x4){0.f, 0.f, 0.f, 0.f};
        cur = nxt; cA = nA; cB = nB; ++ui;
        if constexpr (GATHER) {
#pragma unroll
            for (int h_ = 0; h_ < 2; ++h_) { vA[h_][0] = nvA[h_][0]; vA[h_][1] = nvA[h_][1]; } }
        if constexpr (ALIGN_EPI) { if (wr == 1) PG8_BAR; }
    }
    PG8_WAIT_V(0);
    if constexpr (!ALIGN_EPI) { if (wr == 0) PG8_BAR; }
    PG8_BAR;
#undef PG8_SA
#undef PG8_SB
#undef PG8_STAGE
#undef PG8_LDA
#undef PG8_LDB
#undef PG8_MMA
#undef PG8_LDF
#undef PG8_WAIT_V
#undef PG8_WAIT_L
#undef PG8_BAR
#undef PG8_SCHED
#undef PG8_AOFF
#undef PG8_ABASE
}
}

#include <hip/hip_bf16.h>
#include <cmath>
namespace attn_body {
using bf16=__hip_bfloat16;
using bf16x8=__attribute__((ext_vector_type(8)))short;
using s16x4=__attribute__((ext_vector_type(4)))short;
using f32x16=__attribute__((ext_vector_type(16)))float;
using u32x4=__attribute__((ext_vector_type(4)))unsigned;
constexpr int BATCH=2,NHEAD=8,SEQ=16384,D=64,DM=3072,OP=1024;
constexpr int NW=8,QBLK=32,QB=QBLK*NW,KVBLK=64,NQB=SEQ/QB;
constexpr int ATTN_PITCH=DM, ATTN_UNIT_ROWS=QB;
__device__ __forceinline__ int crow(int r,int hi){return (r&3)+8*(r>>2)+4*hi;}
#define SBAR() __builtin_amdgcn_sched_barrier(0)
__device__ __forceinline__ void cmask(f32x16&p0,f32x16&p1,int jb,int qrel,int hi){
  const float NEG=-INFINITY; int kb=64*jb+4*hi;
  #pragma unroll
  for(int r=0;r<16;++r){int kv=kb+(r&3)+8*(r>>2); if(kv>qrel)p0[r]=NEG; if(kv+32>qrel)p1[r]=NEG;}
}

constexpr int NSLOT=3, SLOTB=8192;
constexpr int LDS_K=0, LDS_V=NSLOT*SLOTB, LDS_WS=2*NSLOT*SLOTB, LDS_OST=LDS_WS+NW*64*4, LDS_BIAS=LDS_OST+NW*4096, BIAS_CP=1552, LDS_BYTES=LDS_BIAS+4*BIAS_CP;
constexpr float C2=0.125f*1.4426950408889634f;
__device__ __forceinline__ void glds16(const void*gsrc,unsigned lds_dst){unsigned keep;
  asm volatile("s_mov_b32 %0, m0\n\ts_mov_b32 m0, %2\n\ts_nop 0\n\tglobal_load_lds_dwordx4 %1, off\n\ts_mov_b32 m0, %0":"=&s"(keep):"v"(gsrc),"s"(lds_dst):"memory");}
__device__ __forceinline__ float max3f(float a,float b,float c){float r;asm("v_max3_f32 %0, %1, %2, %3":"=v"(r):"v"(a),"v"(b),"v"(c));return r;}
__device__ __forceinline__ float max2f(float a,float b){float r;asm("v_max_f32_e32 %0, %1, %2":"=v"(r):"v"(a),"v"(b));return r;}
__device__ __forceinline__ float fadd_s(float a,float b){float r;asm("v_add_f32_e32 %0, %1, %2":"=v"(r):"v"(a),"v"(b));return r;}
__device__ __forceinline__ float fsub_s(float a,float b){float r;asm("v_sub_f32_e32 %0, %1, %2":"=v"(r):"v"(a),"v"(b));return r;}
typedef float f32x2_t __attribute__((ext_vector_type(2))); typedef __bf16 bf16x2_t __attribute__((ext_vector_type(2)));
__device__ __forceinline__ unsigned cvtpk_s(float lo,float hi){f32x2_t v={lo,hi};bf16x2_t b=__builtin_convertvector(v,bf16x2_t);return __builtin_bit_cast(unsigned,b);}
#define WAIT_BAR(N) asm volatile("s_waitcnt vmcnt(" #N ") lgkmcnt(0)\n\ts_barrier":::"memory")

__device__ __forceinline__ void qkt(f32x16&p0,f32x16&p1,const char*Kslot,const bf16x8*qr,int r32,int hi){
  const char*kb=Kslot+hi*1024+r32*16;
  #pragma unroll
  for(int d0=0;d0<4;++d0){
    const bf16x8 b0=*reinterpret_cast<const bf16x8*>(kb+d0*2048);
    const bf16x8 b1=*reinterpret_cast<const bf16x8*>(kb+d0*2048+512);
    if(d0==0){p0=__builtin_amdgcn_mfma_f32_32x32x16_bf16(b0,qr[0],f32x16{},0,0,0);p1=__builtin_amdgcn_mfma_f32_32x32x16_bf16(b1,qr[0],f32x16{},0,0,0);}
    else{p0=__builtin_amdgcn_mfma_f32_32x32x16_bf16(b0,qr[d0],p0,0,0,0);p1=__builtin_amdgcn_mfma_f32_32x32x16_bf16(b1,qr[d0],p1,0,0,0);}}
}
typedef __attribute__((address_space(3))) const char* lds_cptr;
typedef short v4i16_t __attribute__((ext_vector_type(4)));
typedef float f32x4_t __attribute__((ext_vector_type(4)));
__device__ __forceinline__ void kload8(bf16x8*kf,lds_cptr kp){
  kf[0]=*(const __attribute__((address_space(3))) bf16x8*)(kp);      kf[1]=*(const __attribute__((address_space(3))) bf16x8*)(kp+512);
  kf[2]=*(const __attribute__((address_space(3))) bf16x8*)(kp+2048); kf[3]=*(const __attribute__((address_space(3))) bf16x8*)(kp+2560);
  kf[4]=*(const __attribute__((address_space(3))) bf16x8*)(kp+4096); kf[5]=*(const __attribute__((address_space(3))) bf16x8*)(kp+4608);
  kf[6]=*(const __attribute__((address_space(3))) bf16x8*)(kp+6144); kf[7]=*(const __attribute__((address_space(3))) bf16x8*)(kp+6656);
}
__device__ __forceinline__ void kload2(bf16x8*kf,lds_cptr kp,int j){ kf[2*j]=*(const __attribute__((address_space(3))) bf16x8*)(kp+j*2048); kf[2*j+1]=*(const __attribute__((address_space(3))) bf16x8*)(kp+j*2048+512); }
__device__ __forceinline__ s16x4 vtr(lds_cptr p){ return __builtin_bit_cast(s16x4,__builtin_amdgcn_ds_read_tr16_b64_v4i16((__attribute__((address_space(3))) v4i16_t*)p)); }
__device__ __forceinline__ float rowmax(const f32x16&p0,const f32x16&p1){
  float a=max3f(p0[0],p0[1],p1[0]),b=max3f(p0[2],p0[3],p1[1]);a=max3f(a,p1[2],p1[3]);
  #pragma unroll
  for(int r=4;r<16;r+=4){a=max3f(a,p0[r],p0[r+1]);b=max3f(b,p0[r+2],p0[r+3]);a=max3f(a,p1[r],p1[r+1]);b=max3f(b,p1[r+2],p1[r+3]);}
  const float m=max2f(a,b);
  auto rr=__builtin_amdgcn_permlane32_swap(__float_as_uint(m),__float_as_uint(m),false,false);
  return max2f(__uint_as_float(rr[0]),__uint_as_float(rr[1]));
}
__device__ __forceinline__ void pv(f32x16*o,int vb,bf16x8 pa0,bf16x8 pa1,bf16x8 pa2,bf16x8 pa3){
  #pragma unroll
  for(int d0=0;d0<2;++d0){s16x4 lo[4],hi[4];
    #pragma unroll
    for(int ks=0;ks<4;++ks){
      asm volatile("ds_read_b64_tr_b16 %0,%1 offset:%c2":"=&v"(lo[ks]):"v"(vb),"i"(d0*4096+ks*1024):"memory");
      asm volatile("ds_read_b64_tr_b16 %0,%1 offset:%c2":"=&v"(hi[ks]):"v"(vb),"i"(d0*4096+ks*1024+512):"memory");}
    asm volatile("s_waitcnt lgkmcnt(0)":::"memory");SBAR();
    #define PK(k) (bf16x8){lo[k][0],lo[k][1],lo[k][2],lo[k][3],hi[k][0],hi[k][1],hi[k][2],hi[k][3]}
    o[d0]=__builtin_amdgcn_mfma_f32_32x32x16_bf16(pa0,PK(0),o[d0],0,0,0);
    o[d0]=__builtin_amdgcn_mfma_f32_32x32x16_bf16(pa1,PK(1),o[d0],0,0,0);
    o[d0]=__builtin_amdgcn_mfma_f32_32x32x16_bf16(pa2,PK(2),o[d0],0,0,0);
    o[d0]=__builtin_amdgcn_mfma_f32_32x32x16_bf16(pa3,PK(3),o[d0],0,0,0);
    #undef PK
  }
}

__device__ __forceinline__ void maskbias(f32x16&p0,f32x16&p1,int dl,lds_cptr bl,float cfar,float mh){
  if(dl<0||dl>8){
    #pragma unroll
    for(int r=0;r<16;++r){p0[r]=-INFINITY;p1[r]=-INFINITY;}
  } else if(dl>=5){
    {const float cc=cfar-mh; _Pragma("unroll") for(int r=0;r<16;++r){p0[r]+=cc;p1[r]+=cc;}}
  } else { const lds_cptr b=bl-256*dl;
    #pragma unroll
    for(int g=0;g<4;++g){ const f32x4_t x0=*(const __attribute__((address_space(3))) f32x4_t*)(b+32*g), x1=*(const __attribute__((address_space(3))) f32x4_t*)(b+32*g+128);
      #pragma unroll
      for(int e=0;e<4;++e){p0[4*g+e]+=x0[e]-mh;p1[4*g+e]+=x1[e]-mh;} } }
}
#ifndef ATTN_STORE16
#define ATTN_STORE16(p,v) (*(u32x4*)(p)=(v))
#endif
template<int THRL> __device__ __forceinline__ void attn_unit(int b,int h,int qb,const bf16*Q,const bf16*__restrict__ K,const bf16*__restrict__ V,bf16*O,const float*relb,char*shm,bool fill,bf16x8(&qr)[4],bool pre_done,bool want_pre,int b2,int h2,int qb2,bool&pre_out){
  const int tid=threadIdx.x,lane=tid&63,r32=lane&31,hi=lane>>5; const int wid=__builtin_amdgcn_readfirstlane(tid>>6);
  const long rowbase=(long)b*SEQ; const int q0=qb*QB;
  const bf16*Qw=Q+(rowbase+q0+wid*QBLK)*DM+h*D;
  const bf16*Kh=K+rowbase*DM+h*D,*Vh=V+rowbase*DM+h*D;
  const unsigned lds0=(unsigned)(uintptr_t)shm;
  const lds_cptr shm3b=(lds_cptr)shm;
  float*wsf=(float*)(shm+LDS_WS)+wid*64;
  const bf16*ksrc=Kh+(long)lane*DM+wid*8;
  const bf16*vsrc=Vh+(long)(16*(wid&3)+(lane>>2))*DM+(wid>>2)*32+(lane&3)*8;
  const unsigned kdst=lds0+LDS_K+wid*1024, vdst=lds0+LDS_V+wid*1024;
  #define TOFF(t) ((t)==0?0:((t)<=nb?-(t):(t)-nb))
  #define DMA_K(t,slot) glds16(ksrc+(long)(q0+KVBLK*TOFF(t))*DM,(unsigned)__builtin_amdgcn_readfirstlane(kdst+(slot)))
  #define DMA_V(t,slot) glds16(vsrc+(long)(q0+KVBLK*TOFF(t))*DM,(unsigned)__builtin_amdgcn_readfirstlane(vdst+(slot)))
  const int vb0=(int)(lds0+LDS_V)+((lane>>4)&1)*32+(lane&3)*8+(4*hi+((lane&15)>>2))*64;
  const char*Kbase=shm+LDS_K; bf16x8 kf[8];
  const lds_cptr shm3=(lds_cptr)shm; const lds_cptr kp0=shm3+LDS_K+hi*1024+r32*16; const lds_cptr vp0=shm3+LDS_V+((lane>>4)&1)*32+(lane&3)*8+(4*hi+((lane&15)>>2))*64;
  const int nb=(4*qb<8)?4*qb:8; const int NT=4+nb;
  const int pw_=wid>>1, qi_=32*(wid&1)+r32, al_=(3-qi_)&3;
  if(fill){ __attribute__((address_space(3))) float* bc=(__attribute__((address_space(3))) float*)(shm3b+LDS_BIAS);
    for(int j=tid;j<4*388;j+=512){const int a=j/388,jj=j-a*388,rel=319-jj-a; bc[j]=(rel>=-63)?relb[(rel>256?256:rel)+256]*1.4426950408889634f:0.f;} }
  const float cfar=relb[512]*1.4426950408889634f;
  const lds_cptr bl_=shm3b+LDS_BIAS+al_*BIAS_CP+(319-qi_+4*hi-al_)*4;
  if(!pre_done){ DMA_K(0,0);DMA_V(0,0);DMA_K(1,SLOTB);
  _Pragma("unroll") for(int d0=0;d0<4;++d0)qr[d0]=*reinterpret_cast<const bf16x8*>(&Qw[(long)r32*DM+d0*16+hi*8]); }
  float mhat=0.f,l_reg=0.f;f32x16 o[2];o[0]=f32x16{};o[1]=f32x16{};
  const int qrel=wid*QBLK+r32;
  #define CMASK(P0,P1,t) maskbias(P0,P1,pw_-TOFF(t),bl_,cfar,mhat)
  bool resc=false;
  #define START(P0,P1) do{ const float rm=rowmax(P0,P1); resc=false; \
    { const float dl=rm; mhat=fadd_s(mhat,dl); \
      _Pragma("unroll") for(int r=0;r<16;++r){P0[r]=fsub_s(P0[r],dl);P1[r]=fsub_s(P1[r],dl);} } \
    _Pragma("unroll") for(int r=0;r<16;++r)P0[r]=__builtin_amdgcn_exp2f(P0[r]); }while(0)
  #define RESC() do{ if(resc){ asm volatile("s_waitcnt lgkmcnt(0)":::"memory"); \
      _Pragma("unroll") for(int d_=0;d_<2;++d_) _Pragma("unroll") for(int r=0;r<16;++r)o[d_][r]*=wsf[crow(r,hi)]; } }while(0)
  f32x16 pA0,pA1,pB0,pB1;
  int sl_prev=0,sl_cur=0,sl_next=SLOTB;
  #define ROT() do{sl_prev=sl_cur;sl_cur=sl_next;sl_next=(sl_next==(NSLOT-1)*SLOTB)?0:sl_next+SLOTB;}while(0)
  if(!pre_done) DMA_K(2,2*SLOTB);
  WAIT_BAR(3);
  qkt(pA0,pA1,Kbase,qr,r32,hi);asm volatile("s_nop 15\n\ts_nop 7":"+v"(pA0),"+v"(pA1));CMASK(pA0,pA1,0);
  START(pA0,pA1);
  _Pragma("unroll") for(int r=0;r<16;++r)pA1[r]=__builtin_amdgcn_exp2f(pA1[r]);
  WAIT_BAR(0);
  DMA_K(3,0);DMA_V(1,SLOTB);
  ROT();
  kload8(kf,kp0+sl_cur);
  WAIT_BAR(2);
  s16x4 vlo[8],vhi[8]; u32x4 pw0,pw1,pw2,pw3;
  #define PKW(P,B) cvtpk_s(P[B],P[B+1])
  #define PAF(k) __builtin_bit_cast(bf16x8,pw##k)
  #define VFR(i) (bf16x8){vlo[i][0],vlo[i][1],vlo[i][2],vlo[i][3],vhi[i][0],vhi[i][1],vhi[i][2],vhi[i][3]}
  #define PIN(x) asm volatile("":"+v"(x))
  #define MX3(a,b,c) __builtin_fmaxf(__builtin_fmaxf((a),(b)),(c))
  #define GAPA(MF,A0,A1,A2,A3,W0,W1,PW) do{ MF; sacc+=A0; sacc+=A1; sacc+=A2; sacc+=A3; PIN(sacc); W0; W1; PIN(PW); SBAR(); }while(0)
  #define EX(v) __builtin_amdgcn_exp2f(v)
  #define GAPB(MF,X,B) do{ MF; X[B]=EX(X[B]); X[B+1]=EX(X[B+1]); X[B+2]=EX(X[B+2]); X[B+3]=EX(X[B+3]); PIN(X); SBAR(); }while(0)
  #define VRD(i) do{ vlo[i]=vtr(vp_+(((i)>>2)*4096+((i)&3)*1024)); vhi[i]=vtr(vp_+(((i)>>2)*4096+((i)&3)*1024+512)); }while(0)
  #define KRD(G,j) do{ if(G){ kload2(kf,kp0+sl_next,j); SBAR(); } }while(0)
  #define STEP(C0,C1,P0,P1,t,GK,GV,GL) do{ SBAR(); \
    const lds_cptr vp_=vp0+sl_prev; \
    VRD(0); SBAR(); float sacc=(P0[0]+P0[1]); \
    GAPA(C0=__builtin_amdgcn_mfma_f32_32x32x16_bf16(kf[0],qr[0],f32x16{},0,0,0), P0[2],P0[3],P0[4],P0[5],     pw0[0]=PKW(P0,0), pw0[1]=PKW(P0,2), pw0); \
    VRD(4); SBAR(); GAPA(C1=__builtin_amdgcn_mfma_f32_32x32x16_bf16(kf[1],qr[0],f32x16{},0,0,0), P0[6],P0[7],P0[8],P0[9],     pw0[2]=PKW(P0,4), pw0[3]=PKW(P0,6), pw0); \
    VRD(1); SBAR(); GAPA(C0=__builtin_amdgcn_mfma_f32_32x32x16_bf16(kf[2],qr[1],C0,0,0,0),   P0[10],P0[11],P0[12],P0[13], pw1[0]=PKW(P0,8), pw1[1]=PKW(P0,10), pw1); \
    VRD(5); SBAR(); GAPA(C1=__builtin_amdgcn_mfma_f32_32x32x16_bf16(kf[3],qr[1],C1,0,0,0),   P0[14],P0[15],P1[0],P1[1],   pw1[2]=PKW(P0,12),pw1[3]=PKW(P0,14), pw1); \
    VRD(2); SBAR(); GAPA(C0=__builtin_amdgcn_mfma_f32_32x32x16_bf16(kf[4],qr[2],C0,0,0,0),   P1[2],P1[3],P1[4],P1[5],     pw2[0]=PKW(P1,0), pw2[1]=PKW(P1,2), pw2); \
    VRD(6); SBAR(); GAPA(C1=__builtin_amdgcn_mfma_f32_32x32x16_bf16(kf[5],qr[2],C1,0,0,0),   P1[6],P1[7],P1[8],P1[9],     pw2[2]=PKW(P1,4), pw2[3]=PKW(P1,6), pw2); \
    VRD(3); SBAR(); GAPA(C0=__builtin_amdgcn_mfma_f32_32x32x16_bf16(kf[6],qr[3],C0,0,0,0),   P1[10],P1[11],P1[12],P1[13], pw3[0]=PKW(P1,8), pw3[1]=PKW(P1,10), pw3); \
    VRD(7); SBAR(); GAPA(C1=__builtin_amdgcn_mfma_f32_32x32x16_bf16(kf[7],qr[3],C1,0,0,0),   P1[14],P1[15],0.f,0.f,       pw3[2]=PKW(P1,12),pw3[3]=PKW(P1,14), pw3); \
    l_reg+=sacc; \
    if(GK){DMA_K((t)+3,sl_cur);} if(GV){DMA_V((t)+1,sl_next);} \
    CMASK(C0,C1,t); \
    { float a=MX3(C0[0],C0[1],C1[0]),b=MX3(C0[2],C0[3],C1[1]); a=MX3(a,C1[2],C1[3]); \
      _Pragma("unroll") for(int r=4;r<16;r+=4){a=MX3(a,C0[r],C0[r+1]);b=MX3(b,C0[r+2],C0[r+3]);a=MX3(a,C1[r],C1[r+1]);b=MX3(b,C1[r+2],C1[r+3]);} \
      float rm=__builtin_fmaxf(a,b); { auto rr=__builtin_amdgcn_permlane32_swap(__float_as_uint(rm),__float_as_uint(rm),false,false); rm=__builtin_fmaxf(__uint_as_float(rr[0]),__uint_as_float(rr[1])); } \
      resc=false; \
      if(__builtin_expect(__any(rm>(float)THRL),0)){ const float dl=__builtin_fmaxf(rm,0.f); mhat+=dl; \
        _Pragma("unroll") for(int r=0;r<16;++r){C0[r]-=dl;C1[r]-=dl;} \
        const float f=__builtin_amdgcn_exp2f(-dl); l_reg*=f; if(hi==0)wsf[r32]=f; resc=true; } } \
    SBAR(); \
    GAPB(o[0]=__builtin_amdgcn_mfma_f32_32x32x16_bf16(PAF(0),VFR(0),o[0],0,0,0), C0,0); \
    GAPB(o[1]=__builtin_amdgcn_mfma_f32_32x32x16_bf16(PAF(0),VFR(4),o[1],0,0,0), C0,4); \
    KRD(GL,0); GAPB(o[0]=__builtin_amdgcn_mfma_f32_32x32x16_bf16(PAF(1),VFR(1),o[0],0,0,0), C0,8); \
    KRD(GL,1); GAPB(o[1]=__builtin_amdgcn_mfma_f32_32x32x16_bf16(PAF(1),VFR(5),o[1],0,0,0), C0,12); \
    KRD(GL,2); GAPB(o[0]=__builtin_amdgcn_mfma_f32_32x32x16_bf16(PAF(2),VFR(2),o[0],0,0,0), C1,0); \
    KRD(GL,3); GAPB(o[1]=__builtin_amdgcn_mfma_f32_32x32x16_bf16(PAF(2),VFR(6),o[1],0,0,0), C1,4); \
    GAPB(o[0]=__builtin_amdgcn_mfma_f32_32x32x16_bf16(PAF(3),VFR(3),o[0],0,0,0), C1,8); \
    GAPB(o[1]=__builtin_amdgcn_mfma_f32_32x32x16_bf16(PAF(3),VFR(7),o[1],0,0,0), C1,12); \
    }while(0)
  int t=1;
  for(;t+5<NT;t+=2){
    STEP(pB0,pB1,pA0,pA1,t,true,true,true);     WAIT_BAR(2); RESC(); ROT();
    STEP(pA0,pA1,pB0,pB1,t+1,true,true,true);   WAIT_BAR(2); RESC(); ROT();
  }
  #define ENDW(tt) do{ if((tt)+3<NT){WAIT_BAR(2);} else if((tt)+2<NT){WAIT_BAR(1);} else {WAIT_BAR(0);} }while(0)
  for(;t+1<NT;t+=2){
    STEP(pB0,pB1,pA0,pA1,t,(t+3<NT),(t+1<NT),(t+1<NT));       ENDW(t);   RESC(); ROT();
    STEP(pA0,pA1,pB0,pB1,t+1,(t+4<NT),(t+2<NT),(t+2<NT));     ENDW(t+1); RESC(); ROT();
  }
  const bool dp_=want_pre&&(NT==12); pre_out=dp_;
  if(dp_){ const long rb2=(long)b2*SEQ; const int q02=qb2*QB, nb2=(4*qb2<8)?4*qb2:8;
    const bf16*ks2=K+rb2*DM+h2*D+(long)lane*DM+wid*8; const bf16*vs2=V+rb2*DM+h2*D+(long)(16*(wid&3)+(lane>>2))*DM+(wid>>2)*32+(lane&3)*8;
    #define TOFF2(t) ((t)==0?0:((t)<=nb2?-(t):(t)-nb2))
    glds16(ks2+(long)(q02+KVBLK*TOFF2(0))*DM,(unsigned)__builtin_amdgcn_readfirstlane(kdst+0));
    glds16(vs2+(long)(q02+KVBLK*TOFF2(0))*DM,(unsigned)__builtin_amdgcn_readfirstlane(vdst+0));
    glds16(ks2+(long)(q02+KVBLK*TOFF2(1))*DM,(unsigned)__builtin_amdgcn_readfirstlane(kdst+SLOTB));
    glds16(ks2+(long)(q02+KVBLK*TOFF2(2))*DM,(unsigned)__builtin_amdgcn_readfirstlane(kdst+2*SLOTB));
    #undef TOFF2
  }
  STEP(pB0,pB1,pA0,pA1,NT-1,false,false,false); RESC();
  if(dp_){ const bf16*Qw2=Q+((long)b2*SEQ+qb2*QB+wid*QBLK)*DM+h2*D;
    _Pragma("unroll") for(int d0=0;d0<4;++d0)qr[d0]=*reinterpret_cast<const bf16x8*>(&Qw2[(long)r32*DM+d0*16+hi*8]); }
  { float sacc=pB0[0]+pB0[1]; _Pragma("unroll") for(int r=2;r<16;++r)sacc+=pB0[r]; _Pragma("unroll") for(int r=0;r<16;++r)sacc+=pB1[r]; l_reg+=sacc;
    pw0=(u32x4){PKW(pB0,0),PKW(pB0,2),PKW(pB0,4),PKW(pB0,6)};pw1=(u32x4){PKW(pB0,8),PKW(pB0,10),PKW(pB0,12),PKW(pB0,14)};pw2=(u32x4){PKW(pB1,0),PKW(pB1,2),PKW(pB1,4),PKW(pB1,6)};pw3=(u32x4){PKW(pB1,8),PKW(pB1,10),PKW(pB1,12),PKW(pB1,14)};
    SBAR(); pv(o,vb0+sl_cur,PAF(0),PAF(1),PAF(2),PAF(3)); }
  #undef PKW
  #undef PAF
  #undef VFR
  #undef PIN
  #undef MX3
  #undef GAPA
  #undef GAPB
  #undef EX
  #undef VRD
  #undef KRD
  #undef STEP
  #undef ENDW
  {auto rr=__builtin_amdgcn_permlane32_swap(__float_as_uint(l_reg),__float_as_uint(l_reg),false,false);l_reg=__uint_as_float(rr[0])+__uint_as_float(rr[1]);}
  if(hi==0)wsf[32+r32]=l_reg;asm volatile("s_waitcnt lgkmcnt(0)":::"memory");
  float rli[16];
  #pragma unroll
  for(int r=0;r<16;++r)rli[r]=__builtin_amdgcn_rcpf(wsf[32+crow(r,hi)]);
  unsigned char*Ow=(unsigned char*)O+(rowbase+q0+wid*QBLK)*OP+h*D;
  { unsigned char*stg=(unsigned char*)(shm+LDS_OST)+wid*2048;
    #pragma unroll
    for(int r=0;r<16;++r){const int orow=crow(r,hi); const float s_=rli[r]*16.f;
      const unsigned w_=(unsigned)__builtin_amdgcn_cvt_pk_fp8_f32(__builtin_amdgcn_fmed3f(o[0][r]*s_,-448.f,448.f),__builtin_amdgcn_fmed3f(o[1][r]*s_,-448.f,448.f),0,false);
      stg[orow*64+r32]=(unsigned char)w_; stg[orow*64+32+r32]=(unsigned char)(w_>>8);}
    asm volatile("s_waitcnt lgkmcnt(0)":::"memory");
    typedef unsigned u32x2_ __attribute__((ext_vector_type(2)));
    #pragma unroll
    for(int i=0;i<4;++i){const int row=i*8+(lane>>3),ch=lane&7; const u32x2_ v=*(const u32x2_*)(stg+row*64+ch*8); *(u32x2_*)(Ow+(long)row*OP+ch*8)=v;} }
  asm volatile("s_waitcnt lgkmcnt(0)\n\ts_barrier":::"memory");
  #undef DMA_K
  #undef TOFF
  #undef DMA_V
  #undef CMASK
  #undef START
  #undef RESC
  #undef ROT
}
constexpr int ATTN_LDS_BYTES=LDS_BYTES;
struct AttnTensors { const bf16* Q; const bf16* K; const bf16* V; bf16* O; const float* relb; };
struct AttnUnit { int bh; int qb; };
struct StaticOrder {
  int vcu,upb;
  __device__ __forceinline__ explicit StaticOrder(int grid,int block):vcu((grid%8==0)?(block%8)*(grid/8)+block/8:block),upb((BATCH*NHEAD*NQB+grid-1)/grid){}
  __device__ __forceinline__ bool next(int i,AttnUnit&u)const{ const int un=vcu*upb+i; if(i>=upb||un>=BATCH*NHEAD*NQB)return false; u.bh=un/NQB; u.qb=un%NQB; return true; }
  __device__ __forceinline__ void a_ready(const AttnUnit&)const{}
  __device__ __forceinline__ void done(const AttnUnit&)const{}
};
template<class Sched,int THRL=8> __device__ __forceinline__ void attn_phase(char*lds,const AttnTensors&T,const Sched&S,int i0,int i1){
  AttnUnit u,un; bf16x8 qr[4]; bool pre=false;
  int ph=-1;
  bool has=(i0<i1)&&S.next(i0,u);
  for(int i=i0;has;++i){ const bool hn=(i+1<i1)&&S.next(i+1,un); const int h=u.bh%NHEAD; bool pre_out=false;
    attn_unit<THRL>(u.bh/NHEAD,h,u.qb,T.Q,T.K,T.V,T.O,T.relb+h*513,lds,h!=ph,qr,pre,hn,un.bh/NHEAD,un.bh%NHEAD,un.qb,pre_out); ph=h; pre=pre_out; u=un; has=hn; }
}
#undef SBAR
#undef WAIT_BAR
}
constexpr int NWAVES = 8, NTHR = 512;
constexpr int NTOK = 32768, DM = 1024, SEQ = 16384, CH = 64, NCH = SEQ / CH, NCHT = 2 * NCH;
constexpr int PW = 3072;
constexpr int C_GQ = 0, C_GK = 256, C_GV = 512, C_OG = 1024, C_AQ = 1536, C_AK = 2048, C_AV = 2560;
constexpr int NIN = 3072;
constexpr int W_IN_COLS = 3088;
constexpr int NEXP = 32, TOPK = 4, DFF = 1024;
constexpr int PSLOTS = 139264;
constexpr float EPS = 1e-6f;
constexpr float LOG2E = 1.4426950408889634f;
constexpr float C2 = 0.125f * LOG2E;

constexpr size_t MiB = 1u << 20;
constexpr size_t WS_CTL = 0, CTL_ZERO_OFF = 16384, CTL_ZERO_BYTES = 16384;
constexpr size_t WS_RWP = 1 * MiB;
constexpr size_t WS_WLR = 1 * MiB + 262144;
constexpr size_t WS_TOPE = 2 * MiB, WS_TOPG = 3 * MiB, WS_RANK = 4 * MiB, WS_SLOTOF = 5 * MiB;
constexpr size_t WS_HIST = 6 * MiB;
constexpr size_t WS_TILEE = 6 * MiB + 65536;
constexpr size_t WS_RSLOT = 6 * MiB + 131072;
constexpr size_t WS_RSTD = 9 * MiB + 524288;
constexpr size_t WS_BUFTOK = 7 * MiB, WS_GATESLOT = 8 * MiB;
constexpr size_t WS_DEC = 9 * MiB;
constexpr size_t WS_WIN = 10 * MiB;
constexpr size_t WS_WOUT = 17 * MiB;
constexpr size_t WS_WMIN = 20 * MiB;
constexpr size_t WS_WMOUT = 148 * MiB;
constexpr size_t WS_H2 = 212 * MiB;
constexpr size_t WS_Y = 276 * MiB;
constexpr size_t WS_H1 = 548 * MiB;
constexpr size_t WS_ST16 = WS_H1;
constexpr size_t WS_PROJ = 612 * MiB;
constexpr size_t WS_GATE = 804 * MiB;
constexpr size_t WS_US = 836 * MiB;
constexpr size_t WS_MIX = 900 * MiB;
constexpr size_t WS_M16 = WS_US;
constexpr size_t WS_ACT = 548 * MiB;
constexpr size_t WS_END = 964 * MiB;
static_assert(WS_Y + (size_t)PSLOTS * 1024 * 2 <= WS_H1 && WS_ACT + (size_t)PSLOTS * 1024 * 2 <= WS_US && WS_MIX + (size_t)NTOK * 1024 * 2 <= WS_END, "ws map");
static_assert(WS_WIN + (size_t)NIN * 1024 * 2 <= WS_WOUT && WS_WMIN + (size_t)32 * 2048 * 1024 * 2 <= WS_WMOUT && WS_WMOUT + (size_t)32 * 1024 * 1024 * 2 <= WS_H2, "ws map 2");

constexpr int CW_BAR = 4096;
constexpr int RING_BYTES = 131072, LDSCTL_OFF = RING_BYTES, MISC_OFF = LDSCTL_OFF + 320, LDS_BYTES = 147456;

#define GAS __attribute__((address_space(1)))
#define LAS __attribute__((address_space(3)))
typedef unsigned short bf16;
typedef unsigned v4u __attribute__((ext_vector_type(4)));
typedef unsigned v2u __attribute__((ext_vector_type(2)));
typedef float f32x4 __attribute__((ext_vector_type(4)));
typedef float f32x16 __attribute__((ext_vector_type(16)));
#define LDS_WAIT() asm volatile("s_waitcnt lgkmcnt(0)" ::: "memory")
typedef short s16x4 __attribute__((ext_vector_type(4)));
typedef short s16x8 __attribute__((ext_vector_type(8)));
__device__ __forceinline__ s16x4 tr16(const LAS unsigned char* p) { return __builtin_bit_cast(s16x4, __builtin_amdgcn_ds_read_tr16_b64_v4i16((LAS s16x4*)p)); }
__device__ __forceinline__ unsigned f2bf(float f) { unsigned u = __builtin_bit_cast(unsigned, f); return (u + 0x7fffu + ((u >> 16) & 1u)) >> 16; }
__device__ __forceinline__ unsigned pk2(float lo, float hi) { return f2bf(lo) | (f2bf(hi) << 16); }
constexpr float ACT8S = 4.f, Y8S = 16.f, MIX8S = 16.f;
constexpr float SWC = 1.702f * 1.4426950408889634f, SWK = -ACT8S / SWC;
constexpr float W8S = 32.f, W8I = 1.f / 32.f;
__device__ __forceinline__ unsigned pk4_fp8(float a, float b, float c, float d) { int w = __builtin_amdgcn_cvt_pk_fp8_f32(a, b, 0, false); w = __builtin_amdgcn_cvt_pk_fp8_f32(c, d, w, true); return (unsigned)w; }
template <int B> __device__ __forceinline__ float fp8f(unsigned w) { return __builtin_amdgcn_cvt_f32_fp8((int)w, B); }
__device__ __forceinline__ float bflo(unsigned w) { return __builtin_bit_cast(float, w << 16); }
__device__ __forceinline__ float bfhi(unsigned w) { return __builtin_bit_cast(float, w & 0xffff0000u); }

#define XB_TMO      128
#define XB_XCNT(j)  (256  + 64 * (j))
#define XB_XSUB(j)  (1280 + 64 * (j))
#define XB_XGEN(j)  (2304 + 64 * (j))
#define XB_TOP      3328
#define XB_TOPGEN   3392
#define XCD_BAR_WORDS 3456
#define XB_SPIN_CAP (1u << 18)
__device__ __forceinline__ unsigned xb_ld(unsigned* p)              { return __hip_atomic_load(p, __ATOMIC_RELAXED, __HIP_MEMORY_SCOPE_AGENT); }
__device__ __forceinline__ unsigned xb_add(unsigned* p, unsigned v) { return __hip_atomic_fetch_add(p, v, __ATOMIC_RELAXED, __HIP_MEMORY_SCOPE_AGENT); }
__device__ __forceinline__ unsigned xb_xcc_id() { return (unsigned)__builtin_amdgcn_s_getreg((3 << 11) | 20) & 0xFu; }
#define XB_SPIN(cond, bar) do { unsigned _sp = 0; while (cond) { __builtin_amdgcn_s_sleep(1); \
    if ((++_sp & 255u) == 0u) { if (xb_ld(&(bar)[XB_TMO])) break; if (_sp > XB_SPIN_CAP) { atomicAdd(&(bar)[XB_TMO], 1u); break; } } } } while (0)
struct XcdBarrier { unsigned* bar; unsigned x; volatile LAS unsigned* st; };
__device__ __forceinline__ XcdBarrier xcd_barrier_post(unsigned* bar, volatile LAS unsigned* st) {
    XcdBarrier b; b.bar = bar; b.x = xb_xcc_id(); b.st = st;
    if (threadIdx.x == 0) (void)xb_add(&bar[XB_XCNT(b.x)], 1u);
    return b;
}
__device__ __forceinline__ void xcd_barrier_complete(unsigned* bar, unsigned x, unsigned& nloc, unsigned& nx) {
    const unsigned G = gridDim.x * gridDim.y * gridDim.z;
    unsigned sum, cnt, mine, sp = 0u;
    for (;;) {
        sum = 0u; cnt = 0u; mine = 0u;
#pragma unroll
        for (unsigned j = 0; j < 16; ++j) { const unsigned c = xb_ld(&bar[XB_XCNT(j)]); sum += c; cnt += (c > 0u) ? 1u : 0u; mine = (j == x) ? c : mine; }
        if (sum == G) break;
        __builtin_amdgcn_s_sleep(1);
        if ((++sp & 255u) == 0u) { if (xb_ld(&bar[XB_TMO])) break; if (sp > XB_SPIN_CAP) { atomicAdd(&bar[XB_TMO], 1u); break; } }
    }
    nloc = mine > 0u ? mine : 1u; nx = cnt > 0u ? cnt : 1u;
}
__device__ __forceinline__ void xcd_barrier(const XcdBarrier& b) {
    asm volatile("s_waitcnt vmcnt(0)" ::: "memory");
    __syncthreads();
    if (threadIdx.x == 0) {
        unsigned* bar = b.bar;
        __builtin_amdgcn_s_waitcnt(0);
        unsigned nloc = b.st[0], nx = b.st[1];
        if (nloc == 0u) { xcd_barrier_complete(bar, b.x, nloc, nx); b.st[0] = nloc; b.st[1] = nx; }
        const unsigned old = xb_add(&bar[XB_XSUB(b.x)], 1u);
        const unsigned gen = old / nloc;
        if (old + 1u == (gen + 1u) * nloc) {
            __builtin_amdgcn_fence(__ATOMIC_RELEASE, "agent");
            asm volatile("s_waitcnt vmcnt(0)" ::: "memory");
            const unsigned og = xb_add(&bar[XB_TOP], 1u);
            const unsigned tg = og / nx;
            if (og + 1u == (tg + 1u) * nx) xb_add(&bar[XB_TOPGEN], 1u);
            else XB_SPIN(xb_ld(&bar[XB_TOPGEN]) <= tg, bar);
            __builtin_amdgcn_fence(__ATOMIC_ACQUIRE, "agent");
            xb_add(&bar[XB_XGEN(b.x)], 1u);
            asm volatile("s_waitcnt vmcnt(0)" ::: "memory");
        } else {
            XB_SPIN(xb_ld(&bar[XB_XGEN(b.x)]) <= gen, bar);
            __builtin_amdgcn_fence(__ATOMIC_ACQUIRE, "agent");
            asm volatile("s_waitcnt vmcnt(0)" ::: "memory");
        }
    }
    __syncthreads();
}

__device__ __forceinline__ void xcd_arrive(const XcdBarrier& b) {
    asm volatile("s_waitcnt vmcnt(0)" ::: "memory");
    __syncthreads();
    if (threadIdx.x == 0) {
        unsigned* bar = b.bar;
        __builtin_amdgcn_s_waitcnt(0);
        unsigned nloc = b.st[0], nx = b.st[1];
        if (nloc == 0u) { xcd_barrier_complete(bar, b.x, nloc, nx); b.st[0] = nloc; b.st[1] = nx; }
        const unsigned old = xb_add(&bar[XB_XSUB(b.x)], 1u);
        const unsigned gen = old / nloc;
        unsigned role = 0u, tg = 0u;
        if (old + 1u == (gen + 1u) * nloc) {
            __builtin_amdgcn_fence(__ATOMIC_RELEASE, "agent");
            asm volatile("s_waitcnt vmcnt(0)" ::: "memory");
            const unsigned og = xb_add(&bar[XB_TOP], 1u);
            tg = og / nx; role = 1u;
            if (og + 1u == (tg + 1u) * nx) { xb_add(&bar[XB_TOPGEN], 1u); role = 2u; }
        }
        b.st[2] = gen; b.st[3] = tg; b.st[4] = role;
    }
}
__device__ __forceinline__ void xcd_wait(const XcdBarrier& b) {
    if (threadIdx.x == 0) {
        unsigned* bar = b.bar;
        const unsigned gen = b.st[2], tg = b.st[3], role = b.st[4];
        if (role) {
            if (role == 1u) XB_SPIN(xb_ld(&bar[XB_TOPGEN]) <= tg, bar);
            __builtin_amdgcn_fence(__ATOMIC_ACQUIRE, "agent");
            xb_add(&bar[XB_XGEN(b.x)], 1u);
            asm volatile("s_waitcnt vmcnt(0)" ::: "memory");
        } else {
            XB_SPIN(xb_ld(&bar[XB_TOPGEN]) <= gen, bar);
            __builtin_amdgcn_fence(__ATOMIC_ACQUIRE, "agent");
            asm volatile("s_waitcnt vmcnt(0)" ::: "memory");
        }
    }
    __syncthreads();
}

using pg8::Unit; using pg8::cvt_pk_bf16;
typedef float f32x2 __attribute__((ext_vector_type(2)));
__device__ __forceinline__ f32x2 h2(const f32x4 v, int hf) { return hf ? (f32x2){v[2], v[3]} : (f32x2){v[0], v[1]}; }
__device__ __forceinline__ f32x2 fma2(f32x2 a, f32x2 b, f32x2 c) { return __builtin_elementwise_fma(a, b, c); }
__device__ __forceinline__ f32x2 bc2(float s) { return (f32x2){s, s}; }
struct EpiProj {
    static constexpr bool PERM = true, HEADPERM = true, LINE16 = false;
    bf16* P; float* G; const float* gbias; const float* qg; const float* kg; int pf;
    static constexpr bool SIDE = false; __device__ __forceinline__ const void* side_src(const Unit&, const Unit&, bool, int, int) const { return nullptr; }
    __device__ __forceinline__ void operator()(const f32x4 (&acc)[2][2][4][2], const Unit& u, int wr, int wc, int fr, int fq, LAS unsigned char* side) const {
        if (pf & 16) return;
        const int row0 = u.pm * 256 + wr * 64 + fr;
        if (u.pn < 12) {
            const int col0 = u.pn * 256 + wc * 64 + 8 * fq;
            const bool isq = (u.pn == 6 || u.pn == 7), isk = (u.pn == 8 || u.pn == 9);
            f32x4 sq[2][2];
#pragma unroll
            for (int bj = 0; bj < 2; ++bj)
#pragma unroll
                for (int n = 0; n < 2; ++n) { const int d = 32 * bj + 8 * fq + 4 * n; sq[bj][n] = isq ? *(const LAS f32x4*)(side + d * 4) : (f32x4){1.f, 1.f, 1.f, 1.f}; }
#pragma unroll
            for (int ai = 0; ai < 2; ++ai)
#pragma unroll
                for (int m = 0; m < 4; ++m) { bf16* rowp = P + (size_t)(row0 + ai * 128 + m * 16) * PW + col0;
                    float r = 1.f;
                    if (isq || isk) { float ss = 0.f;
#pragma unroll
                        for (int bj = 0; bj < 2; ++bj)
#pragma unroll
                            for (int n = 0; n < 2; ++n) { const f32x4 v = acc[ai][bj][m][n]; ss += (v[0] * v[0] + v[1] * v[1]) + (v[2] * v[2] + v[3] * v[3]); }
                        ss += __shfl_xor(ss, 16); ss += __shfl_xor(ss, 32);
                        r = 1.f / sqrtf(ss * (1.f / 64.f) + EPS); }
#pragma unroll
                    for (int bj = 0; bj < 2; ++bj) { f32x4 v0 = acc[ai][bj][m][0], v1 = acc[ai][bj][m][1];
                        if (isq || isk) { v0 = v0 * (sq[bj][0] * r); v1 = v1 * (sq[bj][1] * r); }
                        v4u w; w.x = cvt_pk_bf16(v0[0], v0[1]); w.y = cvt_pk_bf16(v0[2], v0[3]); w.z = cvt_pk_bf16(v1[0], v1[1]); w.w = cvt_pk_bf16(v1[2], v1[3]);
                        *(v4u*)(rowp + bj * 32) = w; } }
        } else {
            const int col0 = wc * 64 + 8 * fq;
            f32x4 bv[2][2];
#pragma unroll
            for (int bj = 0; bj < 2; ++bj)
#pragma unroll
                for (int n = 0; n < 2; ++n) bv[bj][n] = *(const f32x4*)(gbias + col0 + bj * 32 + 4 * n);
#pragma unroll
            for (int ai = 0; ai < 2; ++ai)
#pragma unroll
                for (int m = 0; m < 4; ++m) { float* rowp = G + (size_t)(row0 + ai * 128 + m * 16) * 256 + col0;
#pragma unroll
                    for (int bj = 0; bj < 2; ++bj)
#pragma unroll
                        for (int n = 0; n < 2; ++n) { const f32x4 z = acc[ai][bj][m][n] + bv[bj][n]; f32x4 o;
#pragma unroll
                            for (int i = 0; i < 4; ++i) { const float zz = z[i]; const float t = __logf(1.f + __expf(-fabsf(zz))); o[i] = (fminf(zz, 0.f) - t) * (1.f / 16.f); }
                            *(f32x4*)(rowp + bj * 32 + 4 * n) = o; } }
        }
    }
};
struct EpiMix16 {
    static constexpr bool PERM = true, HEADPERM = false, LINE16 = false;
    bf16* O; float sc;
    static constexpr bool SIDE = false; __device__ __forceinline__ const void* side_src(const Unit&, const Unit&, bool, int, int) const { return nullptr; }
    __device__ __forceinline__ void operator()(const f32x4 (&acc)[2][2][4][2], const Unit& u, int wr, int wc, int fr, int fq, LAS unsigned char*) const {
        const int row0 = u.pm * 256 + wr * 64 + fr, col0 = u.pn * 256 + wc * 32 + 8 * fq;
#pragma unroll
        for (int ai = 0; ai < 2; ++ai)
#pragma unroll
            for (int m = 0; m < 4; ++m) { bf16* rowp = O + (size_t)(row0 + ai * 128 + m * 16) * DM + col0;
#pragma unroll
                for (int bj = 0; bj < 2; ++bj) { const f32x2 a0 = h2(acc[ai][bj][m][0], 0) * bc2(sc), a1 = h2(acc[ai][bj][m][0], 1) * bc2(sc), a2 = h2(acc[ai][bj][m][1], 0) * bc2(sc), a3 = h2(acc[ai][bj][m][1], 1) * bc2(sc);
                    v4u w; w.x = cvt_pk_bf16(a0[0], a0[1]); w.y = cvt_pk_bf16(a1[0], a1[1]); w.z = cvt_pk_bf16(a2[0], a2[1]); w.w = cvt_pk_bf16(a3[0], a3[1]);
                    *(v4u*)(rowp + bj * 128) = w; } }
    }
};
struct EpiSwiglu {
    static constexpr bool PERM = true, HEADPERM = false, LINE16 = false;
    unsigned char* ACT; const float* bin; const float* rslot; const int* rowtok;
    static constexpr bool SIDE = true;
    __device__ __forceinline__ const void* side_src(const Unit& u, const Unit& nx, bool has_next, int piece, int lane) const {
        const float* b0 = bin + (size_t)u.e * 2048 + u.pn * 128 + ((lane < 32) ? 4 * lane : 1024 + 4 * (lane - 32));
        if (piece == 1) return rslot + u.pm * 256 + 4 * lane;
        if (piece == 2 && has_next) return rowtok + nx.pm * 256 + 4 * lane;
        return b0;
    }
    __device__ __forceinline__ void operator()(const f32x4 (&acc)[2][2][4][2], const Unit& u, int wr, int wc, int fr, int fq, LAS unsigned char* side) const {
        const int row0 = u.pm * 256 + wr * 64 + fr, f0 = u.pn * 128 + wc * 32 + 8 * fq;
        f32x4 bgv[2], blv[2];
#pragma unroll
        for (int n = 0; n < 2; ++n) { bgv[n] = *(const LAS f32x4*)(side + (wc * 32 + 8 * fq + 4 * n) * 4) * (-SWC); blv[n] = *(const LAS f32x4*)(side + 512 + (wc * 32 + 8 * fq + 4 * n) * 4) * SWK + SWK; }
        const LAS float* rsp = (const LAS float*)(side + 1024) + wr * 64 + fr;
#pragma unroll
        for (int ai = 0; ai < 2; ++ai)
#pragma unroll
            for (int m = 0; m < 4; ++m) { float a[8]; const float rs = rsp[ai * 128 + m * 16] * W8I, rsc = rs * (-SWC), rsk = rs * SWK;
#pragma unroll
                for (int n = 0; n < 2; ++n)
#pragma unroll
                    for (int hf = 0; hf < 2; ++hf) { const f32x2 tg = fma2(h2(acc[ai][0][m][n], hf), bc2(rsc), h2(bgv[n], hf)), tl = fma2(h2(acc[ai][1][m][n], hf), bc2(rsk), h2(blv[n], hf));
                        const f32x2 t = {fmaxf(tg[0], -7.f * SWC), fmaxf(tg[1], -7.f * SWC)}, L = {__builtin_amdgcn_fmed3f(tl[0], 8.f * SWK, -6.f * SWK), __builtin_amdgcn_fmed3f(tl[1], 8.f * SWK, -6.f * SWK)};
                        const f32x2 d = (f32x2){__builtin_amdgcn_exp2f(t[0]), __builtin_amdgcn_exp2f(t[1])} + bc2(1.f);
                        const f32x2 sg = {__builtin_amdgcn_rcpf(d[0]), __builtin_amdgcn_rcpf(d[1])}; const f32x2 r = (t * sg) * L; a[4 * n + 2 * hf] = r[0]; a[4 * n + 2 * hf + 1] = r[1]; }
                v2u w; w.x = pk4_fp8(a[0], a[1], a[2], a[3]); w.y = pk4_fp8(a[4], a[5], a[6], a[7]);
                *(v2u*)(ACT + (size_t)(row0 + ai * 128 + m * 16) * 1024 + f0) = w; }
    }
};
struct EpiY {
    static constexpr bool PERM = true, HEADPERM = false, LINE16 = true;
    unsigned char* Y; const float* bout; const float* gslot; const int* dstrow;
    static constexpr bool SIDE = true;
    __device__ __forceinline__ const void* side_src(const Unit& u, const Unit&, bool, int piece, int lane) const {
        if (piece == 1) return gslot + u.pm * 256 + 4 * lane;
        if (piece == 2) return dstrow + u.pm * 256 + 4 * lane;
        return bout + (size_t)u.e * 1024 + u.pn * 256 + 4 * lane;
    }
    __device__ __forceinline__ void operator()(const f32x4 (&acc)[2][2][4][2], const Unit& u, int wr, int wc, int fr, int fq, LAS unsigned char* side) const {
        const int col0 = u.pn * 256 + wc * 64 + 16 * fq;
        f32x4 bv[2][2];
#pragma unroll
        for (int bj = 0; bj < 2; ++bj)
#pragma unroll
            for (int n = 0; n < 2; ++n) bv[bj][n] = *(const LAS f32x4*)(side + (wc * 64 + 16 * fq + 8 * bj + 4 * n) * 4);
        const LAS float* gtp = (const LAS float*)(side + 1024) + wr * 64 + fr; const LAS int* drp = (const LAS int*)(side + 2048) + wr * 64 + fr;
#pragma unroll
        for (int ai = 0; ai < 2; ++ai)
#pragma unroll
            for (int m = 0; m < 4; ++m) { const float gt = gtp[ai * 128 + m * 16]; unsigned char* rowp = Y + (size_t)drp[ai * 128 + m * 16] * 1024 + col0; v4u w4;
#pragma unroll
                for (int bj = 0; bj < 2; ++bj) { const float g_ = gt * Y8S, cg_ = g_ * (W8I / ACT8S);
                    const f32x2 a0 = fma2(h2(acc[ai][bj][m][0], 0), bc2(cg_), h2(bv[bj][0], 0) * bc2(g_)), a1 = fma2(h2(acc[ai][bj][m][0], 1), bc2(cg_), h2(bv[bj][0], 1) * bc2(g_));
                    const f32x2 a2 = fma2(h2(acc[ai][bj][m][1], 0), bc2(cg_), h2(bv[bj][1], 0) * bc2(g_)), a3 = fma2(h2(acc[ai][bj][m][1], 1), bc2(cg_), h2(bv[bj][1], 1) * bc2(g_));
                    if (bj == 0) { w4.x = pk4_fp8(a0[0], a0[1], a1[0], a1[1]); w4.y = pk4_fp8(a2[0], a2[1], a3[0], a3[1]); } else { w4.z = pk4_fp8(a0[0], a0[1], a1[0], a1[1]); w4.w = pk4_fp8(a2[0], a2[1], a3[0], a3[1]); } }
                *(v4u*)rowp = w4; }
    }
};

__device__ __forceinline__ void p0_transpose_item_fp8(const float* W, int Nsrc, unsigned char* WT, int Kp, int k0, int ns0, int nd0, LAS float* scr, int lane, float scale, const float* kscale) {
#pragma unroll 8
    for (int i = 0; i < 32; ++i) { const int kk = 2 * i + (lane >> 5); scr[kk * 33 + (lane & 31)] = W[(size_t)(k0 + kk) * Nsrc + ns0 + (lane & 31)]; }
    LDS_WAIT(); asm volatile("" ::: "memory");
    const int c = lane & 3;
    float ks[16];
#pragma unroll
    for (int q = 0; q < 16; ++q) ks[q] = scale;
    if (kscale) {
#pragma unroll
        for (int q = 0; q < 4; ++q) { const f32x4 g = *(const f32x4*)(kscale + k0 + 16 * c + 4 * q); ks[4 * q] *= g.x; ks[4 * q + 1] *= g.y; ks[4 * q + 2] *= g.z; ks[4 * q + 3] *= g.w; } }
#pragma unroll
    for (int j = 0; j < 2; ++j) { const int n = (lane >> 2) + 16 * j; const LAS float* s = scr + (16 * c) * 33 + n;
        v4u o; o.x = pk4_fp8(s[0 * 33] * ks[0], s[1 * 33] * ks[1], s[2 * 33] * ks[2], s[3 * 33] * ks[3]); o.y = pk4_fp8(s[4 * 33] * ks[4], s[5 * 33] * ks[5], s[6 * 33] * ks[6], s[7 * 33] * ks[7]); o.z = pk4_fp8(s[8 * 33] * ks[8], s[9 * 33] * ks[9], s[10 * 33] * ks[10], s[11 * 33] * ks[11]); o.w = pk4_fp8(s[12 * 33] * ks[12], s[13 * 33] * ks[13], s[14 * 33] * ks[14], s[15 * 33] * ks[15]);
        *(v4u*)(WT + (size_t)(nd0 + n) * Kp + k0 + 16 * c) = o; }
    LDS_WAIT(); asm volatile("" ::: "memory");
}
__device__ __forceinline__ float wave_sum(float v) {
#pragma unroll
    for (int o = 1; o < 64; o <<= 1) v += __shfl_xor(v, o);
    return v;
}
__device__ __forceinline__ void p0_transpose_item(const float* W, int Nsrc, bf16* WT, int Kp, int k0, int ns0, int nd0, LAS float* scr, int lane) {
#pragma unroll 8
    for (int i = 0; i < 32; ++i) { const int kk = 2 * i + (lane >> 5); scr[kk * 33 + (lane & 31)] = W[(size_t)(k0 + kk) * Nsrc + ns0 + (lane & 31)]; }
    LDS_WAIT(); asm volatile("" ::: "memory");
    const int c = lane & 7;
#pragma unroll
    for (int j = 0; j < 4; ++j) { const int n = (lane >> 3) + 8 * j; const LAS float* s = scr + (8 * c) * 33 + n;
        v4u o; o.x = pk2(s[0 * 33], s[1 * 33]); o.y = pk2(s[2 * 33], s[3 * 33]); o.z = pk2(s[4 * 33], s[5 * 33]); o.w = pk2(s[6 * 33], s[7 * 33]);
        *(v4u*)(WT + (size_t)(nd0 + n) * Kp + k0 + 8 * c) = o; }
    LDS_WAIT(); asm volatile("" ::: "memory");
}

struct Args { const float* in[17]; float* out; unsigned char* ws; int ph_lo, ph_hi, li, flags; };
constexpr int NPHASE = 11;
#ifndef STAG_P1
#define STAG_P1 0
#define STAG_P8 0
#define STAG_P9 0
#endif

__global__ void __launch_bounds__(NTHR, 2) fwd(Args args) {
    extern __shared__ __attribute__((aligned(16))) unsigned char lds_raw[];
    LAS unsigned char* lds = (LAS unsigned char*)lds_raw;
    LAS float* ldsf = (LAS float*)lds_raw;
    volatile LAS unsigned* MISC = (volatile LAS unsigned*)(lds + MISC_OFF);
    LAS int* UTAB = (LAS int*)(lds + RING_BYTES + 2048);
    const int tid = threadIdx.x, lane = tid & 63, wave = __builtin_amdgcn_readfirstlane(tid >> 6);
    const int G = gridDim.x, bx = blockIdx.x;
    unsigned char* ws = args.ws;
    unsigned* ctl = (unsigned*)(ws + WS_CTL);
    const float* x = args.in[0]; const float* g1 = args.in[1]; const float* w_in = args.in[2]; const float* gate_up = args.in[3]; const float* gate_bias = args.in[4];
    const float* gla_ng = args.in[5]; const float* qng = args.in[6]; const float* kng = args.in[7]; const float* rel_bias = args.in[8]; const float* w_out = args.in[9];
    const float* g2 = args.in[10]; const float* router_w = args.in[11]; const float* router_b = args.in[12]; const float* moe_w_in = args.in[13]; const float* moe_b_in = args.in[14];
    const float* moe_w_out = args.in[15]; const float* moe_b_out = args.in[16];
    float* out = args.out;
    float* RWP = (float*)(ws + WS_RWP); int* TOPE = (int*)(ws + WS_TOPE); float* TOPG = (float*)(ws + WS_TOPG); int* RANK = (int*)(ws + WS_RANK); int* DSTROW = (int*)(ws + WS_SLOTOF);
    int* HIST = (int*)(ws + WS_HIST); int* TILEE = (int*)(ws + WS_TILEE); int* BUFTOK = (int*)(ws + WS_BUFTOK); float* GATESLOT = (float*)(ws + WS_GATESLOT); float* DEC = (float*)(ws + WS_DEC); float* RSLOT = (float*)(ws + WS_RSLOT); float* RSTD = (float*)(ws + WS_RSTD);
    bf16* WLR = (bf16*)(ws + WS_WLR); bf16* WIN = (bf16*)(ws + WS_WIN); unsigned char* WOUT = ws + WS_WOUT;     unsigned char* WMIN = ws + WS_WMIN; unsigned char* WMOUT = ws + WS_WMOUT;
    unsigned char* H2 = ws + WS_H2; unsigned char* YB = ws + WS_Y; bf16* H1 = (bf16*)(ws + WS_H1); bf16* PROJ = (bf16*)(ws + WS_PROJ); float* GATE = (float*)(ws + WS_GATE);
    bf16* US = (bf16*)(ws + WS_US);    bf16* ST16 = (bf16*)(ws + WS_ST16); unsigned char* MIX = ws + WS_MIX;     bf16* M16 = (bf16*)(ws + WS_M16); unsigned char* ACT = ws + WS_ACT;

    for (int u = tid; u < (LDS_BYTES - LDSCTL_OFF) / 4; u += NTHR) ((LAS unsigned*)(lds + LDSCTL_OFF))[u] = 0u;
    __syncthreads();
    XcdBarrier bar; bar.bar = ctl + CW_BAR; bar.x = 0; bar.st = nullptr;
#if MK_ONE_LAUNCH
    bar = xcd_barrier_post(ctl + CW_BAR, MISC + 8);
#define GRID_BAR() xcd_barrier(bar)
#define GRID_ARRIVE() xcd_arrive(bar)
#define GRID_WAIT() xcd_wait(bar)
#else
#define GRID_BAR() do { } while (0)
#define GRID_ARRIVE() do { } while (0)
#define GRID_WAIT() do { } while (0)
#endif
    const int lo = args.ph_lo, hi = args.ph_hi;
#define IN(k) (lo <= (k) && (k) < hi)
#define BOTH(k) (IN(k) && IN((k) + 1))
    const int gw = bx * NWAVES + wave, NGW = G * NWAVES;
    const int gthr = bx * NTHR + tid, NGT = G * NTHR;

    LAS float* scr = (LAS float*)(lds + wave * 16384);
    constexpr int I_IN = 16 * 96, I_OUT = 16 * 32, I_MIN = 32 * 16 * 64, I_MOUT = 32 * 16 * 32, NITEMS = I_IN + I_OUT + I_MIN + I_MOUT, NSLICE = 5, SLICE = (I_MIN + I_MOUT + NSLICE - 1) / NSLICE;
            struct TI { const float* src; int nsrc; unsigned char* dst; int nd0, k0, mode; };
            auto decode = [&](int it, TI& t) {
                int r = it;
                if (r < I_MIN) { const int e = r / 1024, q = r % 1024, kb = q / 64, nb = q % 64, ns0 = 32 * nb, f = ns0 & 1023;
                    t.src = moe_w_in + (size_t)e * 1024 * 2048 + (size_t)(64 * kb) * 2048 + ns0; t.nsrc = 2048; t.dst = WMIN + (size_t)e * 2048 * 1024; t.nd0 = 256 * (f >> 7) + ((ns0 >= 1024) ? 128 : 0) + (f & 127); t.k0 = 64 * kb; t.mode = 2; return; }
                r -= I_MIN;
                if (r < I_MOUT) { const int e = r / 512, q = r % 512, kb = q / 32, nb = q % 32;
                    t.src = moe_w_out + (size_t)e * 1024 * 1024 + (size_t)(64 * kb) * 1024 + 32 * nb; t.nsrc = 1024; t.dst = WMOUT + (size_t)e * 1024 * 1024; t.nd0 = 32 * nb; t.k0 = 64 * kb; t.mode = 1; return; }
                r -= I_MOUT;
                if (r < I_IN) { const int kb = r / 96, nb = r % 96, nd0 = 32 * nb, ns0 = nd0 < 1024 ? nd0 : nd0 + 16;
                    t.src = w_in + (size_t)(64 * kb) * W_IN_COLS + ns0; t.nsrc = W_IN_COLS; t.dst = (unsigned char*)WIN; t.nd0 = nd0; t.k0 = 64 * kb; t.mode = 0; return; }
                r -= I_IN;
                { const int kb = r / 32, nb = r % 32; t.src = w_out + (size_t)(64 * kb) * 1024 + 32 * nb; t.nsrc = 1024; t.dst = WOUT; t.nd0 = 32 * nb; t.k0 = 64 * kb; t.mode = 1; }
            };
            auto run_items = [&](const int first, const int last) {
            TI cur, nxt; float wv[32], wn[32];
            int it = first + gw;
            if (it < last) { decode(it, cur);
#pragma unroll
                for (int i = 0; i < 32; ++i) wv[i] = __builtin_nontemporal_load(cur.src + (size_t)(2 * i + (lane >> 5)) * cur.nsrc + (lane & 31)); }
            for (; it < last; it += NGW) {
                const bool hn = it + NGW < last;
                if (hn) { decode(it + NGW, nxt);
#pragma unroll
                    for (int i = 0; i < 32; ++i) wn[i] = __builtin_nontemporal_load(nxt.src + (size_t)(2 * i + (lane >> 5)) * nxt.nsrc + (lane & 31)); }
#pragma unroll
                for (int i = 0; i < 32; ++i) scr[(2 * i + (lane >> 5)) * 33 + (lane & 31)] = wv[i];
                LDS_WAIT(); asm volatile("" ::: "memory");
                if (cur.mode == 0) { const int c = lane & 7;
#pragma unroll
                    for (int j = 0; j < 4; ++j) { const int n = (lane >> 3) + 8 * j; const LAS float* s = scr + (8 * c) * 33 + n;
                        v4u o; o.x = pk2(s[0 * 33], s[1 * 33]); o.y = pk2(s[2 * 33], s[3 * 33]); o.z = pk2(s[4 * 33], s[5 * 33]); o.w = pk2(s[6 * 33], s[7 * 33]);
                        *(v4u*)(cur.dst + ((size_t)(cur.nd0 + n) * 1024 + cur.k0 + 8 * c) * 2) = o; }
                } else { const int c = lane & 3; float ks[16];
#pragma unroll
                    for (int q = 0; q < 16; ++q) ks[q] = W8S;
                    if (cur.mode == 2) {
#pragma unroll
                        for (int q = 0; q < 4; ++q) { const f32x4 gg = *(const f32x4*)(g2 + cur.k0 + 16 * c + 4 * q); ks[4 * q] *= gg.x; ks[4 * q + 1] *= gg.y; ks[4 * q + 2] *= gg.z; ks[4 * q + 3] *= gg.w; } }
#pragma unroll
                    for (int j = 0; j < 2; ++j) { const int n = (lane >> 2) + 16 * j; const LAS float* s = scr + (16 * c) * 33 + n;
                        v4u o; o.x = pk4_fp8(s[0 * 33] * ks[0], s[1 * 33] * ks[1], s[2 * 33] * ks[2], s[3 * 33] * ks[3]); o.y = pk4_fp8(s[4 * 33] * ks[4], s[5 * 33] * ks[5], s[6 * 33] * ks[6], s[7 * 33] * ks[7]);
                        o.z = pk4_fp8(s[8 * 33] * ks[8], s[9 * 33] * ks[9], s[10 * 33] * ks[10], s[11 * 33] * ks[11]); o.w = pk4_fp8(s[12 * 33] * ks[12], s[13 * 33] * ks[13], s[14 * 33] * ks[14], s[15 * 33] * ks[15]);
                        *(v4u*)(cur.dst + (size_t)(cur.nd0 + n) * 1024 + cur.k0 + 16 * c) = o; } }
                LDS_WAIT(); asm volatile("" ::: "memory");
                if (hn) { cur = nxt;
#pragma unroll
                    for (int i = 0; i < 32; ++i) wv[i] = wn[i]; }
            }
            };
#define FILLER_BARRIER(kph, s) do { if (BOTH(kph)) GRID_ARRIVE(); run_items((s) * SLICE, ((s) + 1) * SLICE < I_MIN + I_MOUT ? ((s) + 1) * SLICE : I_MIN + I_MOUT); if (BOTH(kph)) GRID_WAIT(); } while (0)
    if (IN(0)) {
        {
            run_items(I_MIN + I_MOUT, NITEMS);
        for (int idx = gthr; idx < 16 * 1024; idx += NGT) { const int r = idx >> 10, d = idx & 1023; WLR[idx] = (bf16)f2bf(w_in[(size_t)d * W_IN_COLS + 1024 + r]); }
        for (int idx = gthr; idx < 1024 * 32; idx += NGT) RWP[idx] = router_w[idx] * g2[idx >> 5];
        for (int m0 = gw * 8; m0 < NTOK; m0 += NGW * 8) {
            const f32x4* gr = (const f32x4*)g1 + lane;
            f32x4 v[8][4]; float s[8];
#pragma unroll
            for (int j = 0; j < 8; ++j) { const f32x4* xr = (const f32x4*)(x + (size_t)(m0 + j) * DM) + lane;
#pragma unroll
                for (int jj = 0; jj < 4; ++jj) v[j][jj] = __builtin_nontemporal_load(xr + 64 * jj); }
#pragma unroll
            for (int j = 0; j < 8; ++j) { float a = 0.f;
#pragma unroll
                for (int jj = 0; jj < 4; ++jj) a += (v[j][jj].x * v[j][jj].x + v[j][jj].y * v[j][jj].y) + (v[j][jj].z * v[j][jj].z + v[j][jj].w * v[j][jj].w);
                s[j] = a; }
#pragma unroll
            for (int o = 1; o < 64; o <<= 1) {
#pragma unroll
                for (int j = 0; j < 8; ++j) s[j] += __shfl_xor(s[j], o); }
#pragma unroll
            for (int j = 0; j < 8; ++j) { const float r = 1.f / sqrtf(s[j] * (1.f / DM) + EPS);
                unsigned long long* o8 = (unsigned long long*)(H1 + (size_t)(m0 + j) * DM) + lane;
#pragma unroll
                for (int jj = 0; jj < 4; ++jj) { const f32x4 gg = gr[64 * jj]; o8[64 * jj] = (unsigned long long)pk2(v[j][jj].x * r * gg.x, v[j][jj].y * r * gg.y) | ((unsigned long long)pk2(v[j][jj].z * r * gg.z, v[j][jj].w * r * gg.w) << 32); } }
        }
        }
        FILLER_BARRIER(0, 0);
    }

    if (IN(1)) {
        pg8::Gemm g{H1, WIN, 2048, nullptr}; pg8::StaticOrder S; S.init(NTOK / 256, NIN / 256, G, bx);
        EpiProj E{PROJ, GATE, gate_bias, qng, kng, 0};
        if (tid < 64) ((LAS float*)(lds + RING_BYTES + 4096))[tid] = qng[tid] * kng[tid] * C2;
        pg8::TableOrder<pg8::StaticOrder> T; T.build(&S, UTAB);
        pg8::gemm_phase<EpiProj, pg8::TableOrder<pg8::StaticOrder>, true, false, false>(lds, g, T, E, lds + RING_BYTES + 4096);
        FILLER_BARRIER(1, 1);
    }

    if (IN(2)) {
        LAS float* cumL = ldsf;
        LAS float* lrp = ldsf + 16384;
        LAS float* gup = ldsf + 18432;
        LAS float* gbs = ldsf + 22528;
        LAS float* segs = ldsf + 22784;
        LAS float* totL = ldsf + 24832;
        LAS unsigned char* kdb = lds + 100352;
        LAS unsigned char* vsb = lds + 109568;
        if (bx < NCHT) { for (int i = tid; i < 1024; i += NTHR) ((LAS f32x4*)gup)[i] = ((const f32x4*)gate_up)[i]; if (tid < 64) ((LAS f32x4*)gbs)[tid] = ((const f32x4*)gate_bias)[tid]; }
        for (int chunk = bx; chunk < NCHT; chunk += G) {
            const size_t tok0 = (size_t)chunk * 64;
            v2u kwp[2], vwp[4];
#pragma unroll
            for (int j = 0; j < 2; ++j) { const int idx4 = tid + 512 * j; kwp[j] = *(const v2u*)(PROJ + (tok0 + (idx4 >> 4)) * PW + C_GK + (idx4 & 15) * 4); }
#pragma unroll
            for (int j = 0; j < 4; ++j) { const int idx4 = tid + 512 * j; vwp[j] = *(const v2u*)(PROJ + (tok0 + (idx4 >> 5)) * PW + C_GV + (idx4 & 31) * 4); }
            {
                const int mt = wave & 3, kh = wave >> 2;
                const bf16* ap = H1 + (tok0 + 16 * mt + (lane & 15)) * 1024 + 512 * kh + 8 * (lane >> 4); const bf16* bp = WLR + (size_t)(lane & 15) * 1024 + 512 * kh + 8 * (lane >> 4);
                f32x4 a4 = {0.f, 0.f, 0.f, 0.f};
#pragma unroll
                for (int s = 0; s < 16; ++s) { const s16x8 a = *(const s16x8*)(ap + 32 * s), b = *(const s16x8*)(bp + 32 * s); a4 = __builtin_amdgcn_mfma_f32_16x16x32_bf16(a, b, a4, 0, 0, 0); }
#pragma unroll
                for (int rg = 0; rg < 4; ++rg) lrp[(kh * 64 + 16 * mt + 4 * (lane >> 4) + rg) * 16 + (lane & 15)] = a4[rg];
            }
            __syncthreads();
            {
                const int c = tid >> 3, jg = tid & 7; float lr[16];
#pragma unroll
                for (int q = 0; q < 4; ++q) { const f32x4 p0 = *(const LAS f32x4*)(lrp + c * 16 + 4 * q), p1 = *(const LAS f32x4*)(lrp + 1024 + c * 16 + 4 * q); lr[4 * q] = p0.x + p1.x; lr[4 * q + 1] = p0.y + p1.y; lr[4 * q + 2] = p0.z + p1.z; lr[4 * q + 3] = p0.w + p1.w; }
#pragma unroll
                for (int jj = 0; jj < 32; jj += 4) { const int j = jj * 8 + jg * 4; f32x4 z = *(const LAS f32x4*)(gbs + j);
#pragma unroll
                    for (int r = 0; r < 16; ++r) z += (*(const LAS f32x4*)(gup + r * 256 + j)) * lr[r];
                    f32x4 o;
#pragma unroll
                    for (int i = 0; i < 4; ++i) { const float zz = z[i]; const float t = __logf(1.f + __expf(-fabsf(zz))); o[i] = (fminf(zz, 0.f) - t) * (1.f / 16.f); }
                    *(LAS f32x4*)(cumL + c * 256 + j) = o; }
            }
            __syncthreads();
            {
                const int seg = tid >> 6, c4 = (tid & 63) * 4; f32x4 run = {0.f, 0.f, 0.f, 0.f};
#pragma unroll
                for (int i = 0; i < 8; ++i) { run += *(const LAS f32x4*)(cumL + (seg * 8 + i) * 256 + c4); *(LAS f32x4*)(cumL + (seg * 8 + i) * 256 + c4) = run; }
                *(LAS f32x4*)(segs + seg * 256 + c4) = run; }
            __syncthreads();
            { const int seg = tid >> 6, c4 = (tid & 63) * 4; f32x4 off = {0.f, 0.f, 0.f, 0.f};
              for (int s = 0; s < seg; ++s) off += *(const LAS f32x4*)(segs + s * 256 + c4);
#pragma unroll
              for (int i = 0; i < 8; ++i) { LAS f32x4* p = (LAS f32x4*)(cumL + (seg * 8 + i) * 256 + c4); *p = *p + off; }
              if (seg == 7) *(LAS f32x4*)(totL + c4) = off + *(const LAS f32x4*)(segs + 7 * 256 + c4); }
            __syncthreads();
            for (int h = 0; h < 4; ++h) {
                const int un = chunk * 4 + h;
#pragma unroll
                for (int j = 0; j < 2; ++j) { const int idx4 = tid + 512 * j, c = idx4 >> 4, k4 = (idx4 & 15) * 4;
                    const v2u kw = kwp[j];
                    const float kv[4] = {bflo(kw.x), bfhi(kw.x), bflo(kw.y), bfhi(kw.y)}; float kx[4];
                    const f32x4 tt = *(const LAS f32x4*)(totL + h * 64 + k4), cc = *(const LAS f32x4*)(cumL + c * 256 + h * 64 + k4);
#pragma unroll
                    for (int i = 0; i < 4; ++i) kx[i] = kv[i] * __expf(tt[i] - cc[i]);
                    v2u w; w.x = pk2(kx[0], kx[1]); w.y = pk2(kx[2], kx[3]); *(LAS v2u*)(kdb + c * 144 + k4 * 2) = w; }
#pragma unroll
                for (int j = 0; j < 4; ++j) { const int idx4 = tid + 512 * j, c = idx4 >> 5, v4 = (idx4 & 31) * 4;
                    *(LAS v2u*)(vsb + c * 272 + v4 * 2) = vwp[j]; }
                if (h < 3) {
#pragma unroll
                    for (int j = 0; j < 2; ++j) { const int idx4 = tid + 512 * j; kwp[j] = *(const v2u*)(PROJ + (tok0 + (idx4 >> 4)) * PW + C_GK + (h + 1) * 64 + (idx4 & 15) * 4); }
#pragma unroll
                    for (int j = 0; j < 4; ++j) { const int idx4 = tid + 512 * j; vwp[j] = *(const v2u*)(PROJ + (tok0 + (idx4 >> 5)) * PW + C_GV + (h + 1) * 128 + (idx4 & 31) * 4); } }
                if (tid < 64) DEC[(size_t)chunk * 256 + h * 64 + tid] = __expf(totL[h * 64 + tid]);
                __syncthreads();
                {
                    const int vblk = wave >> 1, kblk = wave & 1, hi = lane >> 5, q_ = (lane & 15) >> 2, p_ = lane & 3, g16 = (lane >> 4) & 1;
                    const LAS unsigned char* va = vsb + (4 * hi + q_) * 272 + (32 * vblk + 16 * g16 + 4 * p_) * 2;
                    const LAS unsigned char* ka = kdb + (4 * hi + q_) * 144 + (32 * kblk + 16 * g16 + 4 * p_) * 2;
                    f32x16 acc;
#pragma unroll
                    for (int i = 0; i < 16; ++i) acc[i] = 0.f;
#pragma unroll
                    for (int s = 0; s < 4; ++s) {
                        const s16x4 a0 = tr16(va + (16 * s) * 272), a1 = tr16(va + (16 * s + 8) * 272), b0 = tr16(ka + (16 * s) * 144), b1 = tr16(ka + (16 * s + 8) * 144);
                        const s16x8 A = {a0[0], a0[1], a0[2], a0[3], a1[0], a1[1], a1[2], a1[3]}, B = {b0[0], b0[1], b0[2], b0[3], b1[0], b1[1], b1[2], b1[3]};
                        acc = __builtin_amdgcn_mfma_f32_32x32x16_bf16(A, B, acc, 0, 0, 0); }
                    bf16* up = US + ((size_t)un * 128 + 32 * vblk + 4 * hi) * 64 + 32 * kblk + (lane & 31);
#pragma unroll
                    for (int r = 0; r < 16; ++r) up[((r & 3) + 8 * (r >> 2)) * 64] = (bf16)f2bf(acc[r]);
                }
                __syncthreads();
            }
        }
        if (BOTH(2)) GRID_ARRIVE();
    }

    if (IN(3)) {
        const attn_body::AttnTensors AT{(const attn_body::bf16*)(PROJ + C_AQ), (const attn_body::bf16*)(PROJ + C_AK), (const attn_body::bf16*)(PROJ + C_AV), (attn_body::bf16*)(MIX + 512), rel_bias};
        const attn_body::StaticOrder AS(G, bx);
        const int ahalf = AS.upb / 2;
        attn_body::attn_phase<attn_body::StaticOrder>((char*)lds_raw, AT, AS, 0, ahalf);
        if (BOTH(2)) GRID_WAIT();
        if (!(args.flags & 4))
        for (int ci = tid; ci < (65536 + G - 1) / G; ci += NTHR) { const int e = (65536 + G - 1) / G * bx + ci; if (e >= 65536) break;
            const int b = e >> 15, idx = e & 32767, hk = ((idx >> 13) << 6) + (idx & 63);
            const bf16* up = US + (size_t)b * 256 * 32768 + idx; const float* dp = DEC + (size_t)b * 256 * 256 + hk; bf16* sp = ST16 + (size_t)b * 256 * 32768 + idx;
            float s = 0.f;
            for (int n = 0; n < 256; n += 32) { float uu[32], dd[32];
#pragma unroll
                for (int i = 0; i < 32; ++i) { uu[i] = bflo((unsigned)up[(size_t)(n + i) * 32768]); dd[i] = dp[(size_t)(n + i) * 256]; }
#pragma unroll
                for (int i = 0; i < 32; ++i) { s = dd[i] * s + uu[i]; sp[(size_t)(n + i) * 32768] = (bf16)f2bf(s); } }
        }
        if (BOTH(3)) GRID_ARRIVE();
        attn_body::attn_phase<attn_body::StaticOrder>((char*)lds_raw, AT, AS, ahalf, AS.upb);
        if (BOTH(3)) GRID_WAIT();
    }

    if (IN(4)) {
        for (int wp_ = gw; wp_ < NCHT * 4; wp_ += NGW) {
            const int chunk = wp_ >> 2, h = wp_ & 3, un = chunk * 4 + h, l31 = lane & 31, hi = lane >> 5;
            s16x8 sfr[4][4];
#pragma unroll
            for (int vb = 0; vb < 4; ++vb)
#pragma unroll
                for (int s = 0; s < 4; ++s) sfr[vb][s] = *(const s16x8*)(ST16 + ((size_t)un * 128 + 32 * vb + l31) * 64 + 16 * s + 8 * hi);
          for (int cb = 0; cb < 2; ++cb) {
            const size_t tokq = (size_t)chunk * 64 + 32 * cb + l31, tok0 = (size_t)chunk * 64 + 32 * cb + 4 * hi;
            s16x8 qf[4];
#pragma unroll
            for (int s = 0; s < 4; ++s) qf[s] = *(const s16x8*)(PROJ + tokq * PW + C_GQ + h * 64 + 16 * s + 8 * hi);
            LAS unsigned char* ogs = lds + wave * 16384; LAS unsigned char* outs = ogs + 32 * 272;
            const size_t row0 = (size_t)chunk * 64 + 32 * cb;
            v4u ogr[8];
#pragma unroll
            for (int i = 0; i < 8; ++i) { const int idx = i * 64 + lane; ogr[i] = *(const v4u*)(PROJ + (row0 + (idx >> 4)) * PW + C_OG + h * 128 + (idx & 15) * 8); }
            f32x16 acc[4];
#pragma unroll
            for (int vb = 0; vb < 4; ++vb) {
#pragma unroll
                for (int i = 0; i < 16; ++i) acc[vb][i] = 0.f;
#pragma unroll
                for (int s = 0; s < 4; ++s) acc[vb] = __builtin_amdgcn_mfma_f32_32x32x16_bf16(qf[s], sfr[vb][s], acc[vb], 0, 0, 0); }
#pragma unroll
            for (int i = 0; i < 8; ++i) { const int idx = i * 64 + lane; *(LAS v4u*)(ogs + (idx >> 4) * 272 + (idx & 15) * 16) = ogr[i]; }
            asm volatile("" ::: "memory");
            float sc[16];
#pragma unroll
            for (int r = 0; r < 16; ++r) { float ssq = (acc[0][r] * acc[0][r] + acc[1][r] * acc[1][r]) + (acc[2][r] * acc[2][r] + acc[3][r] * acc[3][r]);
                ssq += __shfl_xor(ssq, 1); ssq += __shfl_xor(ssq, 2); ssq += __shfl_xor(ssq, 4); ssq += __shfl_xor(ssq, 8); ssq += __shfl_xor(ssq, 16);
                sc[r] = (0.125f * MIX8S) * __builtin_amdgcn_rsqf(ssq * (1.f / (64.f * 128.f)) + EPS); }
#pragma unroll
            for (int vb = 0; vb < 4; ++vb) { const int v = 32 * vb + l31; const float gn = gla_ng[v];
#pragma unroll
                for (int r = 0; r < 16; r += 2) { const int rl0 = 4 * hi + (r & 3) + 8 * (r >> 2), rl1 = 4 * hi + ((r + 1) & 3) + 8 * (r >> 2);
                    const f32x2 og = {bflo((unsigned)*(const LAS unsigned short*)(ogs + rl0 * 272 + v * 2)), bflo((unsigned)*(const LAS unsigned short*)(ogs + rl1 * 272 + v * 2))};
                    const f32x2 e = og * bc2(-1.4426950408889634f); const f32x2 d = (f32x2){__builtin_amdgcn_exp2f(e[0]), __builtin_amdgcn_exp2f(e[1])} + bc2(1.f);
                    const f32x2 sg = og * (f32x2){__builtin_amdgcn_rcpf(d[0]), __builtin_amdgcn_rcpf(d[1])};
                    const f32x2 o2 = ((f32x2){acc[vb][r], acc[vb][r + 1]} * (f32x2){sc[r], sc[r + 1]}) * (sg * bc2(gn));
                    const float o0 = __builtin_amdgcn_fmed3f(o2[0], -448.f, 448.f), o1 = __builtin_amdgcn_fmed3f(o2[1], -448.f, 448.f);
                    const unsigned w = (unsigned)__builtin_amdgcn_cvt_pk_fp8_f32(o0, o1, 0, false);
                    outs[rl0 * 144 + v] = (unsigned char)w; outs[rl1 * 144 + v] = (unsigned char)(w >> 8); } }
            asm volatile("" ::: "memory");
#pragma unroll
            for (int i = 0; i < 4; ++i) { const int idx = i * 64 + lane; *(v4u*)(MIX + (row0 + (idx >> 3)) * DM + h * 128 + (idx & 7) * 16) = *(const LAS v4u*)(outs + (idx >> 3) * 144 + (idx & 7) * 16); }
            asm volatile("" ::: "memory");
          }
        }
        FILLER_BARRIER(4, 2);
    }

    if (IN(5)) {
        pg8::Gemm g{MIX, WOUT, 1024, nullptr}; pg8::StaticOrder S; S.init(NTOK / 256, 4, G, bx);
        EpiMix16 E{M16, 1.f / (MIX8S * W8S)};
        pg8::TableOrder<pg8::StaticOrder> T; T.build(&S, UTAB);
        pg8::gemm_phase<EpiMix16, pg8::TableOrder<pg8::StaticOrder>, true, false, true>(lds, g, T, E, lds + RING_BYTES + 4096);
        FILLER_BARRIER(5, 3);
    }

    if (IN(6)) {
        LAS float* rwl = ldsf;
        LAS int* lh = (LAS int*)(lds + RING_BYTES + 1024);
        if (bx < 256) { for (int i = tid; i < 8192; i += NTHR) { const int d = i >> 3, c4 = (i & 7) * 4; *(LAS f32x4*)(rwl + (d ^ ((d >> 4) & 1)) * 32 + (c4 ^ (16 * ((d >> 3) & 1)))) = *(const f32x4*)(RWP + d * 32 + c4); } }
        for (int blk = bx; blk < 256; blk += G) {
            const int t0 = blk * 128;
            if (tid < 32) lh[tid] = 0;
            __syncthreads();
            const int tk = lane & 15, kq = lane >> 4; const size_t m = (size_t)t0 + wave * 16 + tk;
            const float* xp = x + m * DM + 8 * kq; bf16* mp = M16 + m * DM + 8 * kq; unsigned char* x8 = H2 + m * DM + 8 * kq;
            const int x1 = 32 * (kq >> 1);
            const LAS float* wpE = rwl + (8 * kq) * 32 + (tk ^ (16 * (kq & 1))) + x1; const LAS float* wpO = rwl + (8 * kq) * 32 + (tk ^ (16 * (kq & 1))) - x1;
            const int o16 = (kq & 1) ? -16 : 16;
            f32x4 acc0 = {0.f, 0.f, 0.f, 0.f}, acc1 = acc0; float ss = 0.f;
            f32x4 xv[8]; v4u mv[4];
#pragma unroll
            for (int j = 0; j < 4; ++j) { xv[2 * j] = *(const f32x4*)(xp + 32 * j); xv[2 * j + 1] = *(const f32x4*)(xp + 32 * j + 4); mv[j] = *(const v4u*)(mp + 32 * j); }
            for (int JJ = 0; JJ < 32; JJ += 4) { f32x4 xn[8]; v4u mn[4];
#pragma unroll
                for (int j = 0; j < 4; ++j) { const int Jn = (JJ + 4 + j) & 31; xn[2 * j] = *(const f32x4*)(xp + 32 * Jn); xn[2 * j + 1] = *(const f32x4*)(xp + 32 * Jn + 4); mn[j] = *(const v4u*)(mp + 32 * Jn); }
#pragma unroll
                for (int j = 0; j < 4; ++j) { const int J = JJ + j;
                    const f32x4 va = xv[2 * j] + (f32x4){bflo(mv[j].x), bfhi(mv[j].x), bflo(mv[j].y), bfhi(mv[j].y)}, vb = xv[2 * j + 1] + (f32x4){bflo(mv[j].z), bfhi(mv[j].z), bflo(mv[j].w), bfhi(mv[j].w)};
                    ss += ((va.x * va.x + va.y * va.y) + (va.z * va.z + va.w * va.w)) + ((vb.x * vb.x + vb.y * vb.y) + (vb.z * vb.z + vb.w * vb.w));
                    *(v2u*)(x8 + 32 * J) = (v2u){pk4_fp8(va.x, va.y, va.z, va.w), pk4_fp8(vb.x, vb.y, vb.z, vb.w)};
                    *(v4u*)(mp + 32 * J) = (v4u){pk2(va.x, va.y), pk2(va.z, va.w), pk2(vb.x, vb.y), pk2(vb.z, vb.w)};
#pragma unroll
                    for (int e = 0; e < 8; ++e) { const LAS float* wp = (e & 1) ? wpO : wpE; const float a0 = wp[(32 * J + e) * 32], a1 = wp[(32 * J + e) * 32 + o16], bvv = (e < 4) ? va[e & 3] : vb[e & 3];
                        acc0 = __builtin_amdgcn_mfma_f32_16x16x4f32(a0, bvv, acc0, 0, 0, 0); acc1 = __builtin_amdgcn_mfma_f32_16x16x4f32(a1, bvv, acc1, 0, 0, 0); } }
#pragma unroll
                for (int j = 0; j < 8; ++j) xv[j] = xn[j];
#pragma unroll
                for (int j = 0; j < 4; ++j) mv[j] = mn[j]; }
            ss += __shfl_xor(ss, 16); ss += __shfl_xor(ss, 32);
            const float r = 1.f / sqrtf(ss * (1.f / DM) + EPS);
            float bv[4] = {-3e38f, -3e38f, -3e38f, -3e38f}; int bi[4] = {0, 0, 0, 0};
#pragma unroll
            for (int c = 0; c < 8; ++c) { const int e = (c < 4) ? (4 * kq + c) : (16 + 4 * kq + (c - 4)); float v = ((c < 4) ? acc0[c & 3] : acc1[c & 3]) * r + router_b[e]; int id = e;
#pragma unroll
                for (int s = 0; s < 4; ++s) { const bool gt = v > bv[s]; const float tv = gt ? bv[s] : v; const int ti = gt ? bi[s] : id; bv[s] = gt ? v : bv[s]; bi[s] = gt ? id : bi[s]; v = tv; id = ti; } }
#pragma unroll
            for (int xo = 16; xo <= 32; xo <<= 1) { float ov[4]; int oi[4];
#pragma unroll
                for (int s = 0; s < 4; ++s) { ov[s] = __shfl_xor(bv[s], xo); oi[s] = __shfl_xor(bi[s], xo); }
#pragma unroll
                for (int c = 0; c < 4; ++c) { float v = ov[c]; int id = oi[c];
#pragma unroll
                    for (int s = 0; s < 4; ++s) { const bool gt = (v > bv[s]) || (v == bv[s] && id < bi[s]); const float tv = gt ? bv[s] : v; const int ti = gt ? bi[s] : id; bv[s] = gt ? v : bv[s]; bi[s] = gt ? id : bi[s]; v = tv; id = ti; } } }
            if (kq == 0) {
                const float e1 = __expf(bv[1] - bv[0]), e2 = __expf(bv[2] - bv[0]), e3 = __expf(bv[3] - bv[0]); const float inv = 1.f / (1.f + e1 + e2 + e3);
                *(f32x4*)(TOPG + m * 4) = (f32x4){inv, e1 * inv, e2 * inv, e3 * inv};
                int rk[4];
#pragma unroll
                for (int s = 0; s < 4; ++s) rk[s] = atomicAdd((int*)&lh[bi[s]], 1);
                *(v4u*)(TOPE + m * 4) = (v4u){(unsigned)bi[0], (unsigned)bi[1], (unsigned)bi[2], (unsigned)bi[3]};
                *(v4u*)(RANK + m * 4) = (v4u){(unsigned)rk[0], (unsigned)rk[1], (unsigned)rk[2], (unsigned)rk[3]};
                RSTD[m] = r;
            }
            __syncthreads();
            if (tid < 32) HIST[blk * 32 + tid] = lh[tid];
            __syncthreads();
        }
        FILLER_BARRIER(6, 4);
    }

    if (IN(7)) {
        LAS int* ptot = (LAS int*)ldsf;
        LAS int* pbase = ptot + 512;
        LAS int* tot = pbase + 512;
        LAS int* pstart = tot + 32;
        LAS int* sbase = pstart + 32;
        for (int blk = bx; blk < 256; blk += G) {
            { const int e = tid & 31, part = tid >> 5; int a = 0, b = 0;
              for (int i = 0; i < 16; ++i) { const int bb = part * 16 + i; const int hv = HIST[bb * 32 + e]; a += hv; b += (bb < blk) ? hv : 0; }
              ptot[part * 32 + e] = a; pbase[part * 32 + e] = b; }
            __syncthreads();
            if (tid < 32) { int a = 0, b = 0; for (int p = 0; p < 16; ++p) { a += ptot[p * 32 + tid]; b += pbase[p * 32 + tid]; } tot[tid] = a; sbase[tid] = b; }
            __syncthreads();
            if (tid < 32) { int ps = 0; for (int e = 0; e < tid; ++e) ps += (tot[e] + 255) & ~255; pstart[tid] = ps; sbase[tid] += ps; }
            __syncthreads();
            { const int tl = tid >> 2, k = tid & 3; const size_t m = (size_t)blk * 128 + tl; const int e = TOPE[m * 4 + k]; const int slot = sbase[e] + RANK[m * 4 + k];
              BUFTOK[slot] = (int)m; GATESLOT[slot] = TOPG[m * 4 + k]; RSLOT[slot] = RSTD[m]; DSTROW[slot] = (int)m * 4 + k; }
            if (blk < 32) { const int e = blk, ps = pstart[e], te = tot[e], pe = (te + 255) & ~255;
                if (tid < 256 && te + tid < pe) { BUFTOK[ps + te + tid] = 0; GATESLOT[ps + te + tid] = 0.f; RSLOT[ps + te + tid] = 0.f; DSTROW[ps + te + tid] = NTOK * 4; }
                for (int t = tid; t < pe / 256; t += NTHR) TILEE[ps / 256 + t] = e;
                if (e == 31 && tid == 0) TILEE[1023] = (ps + pe) / 256; }
            __syncthreads();
        }
        if (BOTH(7)) GRID_BAR();
    }

    if (IN(8)) {
        const int nT = __builtin_amdgcn_readfirstlane(__hip_atomic_load(TILEE + 1023, __ATOMIC_RELAXED, __HIP_MEMORY_SCOPE_AGENT));
        pg8::Gemm g{H2, WMIN, 1024, BUFTOK}; pg8::OwnOrder S; S.init(nT, 8, G, bx, TILEE, false, false);
        EpiSwiglu E{ACT, moe_b_in, RSLOT, BUFTOK};
        pg8::TableOrder<pg8::OwnOrder> T; T.build(&S, UTAB);
        pg8::gemm_phase<EpiSwiglu, pg8::TableOrder<pg8::OwnOrder>, true, true, true>(lds, g, T, E, lds + RING_BYTES + 4096);
        if (BOTH(8)) GRID_ARRIVE();
    }

    if (IN(9)) {
        const int nT = __builtin_amdgcn_readfirstlane(__hip_atomic_load(TILEE + 1023, __ATOMIC_RELAXED, __HIP_MEMORY_SCOPE_AGENT));
        pg8::Gemm g{ACT, WMOUT, 1024, nullptr}; pg8::OwnOrder S; S.init(nT, 4, G, bx, TILEE, true, true);
        EpiY E{YB, moe_b_out, GATESLOT, DSTROW};
        const int n_own = S.has_own ? (S.split ? 2 : 4) : 0;
        typedef pg8::SubOrder<pg8::OwnOrder> Sub;
        { const Sub A{S, 0, n_own}; pg8::TableOrder<Sub> T; T.build(&A, UTAB);
          pg8::gemm_phase<EpiY, pg8::TableOrder<Sub>, true, false, true>(lds, g, T, E, lds + RING_BYTES + 4096); }
        if (BOTH(8)) GRID_WAIT();
        { const Sub B{S, n_own, 1 << 30}; pg8::TableOrder<Sub> T; T.build(&B, UTAB);
          pg8::gemm_phase<EpiY, pg8::TableOrder<Sub>, true, false, true>(lds, g, T, E, lds + RING_BYTES + 4096); }
        if (BOTH(9)) GRID_BAR();
    }

    if (IN(10)) {
        for (int m0 = gw * 4; m0 < NTOK; m0 += NGW * 4) {
            v4u mw[2][4]; v2u w[2][4][4];
#pragma unroll
            for (int j = 0; j < 2; ++j)
#pragma unroll
                for (int t = 0; t < 4; ++t) { const int col = 8 * lane + 512 * j;
                    mw[j][t] = __builtin_nontemporal_load((const v4u*)(M16 + (size_t)(m0 + t) * DM + col));
#pragma unroll
                    for (int kk = 0; kk < 4; ++kk) w[j][t][kk] = __builtin_nontemporal_load((const v2u*)(YB + ((size_t)(m0 + t) * 4 + kk) * 1024 + col)); }
#pragma unroll
            for (int j = 0; j < 2; ++j)
#pragma unroll
                for (int t = 0; t < 4; ++t) { const int col = 8 * lane + 512 * j; const v4u mm_ = mw[j][t];
                    f32x4 b0 = (f32x4){bflo(mm_.x), bfhi(mm_.x), bflo(mm_.y), bfhi(mm_.y)}, b1 = (f32x4){bflo(mm_.z), bfhi(mm_.z), bflo(mm_.w), bfhi(mm_.w)};
                    f32x4 y0 = {0.f, 0.f, 0.f, 0.f}, y1 = y0;
#pragma unroll
                    for (int kk = 0; kk < 4; ++kk) { const v2u ww = w[j][t][kk];
                        y0.x += fp8f<0>(ww.x); y0.y += fp8f<1>(ww.x); y0.z += fp8f<2>(ww.x); y0.w += fp8f<3>(ww.x); y1.x += fp8f<0>(ww.y); y1.y += fp8f<1>(ww.y); y1.z += fp8f<2>(ww.y); y1.w += fp8f<3>(ww.y); }
                    b0 += y0 * (1.f / Y8S); b1 += y1 * (1.f / Y8S);
                    float* op = out + (size_t)(m0 + t) * DM + col; __builtin_nontemporal_store(b0, (f32x4*)op); __builtin_nontemporal_store(b1, (f32x4*)(op + 4)); }
        }
    }
#undef IN
#undef BOTH
}

extern "C" void kernel_launch(void* const* d_in, const int* in_sizes, int n_in, void* d_out, int out_size, void* d_ws, size_t ws_size, hipStream_t stream) {
    static int grid = 0;
    if (grid == 0) {
        if (n_in != 17 || in_sizes[0] != NTOK * DM || out_size != NTOK * DM || ws_size < WS_END) { fprintf(stderr, "kernel_launch: unexpected shapes (n_in %d, in0 %d, out %d, ws %zu)\n", n_in, n_in > 0 ? in_sizes[0] : -1, out_size, ws_size); grid = -1; return; }
        int dev = 0, cus = 0, per_cu = 0;
        if (hipGetDevice(&dev) != hipSuccess || hipDeviceGetAttribute(&cus, hipDeviceAttributeMultiprocessorCount, dev) != hipSuccess) { grid = -1; return; }
        if (hipFuncSetAttribute((const void*)fwd, hipFuncAttributeMaxDynamicSharedMemorySize, LDS_BYTES) != hipSuccess) { fprintf(stderr, "kernel_launch: hipFuncSetAttribute failed\n"); grid = -1; return; }
        if (hipOccupancyMaxActiveBlocksPerMultiprocessor(&per_cu, (const void*)fwd, NTHR, LDS_BYTES) != hipSuccess || per_cu < 1) fprintf(stderr, "kernel_launch: occupancy query reports %d\n", per_cu);
        (void)hipGetLastError();
        grid = cus;
    }
    if (grid < 0) return;
    (void)hipMemsetAsync((char*)d_ws + WS_CTL + CTL_ZERO_OFF, 0, CTL_ZERO_BYTES, stream);
    Args a{};
    for (int i = 0; i < 17; ++i) a.in[i] = (const float*)d_in[i];
    a.out = (float*)d_out; a.ws = (unsigned char*)d_ws; a.li = 0; a.flags = 0;
#if MK_ONE_LAUNCH && !PROBE_MULTI
    a.ph_lo = 0; a.ph_hi = NPHASE;
    hipLaunchKernelGGL(fwd, dim3(grid), dim3(NTHR), LDS_BYTES, stream, a);
#else
    for (int p = 0; p < NPHASE; ++p) { a.ph_lo = p; a.ph_hi = p + 1; a.flags = 0; hipLaunchKernelGGL(fwd, dim3(grid), dim3(NTHR), LDS_BYTES, stream, a);
        if (p == PROBE_DUP) { a.flags = PROBE_FLAGS; hipLaunchKernelGGL(fwd, dim3(grid), dim3(NTHR), LDS_BYTES, stream, a); } }
#endif
}
```
